# Optimizing an MI355X kernel written in HIP

```python
import jax
import jax.numpy as jnp
from jax import lax
import numpy as np

D_MODEL = 1024
BATCH = 8
SEQ = 4096
DEPTH = 2

CTX_LEN = 256
GRID_W = 64
M_WIDTH = D_MODEL // 2
M_HEAD_DIM = 128
M_HEADS = M_WIDTH // M_HEAD_DIM
N_WIDTH = D_MODEL - M_WIDTH
N_HEAD_DIM = 64
N_HEADS = N_WIDTH // N_HEAD_DIM
MIX_WIDTH = M_WIDTH + N_WIDTH
G_COLS = 4 * M_HEADS
Q_COLS = 2 * M_WIDTH + N_WIDTH
KV_COLS = 2 * M_WIDTH + G_COLS + 2 * N_WIDTH
N_IN = Q_COLS + KV_COLS
CONV_WIDTH = 3
CHUNK = 128
WIN_H = 8
WIN_W = 16
ROPE_AXIS_DIM = M_HEAD_DIM // 2
ROPE_BASE = 10000.0
N_EXPERTS = 16
N_GROUPS = 4
EXPERTS_PER_GROUP = N_EXPERTS // N_GROUPS
TOP_K = 2
MOE_D_FF = 512
NORM_EPS = 1e-6
F_BIAS_LO = 3.0
F_BIAS_HI = 6.0

kernel_name = "hybrid_mlstm_natten_grouped_moe_dit"


def rmsnorm(x, w):
    x32 = x.astype(jnp.float32)
    y = x32 * lax.rsqrt(jnp.mean(x32 * x32, axis=-1, keepdims=True) + NORM_EPS)
    return (y * w.astype(jnp.float32)).astype(x.dtype)


def modulate(h, shift, scale):
    return h * (1 + scale) + shift


def centred_dwconv(x, w, b):
    L = x.shape[1]
    pad = CONV_WIDTH // 2
    xp = jnp.pad(x, ((0, 0), (pad, pad), (0, 0)))
    y = b
    for j in range(CONV_WIDTH):
        y = y + xp[:, j:j + L] * w[j]
    return y


def axial_rope_tables(L):
    t = jnp.arange(L)
    row = (t // GRID_W).astype(jnp.float32)
    col = (t % GRID_W).astype(jnp.float32)
    inv = ROPE_BASE ** (-jnp.arange(0, ROPE_AXIS_DIM, 2, dtype=jnp.float32) / ROPE_AXIS_DIM)
    ang_r = row[:, None] * inv
    ang_c = col[:, None] * inv
    return (jnp.cos(ang_r)[:, None], jnp.sin(ang_r)[:, None],
            jnp.cos(ang_c)[:, None], jnp.sin(ang_c)[:, None])


def _rotate(x, cos, sin):
    x1, x2 = jnp.split(x, 2, axis=-1)
    cos = cos.astype(x.dtype)
    sin = sin.astype(x.dtype)
    return jnp.concatenate([x1 * cos - x2 * sin, x1 * sin + x2 * cos], axis=-1)


def axial_rope(x, tables):
    cr, sr, cc, sc = tables
    xr, xc = jnp.split(x, 2, axis=-1)
    return jnp.concatenate([_rotate(xr, cr, sr), _rotate(xc, cc, sc)], axis=-1)


def _to_chunks(a):
    B, L = a.shape[:2]
    a = a.reshape((B, L // CHUNK, CHUNK) + a.shape[2:])
    return jnp.moveaxis(jnp.moveaxis(a, 1, 0), 2, 3)


def mlstm_zero_state(B):
    f32 = jnp.float32
    return (jnp.zeros((B, M_HEADS, M_HEAD_DIM, M_HEAD_DIM), f32),
            jnp.zeros((B, M_HEADS, M_HEAD_DIM), f32),
            jnp.zeros((B, M_HEADS), f32))


def mlstm_scan(q, k, v, i_pre, f_pre, state):
    with_out = q is not None
    f32 = jnp.float32
    B, L = k.shape[:2]
    xs = [_to_chunks(a.astype(f32)) for a in (k, v, i_pre, f_pre)]
    if with_out:
        xs.append(_to_chunks(q.astype(f32)))
    causal = jnp.tril(jnp.ones((CHUNK, CHUNK), dtype=bool))

    def step(carry, inp):
        C, n, m = carry
        kc, vc, ic, fc = inp[:4]
        b = jnp.cumsum(jax.nn.log_sigmoid(fc), axis=-1)
        b_end = b[..., -1]
        g = b_end[..., None] - b + ic
        m_new = jnp.maximum(b_end + m, jnp.max(g, axis=-1))
        w_old = jnp.exp(b_end + m - m_new)
        w_tok = jnp.exp(g - m_new[..., None])
        C_new = w_old[..., None, None] * C + jnp.einsum('bhs,bhsd,bhse->bhde', w_tok, kc, vc)
        n_new = w_old[..., None] * n + jnp.einsum('bhs,bhsd->bhd', w_tok, kc)
        if not with_out:
            return (C_new, n_new, m_new), None
        qc = inp[4]
        logd = jnp.where(causal, b[..., :, None] - b[..., None, :] + ic[..., None, :], -jnp.inf)
        inter = b + m[..., None]
        m_row = jnp.maximum(inter, jnp.max(logd, axis=-1))
        dmat = jnp.exp(logd - m_row[..., None])
        w_inter = jnp.exp(inter - m_row)
        s = jnp.einsum('bhtd,bhsd->bhts', qc, kc) * dmat
        num = (jnp.einsum('bhts,bhse->bhte', s, vc)
               + w_inter[..., None] * jnp.einsum('bhtd,bhde->bhte', qc, C))
        qn = jnp.sum(s, axis=-1) + w_inter * jnp.einsum('bhtd,bhd->bht', qc, n)
        den = jnp.maximum(jnp.abs(qn), jnp.exp(-m_row))
        return (C_new, n_new, m_new), num / den[..., None]

    state, h = lax.scan(step, state, tuple(xs))
    if not with_out:
        return state, None
    h = jnp.moveaxis(jnp.moveaxis(h, 3, 2), 0, 1).reshape(B, L, M_HEADS, M_HEAD_DIM)
    return state, h.astype(v.dtype)


def _dir_gates(g, gate_b, d):
    g = g.astype(jnp.float32) + gate_b.astype(jnp.float32)
    i_pre = g[..., (2 * d) * M_HEADS:(2 * d + 1) * M_HEADS]
    f_pre = g[..., (2 * d + 1) * M_HEADS:(2 * d + 2) * M_HEADS]
    return i_pre, f_pre


def _ident(a):
    return a


def _rev(a):
    return jnp.flip(a, axis=1)


def mlstm_bidirectional(q_l, k_l, v_l, g_l, q_c, k_c, v_c, g_c, gate_b):
    B = k_l.shape[0]
    h_lat, h_ctx = [], []
    for d, rev in ((0, _ident), (1, _rev)):
        il, fl = _dir_gates(g_l, gate_b, d)
        ic, fc = _dir_gates(g_c, gate_b, d)
        st, hc = mlstm_scan(None if q_c is None else rev(q_c), rev(k_c), rev(v_c),
                            rev(ic), rev(fc), mlstm_zero_state(B))
        _, hl = mlstm_scan(rev(q_l), rev(k_l), rev(v_l), rev(il), rev(fl), st)
        h_lat.append(rev(hl))
        if q_c is not None:
            h_ctx.append(rev(hc))
    return h_lat[0] + h_lat[1], (h_ctx[0] + h_ctx[1] if q_c is not None else None)


def head_rmsnorm(h, w):
    B, L = h.shape[:2]
    return rmsnorm(h, w.reshape(M_HEADS, M_HEAD_DIM)).reshape(B, L, M_WIDTH)


def neighborhood_attention(q, k, v, k_ctx, v_ctx, rpb):
    B, L, H, hd = q.shape
    rows = L // GRID_W
    kh = min(WIN_H, rows)
    kw = WIN_W
    qg = (q * hd ** -0.5).reshape(B, rows, GRID_W, H, hd)
    kg = k.reshape(B, rows, GRID_W, H, hd)
    vg = v.reshape(B, rows, GRID_W, H, hd)
    cols = jnp.arange(GRID_W)
    col_idx = jnp.clip(cols - kw // 2, 0, GRID_W - kw)[:, None] + jnp.arange(kw)[None, :]
    dc = col_idx - cols[:, None] + (WIN_W - 1)

    def row_block(r):
        rs = jnp.clip(r - kh // 2, 0, rows - kh)
        kb = lax.dynamic_slice_in_dim(kg, rs, kh, axis=1)[:, :, col_idx]
        vb = lax.dynamic_slice_in_dim(vg, rs, kh, axis=1)[:, :, col_idx]
        qr = lax.dynamic_index_in_dim(qg, r, axis=1, keepdims=False)
        dr = rs + jnp.arange(kh) - r + (WIN_H - 1)
        bias = jnp.transpose(rpb[:, dr[:, None, None], dc[None]], (0, 2, 1, 3))
        s_win = (jnp.einsum('bwhd,biwjhd->bhwij', qr, kb) + bias).reshape(B, H, GRID_W, kh * kw)
        s_ctx = jnp.einsum('bwhd,bnhd->bhwn', qr, k_ctx)
        p = jax.nn.softmax(jnp.concatenate([s_win, s_ctx], axis=-1).astype(jnp.float32), axis=-1)
        p = p.astype(v.dtype)
        p_win = p[..., :kh * kw].reshape(B, H, GRID_W, kh, kw)
        return (jnp.einsum('bhwij,biwjhd->bwhd', p_win, vb)
                + jnp.einsum('bhwn,bnhd->bwhd', p[..., kh * kw:], v_ctx))

    out = lax.map(row_block, jnp.arange(rows))
    return jnp.moveaxis(out, 0, 1).reshape(B, L, H * hd)


def context_attention(q, k, v):
    B, N, H, hd = q.shape
    s = jnp.einsum('bnhd,bmhd->bhnm', q * hd ** -0.5, k)
    p = jax.nn.softmax(s.astype(jnp.float32), axis=-1).astype(v.dtype)
    return jnp.einsum('bhnm,bmhd->bnhd', p, v).reshape(B, N, H * hd)


def _q_side(p):
    return jnp.split(p, [M_WIDTH, 2 * M_WIDTH], axis=-1)


def _kv_side(p):
    return jnp.split(p, [M_WIDTH, 2 * M_WIDTH, 2 * M_WIDTH + G_COLS,
                         2 * M_WIDTH + G_COLS + N_WIDTH], axis=-1)


def _m_heads(a):
    return a.reshape(a.shape[:2] + (M_HEADS, M_HEAD_DIM))


def _n_heads(a):
    return a.reshape(a.shape[:2] + (N_HEADS, N_HEAD_DIM))


def hybrid_mixer(hx, hc, rope, w_in, conv_w, conv_b, gate_b, mnorm_w, rpb, w_out, with_ctx_out):
    px = hx @ w_in
    pc = hc @ (w_in if with_ctx_out else w_in[:, Q_COLS:])
    mq_l, mo_l, nq_l = _q_side(px[..., :Q_COLS])
    mk_l, mv_l, g_l, nk_l, nv_l = _kv_side(px[..., Q_COLS:])
    if with_ctx_out:
        mq_c, mo_c, nq_c = _q_side(pc[..., :Q_COLS])
        mk_c, mv_c, g_c, nk_c, nv_c = _kv_side(pc[..., Q_COLS:])
    else:
        mk_c, mv_c, g_c, nk_c, nv_c = _kv_side(pc)
    cw_q, cw_k = conv_w[:, :M_WIDTH], conv_w[:, M_WIDTH:]
    cb_q, cb_k = conv_b[:M_WIDTH], conv_b[M_WIDTH:]
    k_scale = M_HEAD_DIM ** -0.5
    q_l = axial_rope(_m_heads(jax.nn.silu(centred_dwconv(mq_l, cw_q, cb_q))), rope)
    k_l = axial_rope(_m_heads(jax.nn.silu(centred_dwconv(mk_l, cw_k, cb_k))), rope) * k_scale
    k_c = _m_heads(jax.nn.silu(centred_dwconv(mk_c, cw_k, cb_k))) * k_scale
    q_c = _m_heads(jax.nn.silu(centred_dwconv(mq_c, cw_q, cb_q))) if with_ctx_out else None
    h_l, h_c = mlstm_bidirectional(q_l, k_l, _m_heads(mv_l), g_l,
                                   q_c, k_c, _m_heads(mv_c), g_c, gate_b)
    m_out_l = head_rmsnorm(h_l, mnorm_w) * jax.nn.sigmoid(mo_l)
    nk_c, nv_c = _n_heads(nk_c), _n_heads(nv_c)
    n_out_l = neighborhood_attention(_n_heads(nq_l), _n_heads(nk_l), _n_heads(nv_l), nk_c, nv_c, rpb)
    y_l = jnp.concatenate([m_out_l, n_out_l], axis=-1) @ w_out
    if not with_ctx_out:
        return y_l, None
    m_out_c = head_rmsnorm(h_c, mnorm_w) * jax.nn.sigmoid(mo_c)
    n_out_c = context_attention(_n_heads(nq_c), nk_c, nv_c)
    y_c = jnp.concatenate([m_out_c, n_out_c], axis=-1) @ w_out
    return y_l, y_c


def grouped_moe(h, router_w, router_b, w1, w3, w2):
    shape = h.shape
    t = h.reshape(-1, shape[-1])
    scores = jax.nn.softmax((t @ router_w).astype(jnp.float32), axis=-1)
    sel = scores + router_b.astype(jnp.float32)
    gscore = jnp.sum(lax.top_k(sel.reshape(-1, N_GROUPS, EXPERTS_PER_GROUP), TOP_K)[0], axis=-1)
    best = jnp.argmax(gscore, axis=-1)
    in_grp = (jnp.arange(N_EXPERTS) // EXPERTS_PER_GROUP)[None, :] == best[:, None]
    _, idx = lax.top_k(jnp.where(in_grp, sel, -jnp.inf), TOP_K)
    wts = jnp.take_along_axis(scores, idx, axis=-1)
    wts = wts / jnp.sum(wts, axis=-1, keepdims=True)
    gate = jnp.sum(jax.nn.one_hot(idx, N_EXPERTS, dtype=jnp.float32) * wts[..., None], axis=1)
    gate = gate.astype(t.dtype)
    y = jnp.zeros_like(t)
    for e in range(N_EXPERTS):
        a = jax.nn.silu(t @ w1[e]) * (t @ w3[e])
        y = y + gate[:, e:e + 1] * (a @ w2[e])
    return y.reshape(shape)


def setup_inputs(seed: int = 0) -> dict:
    key = jax.random.key(seed)
    ks = jax.random.split(key, 24)
    f32 = jnp.float32

    def nrm(k, shape, s):
        return jax.random.normal(k, shape, f32) * s

    gate_base = jnp.concatenate([jnp.zeros((M_HEADS,), f32), jnp.linspace(F_BIAS_LO, F_BIAS_HI, M_HEADS),
                                 jnp.zeros((M_HEADS,), f32), jnp.linspace(F_BIAS_LO, F_BIAS_HI, M_HEADS)])
    return {
        "x": nrm(ks[0], (BATCH, SEQ, D_MODEL), 1.0),
        "c": nrm(ks[1], (BATCH, D_MODEL), 1.0),
        "ctx": nrm(ks[2], (BATCH, CTX_LEN, D_MODEL), 1.0),
        "c_ctx": nrm(ks[3], (D_MODEL,), 1.0),
        "ada_w": nrm(ks[4], (DEPTH, D_MODEL, 6 * D_MODEL), 0.5 * D_MODEL ** -0.5),
        "ada_b": nrm(ks[5], (DEPTH, 6 * D_MODEL), 0.02),
        "norm1_w": 1.0 + nrm(ks[6], (DEPTH, D_MODEL), 0.02),
        "w_in": nrm(ks[7], (DEPTH, D_MODEL, N_IN), D_MODEL ** -0.5),
        "conv_w": nrm(ks[8], (DEPTH, CONV_WIDTH, 2 * M_WIDTH), CONV_WIDTH ** -0.5),
        "conv_b": nrm(ks[9], (DEPTH, 2 * M_WIDTH), 0.02),
        "gate_b": gate_base[None, :] + nrm(ks[10], (DEPTH, G_COLS), 0.1),
        "mnorm_w": 1.0 + nrm(ks[11], (DEPTH, M_WIDTH), 0.02),
        "rpb": nrm(ks[12], (DEPTH, N_HEADS, 2 * WIN_H - 1, 2 * WIN_W - 1), 0.1),
        "w_out": nrm(ks[13], (DEPTH, MIX_WIDTH, D_MODEL), MIX_WIDTH ** -0.5),
        "norm2_w": 1.0 + nrm(ks[14], (DEPTH, D_MODEL), 0.02),
        "router_w": nrm(ks[15], (D_MODEL, N_EXPERTS), D_MODEL ** -0.5),
        "router_b": nrm(ks[16], (N_EXPERTS,), 0.01),
        "exp_w1": nrm(ks[17], (DEPTH, N_EXPERTS, D_MODEL, MOE_D_FF), D_MODEL ** -0.5),
        "exp_w3": nrm(ks[18], (DEPTH, N_EXPERTS, D_MODEL, MOE_D_FF), D_MODEL ** -0.5),
        "exp_w2": nrm(ks[19], (DEPTH, N_EXPERTS, MOE_D_FF, D_MODEL), MOE_D_FF ** -0.5),
        "final_norm_w": 1.0 + nrm(ks[20], (D_MODEL,), 0.02),
    }


def reference(x, c, ctx, c_ctx, ada_w, ada_b, norm1_w, w_in, conv_w, conv_b, gate_b, mnorm_w, rpb,
              w_out, norm2_w, router_w, router_b, exp_w1, exp_w3, exp_w2, final_norm_w):
    L = x.shape[1]
    rope = axial_rope_tables(L)
    s_lat = jax.nn.silu(c)
    s_ctx = jax.nn.silu(c_ctx)
    for layer in range(DEPTH):
        last = layer == DEPTH - 1
        mod_l = jnp.split((s_lat @ ada_w[layer] + ada_b[layer])[:, None, :], 6, axis=-1)
        mod_c = jnp.split(s_ctx @ ada_w[layer] + ada_b[layer], 6, axis=-1)
        hx = modulate(rmsnorm(x, norm1_w[layer]), mod_l[0], mod_l[1])
        hc = modulate(rmsnorm(ctx, norm1_w[layer]), mod_c[0], mod_c[1])
        y_l, y_c = hybrid_mixer(hx, hc, rope, w_in[layer], conv_w[layer], conv_b[layer], gate_b[layer],
                                mnorm_w[layer], rpb[layer], w_out[layer], not last)
        x = x + mod_l[2] * y_l
        hx = modulate(rmsnorm(x, norm2_w[layer]), mod_l[3], mod_l[4])
        if last:
            x = x + mod_l[5] * grouped_moe(hx, router_w, router_b,
                                           exp_w1[layer], exp_w3[layer], exp_w2[layer])
        else:
            ctx = ctx + mod_c[2] * y_c
            hc = modulate(rmsnorm(ctx, norm2_w[layer]), mod_c[3], mod_c[4])
            h_all = grouped_moe(jnp.concatenate([hx, hc], axis=1), router_w, router_b,
                                exp_w1[layer], exp_w3[layer], exp_w2[layer])
            x = x + mod_l[5] * h_all[:, :L]
            ctx = ctx + mod_c[5] * h_all[:, L:]
    return rmsnorm(x, final_norm_w)
```

```cpp
#include <hip/hip_runtime.h>
#include <cstdio>
#include <cstdint>

typedef unsigned short bf16;
__device__ __forceinline__ float bf2f(bf16 b) { return __uint_as_float(((unsigned)b) << 16); }
__device__ __forceinline__ bf16 f2bf(float f) { unsigned u = __float_as_uint(f); u += 0x7fffu + ((u >> 16) & 1u); return (bf16)(u >> 16); }

constexpr int DM = 1024, NB = 8, SEQ = 4096, CTXL = 256, UT = SEQ + CTXL  ;
constexpr int MROWS = NB * UT;
constexpr int NCHUNK = UT / 128;
constexpr int N_IN = 3600;
constexpr float EPS = 1e-6f;
constexpr int MAXSLOTS = 73728;

constexpr size_t MiB = 1u << 20;
constexpr size_t WS_CTL = 0;
constexpr size_t WS_MOD = 1 * MiB;
constexpr size_t WS_CTX = 2 * MiB;
constexpr size_t WS_WIN = 10 * MiB;
constexpr size_t WS_WOUT = 25 * MiB;
constexpr size_t WS_GATES = 29 * MiB;
constexpr size_t WS_ROUTE = 32 * MiB;
constexpr size_t WS_ACT = 34 * MiB;
constexpr size_t WS_PA = 102 * MiB;
constexpr size_t WS_QKRAW = 204 * MiB;
constexpr size_t WS_CST = 204 * MiB;
constexpr size_t WS_MVT = 272 * MiB;
constexpr size_t WS_NVT = 306 * MiB;
constexpr size_t WS_QP = 340 * MiB;
constexpr size_t WS_KP = 374 * MiB;
constexpr size_t WS_KPT = 408 * MiB;
constexpr size_t WS_NST = 442 * MiB;
constexpr size_t WS_MST = 443 * MiB + 512 * 1024;
constexpr size_t WS_HSUM = 444 * MiB;
constexpr size_t WS_ACTM = 150 * MiB;
constexpr size_t WS_Y = 222 * MiB;
constexpr size_t WS_END = 512 * MiB;
constexpr size_t RT_TOK_E = 0, RT_TOK_W = 300 * 1024, RT_TOK_SLOT = 600 * 1024, RT_SLOT_TOK = 900 * 1024, RT_SLOT_W = 1200 * 1024, RT_TILE_E = 1500 * 1024;
constexpr int CW_CNT = 1024, CW_CUR = 1088, CW_OFF = 1152  , CW_NT = 1216;

__device__ __forceinline__ float silu_f(float v) { return v / (1.f + expf(-v)); }
__device__ __forceinline__ float sigmoid_f(float v) { return 1.f / (1.f + expf(-v)); }
__device__ __forceinline__ float logsig_f(float x) { return fminf(x, 0.f) - log1pf(expf(-fabsf(x))); }

__global__ void nv_mod(const float* c, const float* c_ctx, const float* ada_w, const float* ada_b, float* MOD) {
    const int j = blockIdx.x * 256 + threadIdx.x, r = blockIdx.y, l = blockIdx.z;
    __shared__ float s[1024];
    const float* src = r < 8 ? c + r * 1024 : c_ctx;
    for (int k = threadIdx.x; k < 1024; k += 256) s[k] = silu_f(src[k]);
    __syncthreads();
    const float* w = ada_w + (size_t)l * 1024 * 6144;
    float acc = 0.f;
    for (int k = 0; k < 1024; ++k) acc += s[k] * w[(size_t)k * 6144 + j];
    MOD[((size_t)l * 9 + r) * 6144 + j] = acc + ada_b[l * 6144 + j];
}

__device__ __forceinline__ float block_sum256(float v, float* red) {
    for (int o = 32; o >= 1; o >>= 1) v += __shfl_xor(v, o);
    __syncthreads();
    if ((threadIdx.x & 63) == 0) red[threadIdx.x >> 6] = v;
    __syncthreads();
    return red[0] + red[1] + red[2] + red[3];
}

__global__ void nv_norm(const float* xl, const float* xc, const float* nw, const float* MODl, int sh, int sc, bf16* ACT, int do_router,
                        const float* router_w, const float* router_b, int* TOK_E, float* TOK_W, unsigned* CNT, int skip_ctx) {
    const int row = blockIdx.x, b = row / UT, u = row % UT, tid = threadIdx.x;
    const bool ctx = u < CTXL;
    if (ctx && skip_ctx) return;
    __shared__ float red[4];
    __shared__ float lg[4][16];
    const float* xr = ctx ? xc + ((size_t)b * CTXL + u) * DM : xl + ((size_t)b * SEQ + (u - CTXL)) * DM;
    float v[4]; float ss = 0.f;
    for (int i = 0; i < 4; ++i) { v[i] = xr[tid + 256 * i]; ss += v[i] * v[i]; }
    ss = block_sum256(ss, red);
    const float rstd = rsqrtf(ss * (1.f / DM) + EPS);
    const float* md = MODl + (size_t)(ctx ? 8 : b) * 6144;
    float h[4];
    for (int i = 0; i < 4; ++i) { const int col = tid + 256 * i; h[i] = v[i] * rstd * nw[col] * (1.f + md[sc * 1024 + col]) + md[sh * 1024 + col]; ACT[(size_t)row * DM + col] = f2bf(h[i]); }
    if (!do_router) return;
    float pl[16];
    for (int e = 0; e < 16; ++e) { float a = 0.f; for (int i = 0; i < 4; ++i) a += h[i] * router_w[(tid + 256 * i) * 16 + e]; pl[e] = a; }
    for (int e = 0; e < 16; ++e) { float a = pl[e]; for (int o = 32; o >= 1; o >>= 1) a += __shfl_xor(a, o); if ((tid & 63) == 0) lg[tid >> 6][e] = a; }
    __syncthreads();
    if (tid == 0) {
        float p[16], sel[16], mx = -1e30f, sum = 0.f;
        for (int e = 0; e < 16; ++e) { p[e] = lg[0][e] + lg[1][e] + lg[2][e] + lg[3][e]; mx = fmaxf(mx, p[e]); }
        for (int e = 0; e < 16; ++e) { p[e] = expf(p[e] - mx); sum += p[e]; }
        for (int e = 0; e < 16; ++e) { p[e] /= sum; sel[e] = p[e] + router_b[e]; }
        int best = 0; float bgs = -1e30f;
        for (int g = 0; g < 4; ++g) {
            float m1 = -1e30f, m2 = -1e30f;
            for (int k = 0; k < 4; ++k) { const float s = sel[4 * g + k]; if (s > m1) { m2 = m1; m1 = s; } else if (s > m2) m2 = s; }
            if (m1 + m2 > bgs) { bgs = m1 + m2; best = g; }
        }
        int i0 = 4 * best; for (int k = 1; k < 4; ++k) if (sel[4 * best + k] > sel[i0]) i0 = 4 * best + k;
        int i1 = -1; for (int k = 0; k < 4; ++k) { const int e = 4 * best + k; if (e == i0) continue; if (i1 < 0 || sel[e] > sel[i1]) i1 = e; }
        const float w0 = p[i0], w1 = p[i1], ws = w0 + w1;
        TOK_E[row * 2] = i0; TOK_E[row * 2 + 1] = i1; TOK_W[row * 2] = w0 / ws; TOK_W[row * 2 + 1] = w1 / ws;
        atomicAdd(&CNT[i0], 1u); atomicAdd(&CNT[i1], 1u);
    }
}

struct EpiIn { bf16* QKRAW; bf16* PA; bf16* MVT; bf16* NVT; float* GATES; const float* gate_b; };
struct EpiOut { const float* sl; const float* sc; float* dl; float* dc; const float* MODl; int skip_ctx; int pad; };

template <int MODE> __global__ void nv_gemm(const bf16* A, const float* W, int ldw, int N, int K, EpiIn ei, EpiOut eo) {
    __shared__ float As[16][65], Bs[16][64];
    const int tid = threadIdx.x, tx = tid & 15, ty = tid >> 4, row0 = blockIdx.y * 64, col0 = blockIdx.x * 64;
    float acc[4][4];
    for (int i = 0; i < 4; ++i) for (int j = 0; j < 4; ++j) acc[i][j] = 0.f;
    for (int kt = 0; kt < K; kt += 16) {
        for (int i = 0; i < 4; ++i) { const int idx = tid + 256 * i, m = idx >> 4, k = idx & 15; As[k][m] = bf2f(A[(size_t)(row0 + m) * K + kt + k]); }
        for (int i = 0; i < 4; ++i) { const int idx = tid + 256 * i, k = idx >> 6, n = idx & 63; Bs[k][n] = (col0 + n < N) ? W[(size_t)(kt + k) * ldw + col0 + n] : 0.f; }
        __syncthreads();
        for (int k = 0; k < 16; ++k) {
            float a[4], bb[4];
            for (int i = 0; i < 4; ++i) a[i] = As[k][ty * 4 + i];
            for (int j = 0; j < 4; ++j) bb[j] = Bs[k][tx * 4 + j];
            for (int i = 0; i < 4; ++i) for (int j = 0; j < 4; ++j) acc[i][j] += a[i] * bb[j];
        }
        __syncthreads();
    }
    for (int i = 0; i < 4; ++i) for (int j = 0; j < 4; ++j) {
        const int row = row0 + ty * 4 + i, n = col0 + tx * 4 + j; if (n >= N) continue;
        const float v = acc[i][j]; const int b = row / UT, u = row % UT;
        if (MODE == 0) {
            if (n < 512) ei.QKRAW[(size_t)row * 1024 + n] = f2bf(v);
            else if (n < 1024) ei.PA[(size_t)row * 1536 + (n - 512)] = f2bf(v);
            else if (n < 1536) ei.PA[(size_t)row * 1536 + 512 + (n - 1024)] = f2bf(v);
            else if (n < 2048) ei.QKRAW[(size_t)row * 1024 + 512 + (n - 1536)] = f2bf(v);
            else if (n < 2560) { const int c = n - 2048; ei.MVT[((size_t)(b * 4 + c / 128) * 128 + c % 128) * UT + u] = f2bf(v); }
            else if (n < 2576) ei.GATES[(size_t)row * 16 + (n - 2560)] = v + ei.gate_b[n - 2560];
            else if (n < 3088) ei.PA[(size_t)row * 1536 + 1024 + (n - 2576)] = f2bf(v);
            else { const int c = n - 3088; ei.NVT[((size_t)(b * 8 + c / 64) * 64 + c % 64) * UT + u] = f2bf(v); }
        } else {
            const bool ctx = u < CTXL; if (ctx && eo.skip_ctx) continue;
            const size_t off = ctx ? ((size_t)b * CTXL + u) * DM + n : ((size_t)b * SEQ + (u - CTXL)) * DM + n;
            const float md = eo.MODl[(size_t)(ctx ? 8 : b) * 6144 + 2 * 1024 + n];
            if (ctx) eo.dc[off] = eo.sc[off] + md * v; else eo.dl[off] = eo.sl[off] + md * v;
        }
    }
}

__device__ __forceinline__ float conv_silu(const bf16* QKRAW, int row, int u, int col, const float* cw, const float* cb) {
    const int lo = u < CTXL ? 0 : CTXL, hi = u < CTXL ? CTXL - 1 : UT - 1;
    float y = cb[col] + cw[1024 + col] * bf2f(QKRAW[(size_t)row * 1024 + col]);
    if (u > lo) y += cw[col] * bf2f(QKRAW[(size_t)(row - 1) * 1024 + col]);
    if (u < hi) y += cw[2048 + col] * bf2f(QKRAW[(size_t)(row + 1) * 1024 + col]);
    return silu_f(y);
}
__global__ void nv_prep(const bf16* QKRAW, const float* cw, const float* cb, bf16* QP, bf16* KP, bf16* KPT) {
    const size_t gid = (size_t)blockIdx.x * 256 + threadIdx.x;
    const int row = (int)(gid >> 10), col = (int)(gid & 1023), b = row / UT, u = row % UT;
    const int c = col & 511, head = c >> 7, d = c & 127;
    float val = conv_silu(QKRAW, row, u, col, cw, cb);
    if (u >= CTXL) {
        const int t = u - CTXL, blk = d >> 6, dd = d & 63, i = dd & 31;
        const float pos = (float)(blk == 0 ? (t >> 6) : (t & 63));
        const float inv = powf(10000.f, -(float)(2 * i) / 64.f);
        const float ang = pos * inv, cs = cosf(ang), sn = sinf(ang);
        const float pv = conv_silu(QKRAW, row, u, dd < 32 ? col + 32 : col - 32, cw, cb);
        val = dd < 32 ? val * cs - pv * sn : pv * sn + val * cs;
    }
    if (col < 512) QP[(size_t)row * 512 + c] = f2bf(val);
    else { val *= 0.08838834764831845f; KP[(size_t)row * 512 + c] = f2bf(val); KPT[((size_t)(b * 4 + head) * 128 + d) * UT + u] = f2bf(val); }
}

__device__ __forceinline__ int u_of(int dir, int j, int s) {
    if (dir == 0) return 128 * j + s;
    return j < 2 ? 255 - (128 * j + s) : UT - 1 - 128 * (j - 2) - s;
}
__global__ void nv_scan(const bf16* KP, const bf16* MVT, const float* GATES, bf16* CST, float* NST, float* MST) {
    const int chain = blockIdx.x, b = chain >> 3, h = (chain >> 1) & 3, dir = chain & 1, tid = threadIdx.x;
    const int dk = tid & 127, dv = blockIdx.y * 2 + (tid >> 7);
    __shared__ float wt[128], lf[128], ig[128], scal[2];
    __shared__ int us[128];
    float C = 0.f, n = 0.f;
    if (tid == 0) scal[1] = 0.f;
    __syncthreads();
    for (int j = 0; j < NCHUNK; ++j) {
        CST[((size_t)(chain * NCHUNK + j) * 128 + dv) * 128 + dk] = f2bf(C);
        if (blockIdx.y == 0 && tid < 128) NST[(size_t)(chain * NCHUNK + j) * 128 + dk] = n;
        if (blockIdx.y == 0 && tid == 0) MST[chain * NCHUNK + j] = scal[1];
        if (tid < 128) { const int u = u_of(dir, j, tid); us[tid] = u; const size_t row = (size_t)b * UT + u;
            lf[tid] = logsig_f(GATES[row * 16 + (2 * dir + 1) * 4 + h]); ig[tid] = GATES[row * 16 + (2 * dir) * 4 + h]; }
        __syncthreads();
        if (tid == 0) {
            float run = 0.f; for (int s = 0; s < 128; ++s) { run += lf[s]; lf[s] = run; }
            const float bend = run; float gmax = -1e30f;
            for (int s = 0; s < 128; ++s) { const float g = bend - lf[s] + ig[s]; ig[s] = g; gmax = fmaxf(gmax, g); }
            const float m = scal[1], mn = fmaxf(bend + m, gmax);
            scal[0] = expf(bend + m - mn); scal[1] = mn;
            for (int s = 0; s < 128; ++s) wt[s] = expf(ig[s] - mn);
        }
        __syncthreads();
        const float wo = scal[0]; float accC = 0.f, accn = 0.f;
        for (int s = 0; s < 128; ++s) { const int u = us[s]; const float kk = wt[s] * bf2f(KP[((size_t)b * UT + u) * 512 + h * 128 + dk]);
            accC += kk * bf2f(MVT[((size_t)(b * 4 + h) * 128 + dv) * UT + u]); accn += kk; }
        C = wo * C + accC; n = wo * n + accn;
        __syncthreads();
    }
}

__global__ void nv_mout(const bf16* QP, const bf16* KP, const bf16* MVT, const float* GATES, const bf16* CST, const float* NST, const float* MST, float* HSUM, int last) {
    const int c = blockIdx.x, bh = blockIdx.y, b = bh >> 2, h = bh & 3, tid = threadIdx.x;
    if (last && c < 2) return;
    extern __shared__ float sm[];
    float* S = sm; float* bb = S + 128 * 129; float* ig = bb + 128; float* den = ig + 128; float* wint = den + 128;
    const int p = tid & 127, half = tid >> 7;
    for (int dir = 0; dir < 2; ++dir) {
        const int j = dir == 0 ? c : (c < 2 ? 1 - c : 35 - c), chain = (b * 4 + h) * 2 + dir;
        if (tid < 128) { const int tau = tid, pp = dir ? 127 - tau : tau; const size_t row = (size_t)b * UT + 128 * c + tau;
            bb[pp] = logsig_f(GATES[row * 16 + (2 * dir + 1) * 4 + h]); ig[pp] = GATES[row * 16 + (2 * dir) * 4 + h]; }
        __syncthreads();
        if (tid == 0) { float run = 0.f; for (int s = 0; s < 128; ++s) { run += bb[s]; bb[s] = run; } }
        __syncthreads();
        const float m = MST[chain * NCHUNK + j];
        const size_t rowp = (size_t)b * UT + 128 * c + (dir ? 127 - p : p);
        const bf16* qrow = QP + rowp * 512 + h * 128;
        for (int p2 = 64 * half; p2 < 64 * half + 64; ++p2) {
            if (p2 > p) continue;
            const bf16* krow = KP + ((size_t)b * UT + 128 * c + (dir ? 127 - p2 : p2)) * 512 + h * 128;
            float dot = 0.f; for (int d = 0; d < 128; ++d) dot += bf2f(qrow[d]) * bf2f(krow[d]);
            S[p * 129 + p2] = dot;
        }
        __syncthreads();
        if (tid < 128) {
            const float inter = bb[p] + m; float mx = inter;
            for (int p2 = 0; p2 <= p; ++p2) mx = fmaxf(mx, bb[p] - bb[p2] + ig[p2]);
            float sum = 0.f;
            for (int p2 = 0; p2 <= p; ++p2) { const float dd = expf(bb[p] - bb[p2] + ig[p2] - mx); const float sv = S[p * 129 + p2] * dd; S[p * 129 + p2] = sv; sum += sv; }
            const float wi = expf(inter - mx);
            float qn = 0.f; const float* nn = NST + (size_t)(chain * NCHUNK + j) * 128;
            for (int d = 0; d < 128; ++d) qn += bf2f(qrow[d]) * nn[d];
            qn = sum + wi * qn;
            den[p] = fmaxf(fabsf(qn), expf(-mx)); wint[p] = wi;
        }
        __syncthreads();
        for (int dv = 64 * half; dv < 64 * half + 64; ++dv) {
            const bf16* vt = MVT + ((size_t)(b * 4 + h) * 128 + dv) * UT + 128 * c;
            float acc = 0.f;
            for (int p2 = 0; p2 <= p; ++p2) acc += S[p * 129 + p2] * bf2f(vt[dir ? 127 - p2 : p2]);
            const bf16* cc = CST + ((size_t)(chain * NCHUNK + j) * 128 + dv) * 128;
            float qc = 0.f; for (int d = 0; d < 128; ++d) qc += bf2f(qrow[d]) * bf2f(cc[d]);
            const float hv = (acc + wint[p] * qc) / den[p];
            float* o = HSUM + rowp * 512 + h * 128 + dv;
            if (dir == 0) *o = hv; else *o += hv;
        }
        __syncthreads();
    }
}

__global__ void nv_mnorm(const float* HSUM, const bf16* PA, const float* mnw, bf16* ACT, int skip_ctx) {
    const int row = blockIdx.x, u = row % UT, h = threadIdx.x >> 6, lane = threadIdx.x & 63;
    if (u < CTXL && skip_ctx) return;
    const float a = HSUM[(size_t)row * 512 + h * 128 + lane], bq = HSUM[(size_t)row * 512 + h * 128 + 64 + lane];
    float ss = a * a + bq * bq; for (int o = 32; o >= 1; o >>= 1) ss += __shfl_xor(ss, o);
    const float rstd = rsqrtf(ss * (1.f / 128.f) + EPS);
    for (int k = 0; k < 2; ++k) { const int col = h * 128 + 64 * k + lane; const float v = (k ? bq : a) * rstd * mnw[col] * sigmoid_f(bf2f(PA[(size_t)row * 1536 + col]));
        ACT[(size_t)row * 1024 + col] = f2bf(v); }
}

__global__ void nv_na(const bf16* PA, const bf16* NVT, const float* rpb, bf16* ACT, int ctxq) {
    const int tq = blockIdx.x, hd = blockIdx.y, b = blockIdx.z, tid = threadIdx.x;
    __shared__ float q[64], sc[384], red[4], o2[2][64];
    __shared__ int uk[384];
    const size_t rowq = (size_t)b * UT + (ctxq ? tq : CTXL + tq);
    if (tid < 64) q[tid] = bf2f(PA[rowq * 1536 + 512 + hd * 64 + tid]) * 0.125f;
    __syncthreads();
    const int nkeys = ctxq ? 256 : 384;
    for (int key = tid; key < nkeys; key += 128) {
        int uu; float bias = 0.f;
        if (!ctxq && key < 128) { const int i = key >> 4, j = key & 15, r = tq >> 6, c = tq & 63;
            const int rs = min(max(r - 4, 0), 56), cs = min(max(c - 8, 0), 48);
            uu = CTXL + (rs + i) * 64 + cs + j; bias = rpb[(hd * 15 + (rs + i - r + 7)) * 31 + (cs + j - c + 15)]; }
        else uu = ctxq ? key : key - 128;
        const bf16* kr = PA + ((size_t)b * UT + uu) * 1536 + 1024 + hd * 64;
        float dot = 0.f; for (int d = 0; d < 64; ++d) dot += q[d] * bf2f(kr[d]);
        sc[key] = dot + bias; uk[key] = uu;
    }
    __syncthreads();
    float mx = -1e30f; for (int key = tid; key < nkeys; key += 128) mx = fmaxf(mx, sc[key]);
    for (int o = 32; o >= 1; o >>= 1) mx = fmaxf(mx, __shfl_xor(mx, o));
    if ((tid & 63) == 0) red[tid >> 6] = mx;
    __syncthreads();
    mx = fmaxf(red[0], red[1]);
    float sum = 0.f; for (int key = tid; key < nkeys; key += 128) { const float e = expf(sc[key] - mx); sc[key] = e; sum += e; }
    for (int o = 32; o >= 1; o >>= 1) sum += __shfl_xor(sum, o);
    __syncthreads();
    if ((tid & 63) == 0) red[2 + (tid >> 6)] = sum;
    __syncthreads();
    sum = red[2] + red[3];
    const int dv = tid & 63, part = tid >> 6; const bf16* vt = NVT + ((size_t)(b * 8 + hd) * 64 + dv) * UT;
    float acc = 0.f; for (int key = part * (nkeys / 2); key < (part + 1) * (nkeys / 2); ++key) acc += sc[key] * bf2f(vt[uk[key]]);
    o2[part][dv] = acc;
    __syncthreads();
    if (tid < 64) ACT[rowq * 1024 + 512 + hd * 64 + tid] = f2bf((o2[0][tid] + o2[1][tid]) / sum);
}

__global__ void nv_slots_off(unsigned* CTL, int* SLOT_TOK, float* SLOT_W, int* TILE_E) {
    __shared__ unsigned off[17];
    if (threadIdx.x == 0) { unsigned o = 0; for (int e = 0; e < 16; ++e) { off[e] = o; CTL[CW_OFF + e] = o; o += (CTL[CW_CNT + e] + 255u) & ~255u; CTL[CW_CUR + e] = 0u; } off[16] = o; CTL[CW_OFF + 16] = o; CTL[CW_NT] = o >> 8; }
    __syncthreads();
    for (int e = 0; e < 16; ++e) {
        const unsigned cnt = CTL[CW_CNT + e];
        for (unsigned i = off[e] + cnt + threadIdx.x; i < off[e + 1]; i += blockDim.x) { SLOT_TOK[i] = 0; SLOT_W[i] = 0.f; }
        for (unsigned t = (off[e] >> 8) + threadIdx.x; t < (off[e + 1] >> 8); t += blockDim.x) TILE_E[t] = e;
    }
}
__global__ void nv_slots_assign(unsigned* CTL, const int* TOK_E, const float* TOK_W, int* TOK_SLOT, int* SLOT_TOK, float* SLOT_W, int skip_ctx) {
    const int row = blockIdx.x * 256 + threadIdx.x; if (row >= MROWS) return;
    if ((row % UT) < CTXL && skip_ctx) return;
    for (int k = 0; k < 2; ++k) { const int e = TOK_E[row * 2 + k]; const unsigned pos = atomicAdd(&CTL[CW_CUR + e], 1u); const int slot = (int)(CTL[CW_OFF + e] + pos);
        SLOT_TOK[slot] = row; SLOT_W[slot] = TOK_W[row * 2 + k]; TOK_SLOT[row * 2 + k] = slot; }
}
__global__ void nv_moe1(const unsigned* CTL, const bf16* ACT, const int* SLOT_TOK, const float* SLOT_W, const int* TILE_E, const float* w1, const float* w3, bf16* ACTM) {
    const int slot = blockIdx.x, tid = threadIdx.x; if ((unsigned)slot >= CTL[CW_OFF + 16]) return;
    const float w = SLOT_W[slot]; if (w == 0.f) return;
    const int e = TILE_E[slot >> 8], tok = SLOT_TOK[slot];
    __shared__ float t[1024];
    for (int k = tid; k < 1024; k += 256) t[k] = bf2f(ACT[(size_t)tok * 1024 + k]);
    __syncthreads();
    const float* a1 = w1 + (size_t)e * 1024 * 512; const float* a3 = w3 + (size_t)e * 1024 * 512;
    for (int cc = 0; cc < 2; ++cc) { const int col = tid + 256 * cc; float g1 = 0.f, g3 = 0.f;
        for (int k = 0; k < 1024; ++k) { g1 += t[k] * a1[(size_t)k * 512 + col]; g3 += t[k] * a3[(size_t)k * 512 + col]; }
        ACTM[(size_t)slot * 512 + col] = f2bf(silu_f(g1) * g3 * w); }
}
__global__ void nv_moe2(const unsigned* CTL, const bf16* ACTM, const float* SLOT_W, const int* TILE_E, const float* w2, bf16* Y) {
    const int slot = blockIdx.x, tid = threadIdx.x; if ((unsigned)slot >= CTL[CW_OFF + 16]) return;
    if (SLOT_W[slot] == 0.f) return;
    const int e = TILE_E[slot >> 8];
    __shared__ float a[512];
    for (int k = tid; k < 512; k += 256) a[k] = bf2f(ACTM[(size_t)slot * 512 + k]);
    __syncthreads();
    const float* ww = w2 + (size_t)e * 512 * 1024;
    for (int cc = 0; cc < 4; ++cc) { const int col = tid + 256 * cc; float acc = 0.f; for (int k = 0; k < 512; ++k) acc += a[k] * ww[(size_t)k * 1024 + col]; Y[(size_t)slot * 1024 + col] = f2bf(acc); }
}
__global__ void nv_combine(float* xl, float* xc, const float* MODl, const int* TOK_SLOT, const bf16* Y, int skip_ctx) {
    const int row = blockIdx.x, b = row / UT, u = row % UT, tid = threadIdx.x; const bool ctx = u < CTXL;
    if (ctx && skip_ctx) return;
    float* xr = ctx ? xc + ((size_t)b * CTXL + u) * DM : xl + ((size_t)b * SEQ + (u - CTXL)) * DM;
    const int s0 = TOK_SLOT[row * 2], s1 = TOK_SLOT[row * 2 + 1]; const float* md = MODl + (size_t)(ctx ? 8 : b) * 6144 + 5 * 1024;
    for (int i = 0; i < 4; ++i) { const int col = tid + 256 * i; xr[col] += md[col] * (bf2f(Y[(size_t)s0 * 1024 + col]) + bf2f(Y[(size_t)s1 * 1024 + col])); }
}
__global__ void nv_final(float* xl, const float* fw) {
    const int row = blockIdx.x, tid = threadIdx.x; __shared__ float red[4];
    float* xr = xl + (size_t)row * DM; float v[4]; float ss = 0.f;
    for (int i = 0; i < 4; ++i) { v[i] = xr[tid + 256 * i]; ss += v[i] * v[i]; }
    ss = block_sum256(ss, red); const float rstd = rsqrtf(ss * (1.f / DM) + EPS);
    for (int i = 0; i < 4; ++i) xr[tid + 256 * i] = v[i] * rstd * fw[tid + 256 * i];
}

extern "C" void kernel_launch(void* const* d_in, const int* in_sizes, int n_in, void* d_out, int out_size, void* d_ws, size_t ws_size, hipStream_t stream) {
    const float* x = (const float*)d_in[0]; const float* c = (const float*)d_in[1]; const float* ctx = (const float*)d_in[2]; const float* c_ctx = (const float*)d_in[3];
    const float* ada_w = (const float*)d_in[4]; const float* ada_b = (const float*)d_in[5]; const float* norm1_w = (const float*)d_in[6]; const float* w_in = (const float*)d_in[7];
    const float* conv_w = (const float*)d_in[8]; const float* conv_b = (const float*)d_in[9]; const float* gate_b = (const float*)d_in[10]; const float* mnorm_w = (const float*)d_in[11];
    const float* rpb = (const float*)d_in[12]; const float* w_out = (const float*)d_in[13]; const float* norm2_w = (const float*)d_in[14]; const float* router_w = (const float*)d_in[15];
    const float* router_b = (const float*)d_in[16]; const float* exp_w1 = (const float*)d_in[17]; const float* exp_w3 = (const float*)d_in[18]; const float* exp_w2 = (const float*)d_in[19];
    const float* final_w = (const float*)d_in[20];
    if (ws_size < WS_END) { fprintf(stderr, "kernel_launch: workspace too small (%zu < %zu)\n", ws_size, (size_t)WS_END); return; }
    unsigned char* ws = (unsigned char*)d_ws; float* out = (float*)d_out;
    unsigned* CTL = (unsigned*)(ws + WS_CTL); float* MOD = (float*)(ws + WS_MOD); float* CTXB = (float*)(ws + WS_CTX);
    float* GATES = (float*)(ws + WS_GATES); bf16* ACT = (bf16*)(ws + WS_ACT); bf16* PA = (bf16*)(ws + WS_PA); bf16* QKRAW = (bf16*)(ws + WS_QKRAW); bf16* CST = (bf16*)(ws + WS_CST);
    bf16* MVT = (bf16*)(ws + WS_MVT); bf16* NVT = (bf16*)(ws + WS_NVT); bf16* QP = (bf16*)(ws + WS_QP); bf16* KP = (bf16*)(ws + WS_KP); bf16* KPT = (bf16*)(ws + WS_KPT);
    float* NST = (float*)(ws + WS_NST); float* MST = (float*)(ws + WS_MST); float* HSUM = (float*)(ws + WS_HSUM); bf16* ACTM = (bf16*)(ws + WS_ACTM); bf16* Y = (bf16*)(ws + WS_Y);
    int* TOK_E = (int*)(ws + WS_ROUTE + RT_TOK_E); float* TOK_W = (float*)(ws + WS_ROUTE + RT_TOK_W); int* TOK_SLOT = (int*)(ws + WS_ROUTE + RT_TOK_SLOT);
    int* SLOT_TOK = (int*)(ws + WS_ROUTE + RT_SLOT_TOK); float* SLOT_W = (float*)(ws + WS_ROUTE + RT_SLOT_W); int* TILE_E = (int*)(ws + WS_ROUTE + RT_TILE_E);
    static bool attr = false;
    if (!attr) { hipFuncSetAttribute((const void*)nv_mout, hipFuncAttributeMaxDynamicSharedMemorySize, 70 * 1024); attr = true; }

    nv_mod<<<dim3(24, 9, 2), 256, 0, stream>>>(c, c_ctx, ada_w, ada_b, MOD);
    for (int l = 0; l < 2; ++l) {
        const bool last = (l == 1);
        const float* MODl = MOD + (size_t)l * 9 * 6144;
        const float* sl = l == 0 ? x : out; const float* scx = l == 0 ? ctx : CTXB;
        hipMemsetAsync(ws + WS_CTL, 0, 65536, stream);
        nv_norm<<<MROWS, 256, 0, stream>>>(sl, scx, norm1_w + l * 1024, MODl, 0, 1, ACT, 0, nullptr, nullptr, nullptr, nullptr, nullptr, 0);
        EpiIn ei{QKRAW, PA, MVT, NVT, GATES, gate_b + l * 16}; EpiOut eo{};
        nv_gemm<0><<<dim3((N_IN + 63) / 64, MROWS / 64), 256, 0, stream>>>(ACT, w_in + (size_t)l * 1024 * N_IN, N_IN, N_IN, 1024, ei, eo);
        nv_prep<<<MROWS * 1024 / 256, 256, 0, stream>>>(QKRAW, conv_w + l * 3072, conv_b + l * 1024, QP, KP, KPT);
        nv_scan<<<dim3(64, 64), 256, 0, stream>>>(KP, MVT, GATES, CST, NST, MST);
        nv_mout<<<dim3(NCHUNK, 32), 256, (128 * 129 + 1024) * 4, stream>>>(QP, KP, MVT, GATES, CST, NST, MST, HSUM, last ? 1 : 0);
        nv_mnorm<<<MROWS, 256, 0, stream>>>(HSUM, PA, mnorm_w + l * 512, ACT, last ? 1 : 0);
        nv_na<<<dim3(SEQ, 8, 8), 128, 0, stream>>>(PA, NVT, rpb + (size_t)l * 8 * 15 * 31, ACT, 0);
        if (!last) nv_na<<<dim3(CTXL, 8, 8), 128, 0, stream>>>(PA, NVT, rpb + (size_t)l * 8 * 15 * 31, ACT, 1);
        EpiOut eo2{sl, scx, out, CTXB, MODl, last ? 1 : 0, 0}; EpiIn ei2{};
        nv_gemm<1><<<dim3(16, MROWS / 64), 256, 0, stream>>>(ACT, w_out + (size_t)l * 1024 * 1024, 1024, 1024, 1024, ei2, eo2);
        nv_norm<<<MROWS, 256, 0, stream>>>(out, CTXB, norm2_w + l * 1024, MODl, 3, 4, ACT, 1, router_w, router_b, TOK_E, TOK_W, CTL + CW_CNT, last ? 1 : 0);
        nv_slots_off<<<1, 256, 0, stream>>>(CTL, SLOT_TOK, SLOT_W, TILE_E);
        nv_slots_assign<<<MROWS / 256, 256, 0, stream>>>(CTL, TOK_E, TOK_W, TOK_SLOT, SLOT_TOK, SLOT_W, last ? 1 : 0);
        nv_moe1<<<MAXSLOTS, 256, 0, stream>>>(CTL, ACT, SLOT_TOK, SLOT_W, TILE_E, exp_w1 + (size_t)l * 16 * 1024 * 512, exp_w3 + (size_t)l * 16 * 1024 * 512, ACTM);
        nv_moe2<<<MAXSLOTS, 256, 0, stream>>>(CTL, ACTM, SLOT_W, TILE_E, exp_w2 + (size_t)l * 16 * 512 * 1024, Y);
        nv_combine<<<MROWS, 256, 0, stream>>>(out, CTXB, MODl, TOK_SLOT, Y, last ? 1 : 0);
    }
    nv_final<<<NB * SEQ, 256, 0, stream>>>(out, final_w);
}
```

```cpp
#include <hip/hip_runtime.h>
#include <cstdio>
#include <cstdint>

typedef unsigned short bf16;
__device__ __forceinline__ float bf2f(bf16 b) { return __uint_as_float(((unsigned)b) << 16); }
__device__ __forceinline__ bf16 f2bf(float f) { unsigned u = __float_as_uint(f); u += 0x7fffu + ((u >> 16) & 1u); return (bf16)(u >> 16); }

constexpr int DM = 1024, NB = 8, SEQ = 4096, CTXL = 256, UT = SEQ + CTXL  ;
constexpr int MROWS = NB * UT;
constexpr int NCHUNK = UT / 128;
constexpr int N_IN = 3600;
constexpr float EPS = 1e-6f;
constexpr int MAXSLOTS = 73728;

constexpr size_t MiB = 1u << 20;
constexpr size_t WS_CTL = 0;
constexpr size_t WS_MOD = 1 * MiB;
constexpr size_t WS_CTX = 2 * MiB;
constexpr size_t WS_WIN = 10 * MiB;
constexpr size_t WS_WOUT = 25 * MiB;
constexpr size_t WS_GATES = 29 * MiB;
constexpr size_t WS_ROUTE = 32 * MiB;
constexpr size_t WS_ACT = 34 * MiB;
constexpr size_t WS_PA = 102 * MiB;
constexpr size_t WS_QKRAW = 204 * MiB;
constexpr size_t WS_CST = 204 * MiB;
constexpr size_t WS_MVT = 272 * MiB;
constexpr size_t WS_NVT = 306 * MiB;
constexpr size_t WS_QP = 340 * MiB;
constexpr size_t WS_KP = 374 * MiB;
constexpr size_t WS_KPT = 408 * MiB;
constexpr size_t WS_NST = 442 * MiB;
constexpr size_t WS_MST = 443 * MiB + 512 * 1024;
constexpr size_t WS_HSUM = 444 * MiB;
constexpr size_t WS_ACTM = 150 * MiB;
constexpr size_t WS_Y = 222 * MiB;
constexpr size_t WS_END = 512 * MiB;
constexpr size_t RT_TOK_E = 0, RT_TOK_W = 300 * 1024, RT_TOK_SLOT = 600 * 1024, RT_SLOT_TOK = 900 * 1024, RT_SLOT_W = 1200 * 1024, RT_TILE_E = 1500 * 1024;
constexpr int CW_CNT = 1024, CW_CUR = 1088, CW_OFF = 1152  , CW_NT = 1216;

__device__ __forceinline__ float silu_f(float v) { return v / (1.f + expf(-v)); }
__device__ __forceinline__ float sigmoid_f(float v) { return 1.f / (1.f + expf(-v)); }
__device__ __forceinline__ float logsig_f(float x) { return fminf(x, 0.f) - log1pf(expf(-fabsf(x))); }

__global__ void nv_mod(const float* c, const float* c_ctx, const float* ada_w, const float* ada_b, float* MOD) {
    const int j = blockIdx.x * 256 + threadIdx.x, r = blockIdx.y, l = blockIdx.z;
    __shared__ float s[1024];
    const float* src = r < 8 ? c + r * 1024 : c_ctx;
    for (int k = threadIdx.x; k < 1024; k += 256) s[k] = silu_f(src[k]);
    __syncthreads();
    const float* w = ada_w + (size_t)l * 1024 * 6144;
    float acc = 0.f;
    for (int k = 0; k < 1024; ++k) acc += s[k] * w[(size_t)k * 6144 + j];
    MOD[((size_t)l * 9 + r) * 6144 + j] = acc + ada_b[l * 6144 + j];
}

__device__ __forceinline__ float block_sum256(float v, float* red) {
    for (int o = 32; o >= 1; o >>= 1) v += __shfl_xor(v, o);
    __syncthreads();
    if ((threadIdx.x & 63) == 0) red[threadIdx.x >> 6] = v;
    __syncthreads();
    return red[0] + red[1] + red[2] + red[3];
}

__global__ void nv_norm(const float* xl, const float* xc, const float* nw, const float* MODl, int sh, int sc, bf16* ACT, int do_router,
                        const float* router_w, const float* router_b, int* TOK_E, float* TOK_W, unsigned* CNT, int skip_ctx) {
    const int row = blockIdx.x, b = row / UT, u = row % UT, tid = threadIdx.x;
    const bool ctx = u < CTXL;
    if (ctx && skip_ctx) return;
    __shared__ float red[4];
    __shared__ float lg[4][16];
    const float* xr = ctx ? xc + ((size_t)b * CTXL + u) * DM : xl + ((size_t)b * SEQ + (u - CTXL)) * DM;
    float v[4]; float ss = 0.f;
    for (int i = 0; i < 4; ++i) { v[i] = xr[tid + 256 * i]; ss += v[i] * v[i]; }
    ss = block_sum256(ss, red);
    const float rstd = rsqrtf(ss * (1.f / DM) + EPS);
    const float* md = MODl + (size_t)(ctx ? 8 : b) * 6144;
    float h[4];
    for (int i = 0; i < 4; ++i) { const int col = tid + 256 * i; h[i] = v[i] * rstd * nw[col] * (1.f + md[sc * 1024 + col]) + md[sh * 1024 + col]; ACT[(size_t)row * DM + col] = f2bf(h[i]); }
    if (!do_router) return;
    float pl[16];
    for (int e = 0; e < 16; ++e) { float a = 0.f; for (int i = 0; i < 4; ++i) a += h[i] * router_w[(tid + 256 * i) * 16 + e]; pl[e] = a; }
    for (int e = 0; e < 16; ++e) { float a = pl[e]; for (int o = 32; o >= 1; o >>= 1) a += __shfl_xor(a, o); if ((tid & 63) == 0) lg[tid >> 6][e] = a; }
    __syncthreads();
    if (tid == 0) {
        float p[16], sel[16], mx = -1e30f, sum = 0.f;
        for (int e = 0; e < 16; ++e) { p[e] = lg[0][e] + lg[1][e] + lg[2][e] + lg[3][e]; mx = fmaxf(mx, p[e]); }
        for (int e = 0; e < 16; ++e) { p[e] = expf(p[e] - mx); sum += p[e]; }
        for (int e = 0; e < 16; ++e) { p[e] /= sum; sel[e] = p[e] + router_b[e]; }
        int best = 0; float bgs = -1e30f;
        for (int g = 0; g < 4; ++g) {
            float m1 = -1e30f, m2 = -1e30f;
            for (int k = 0; k < 4; ++k) { const float s = sel[4 * g + k]; if (s > m1) { m2 = m1; m1 = s; } else if (s > m2) m2 = s; }
            if (m1 + m2 > bgs) { bgs = m1 + m2; best = g; }
        }
        int i0 = 4 * best; for (int k = 1; k < 4; ++k) if (sel[4 * best + k] > sel[i0]) i0 = 4 * best + k;
        int i1 = -1; for (int k = 0; k < 4; ++k) { const int e = 4 * best + k; if (e == i0) continue; if (i1 < 0 || sel[e] > sel[i1]) i1 = e; }
        const float w0 = p[i0], w1 = p[i1], ws = w0 + w1;
        TOK_E[row * 2] = i0; TOK_E[row * 2 + 1] = i1; TOK_W[row * 2] = w0 / ws; TOK_W[row * 2 + 1] = w1 / ws;
        atomicAdd(&CNT[i0], 1u); atomicAdd(&CNT[i1], 1u);
    }
}

struct EpiIn { bf16* QKRAW; bf16* PA; bf16* MVT; bf16* NVT; float* GATES; const float* gate_b; };
struct EpiOut { const float* sl; const float* sc; float* dl; float* dc; const float* MODl; int skip_ctx; int pad; };

template <int MODE> __global__ void nv_gemm(const bf16* A, const float* W, int ldw, int N, int K, EpiIn ei, EpiOut eo) {
    __shared__ float As[16][65], Bs[16][64];
    const int tid = threadIdx.x, tx = tid & 15, ty = tid >> 4, row0 = blockIdx.y * 64, col0 = blockIdx.x * 64;
    float acc[4][4];
    for (int i = 0; i < 4; ++i) for (int j = 0; j < 4; ++j) acc[i][j] = 0.f;
    for (int kt = 0; kt < K; kt += 16) {
        for (int i = 0; i < 4; ++i) { const int idx = tid + 256 * i, m = idx >> 4, k = idx & 15; As[k][m] = bf2f(A[(size_t)(row0 + m) * K + kt + k]); }
        for (int i = 0; i < 4; ++i) { const int idx = tid + 256 * i, k = idx >> 6, n = idx & 63; Bs[k][n] = (col0 + n < N) ? W[(size_t)(kt + k) * ldw + col0 + n] : 0.f; }
        __syncthreads();
        for (int k = 0; k < 16; ++k) {
            float a[4], bb[4];
            for (int i = 0; i < 4; ++i) a[i] = As[k][ty * 4 + i];
            for (int j = 0; j < 4; ++j) bb[j] = Bs[k][tx * 4 + j];
            for (int i = 0; i < 4; ++i) for (int j = 0; j < 4; ++j) acc[i][j] += a[i] * bb[j];
        }
        __syncthreads();
    }
    for (int i = 0; i < 4; ++i) for (int j = 0; j < 4; ++j) {
        const int row = row0 + ty * 4 + i, n = col0 + tx * 4 + j; if (n >= N) continue;
        const float v = acc[i][j]; const int b = row / UT, u = row % UT;
        if (MODE == 0) {
            if (n < 512) ei.QKRAW[(size_t)row * 1024 + n] = f2bf(v);
            else if (n < 1024) ei.PA[(size_t)row * 1536 + (n - 512)] = f2bf(v);
            else if (n < 1536) ei.PA[(size_t)row * 1536 + 512 + (n - 1024)] = f2bf(v);
            else if (n < 2048) ei.QKRAW[(size_t)row * 1024 + 512 + (n - 1536)] = f2bf(v);
            else if (n < 2560) { const int c = n - 2048; ei.MVT[((size_t)(b * 4 + c / 128) * 128 + c % 128) * UT + u] = f2bf(v); }
            else if (n < 2576) ei.GATES[(size_t)row * 16 + (n - 2560)] = v + ei.gate_b[n - 2560];
            else if (n < 3088) ei.PA[(size_t)row * 1536 + 1024 + (n - 2576)] = f2bf(v);
            else { const int c = n - 3088; ei.NVT[((size_t)(b * 8 + c / 64) * 64 + c % 64) * UT + u] = f2bf(v); }
        } else {
            const bool ctx = u < CTXL; if (ctx && eo.skip_ctx) continue;
            const size_t off = ctx ? ((size_t)b * CTXL + u) * DM + n : ((size_t)b * SEQ + (u - CTXL)) * DM + n;
            const float md = eo.MODl[(size_t)(ctx ? 8 : b) * 6144 + 2 * 1024 + n];
            if (ctx) eo.dc[off] = eo.sc[off] + md * v; else eo.dl[off] = eo.sl[off] + md * v;
        }
    }
}

__device__ __forceinline__ float conv_silu(const bf16* QKRAW, int row, int u, int col, const float* cw, const float* cb) {
    const int lo = u < CTXL ? 0 : CTXL, hi = u < CTXL ? CTXL - 1 : UT - 1;
    float y = cb[col] + cw[1024 + col] * bf2f(QKRAW[(size_t)row * 1024 + col]);
    if (u > lo) y += cw[col] * bf2f(QKRAW[(size_t)(row - 1) * 1024 + col]);
    if (u < hi) y += cw[2048 + col] * bf2f(QKRAW[(size_t)(row + 1) * 1024 + col]);
    return silu_f(y);
}
__global__ void nv_prep(const bf16* QKRAW, const float* cw, const float* cb, bf16* QP, bf16* KP, bf16* KPT) {
    const size_t gid = (size_t)blockIdx.x * 256 + threadIdx.x;
    const int row = (int)(gid >> 10), col = (int)(gid & 1023), b = row / UT, u = row % UT;
    const int c = col & 511, head = c >> 7, d = c & 127;
    float val = conv_silu(QKRAW, row, u, col, cw, cb);
    if (u >= CTXL) {
        const int t = u - CTXL, blk = d >> 6, dd = d & 63, i = dd & 31;
        const float pos = (float)(blk == 0 ? (t >> 6) : (t & 63));
        const float inv = powf(10000.f, -(float)(2 * i) / 64.f);
        const float ang = pos * inv, cs = cosf(ang), sn = sinf(ang);
        const float pv = conv_silu(QKRAW, row, u, dd < 32 ? col + 32 : col - 32, cw, cb);
        val = dd < 32 ? val * cs - pv * sn : pv * sn + val * cs;
    }
    if (col < 512) QP[(size_t)row * 512 + c] = f2bf(val);
    else { val *= 0.08838834764831845f; KP[(size_t)row * 512 + c] = f2bf(val); KPT[((size_t)(b * 4 + head) * 128 + d) * UT + u] = f2bf(val); }
}

__device__ __forceinline__ int u_of(int dir, int j, int s) {
    if (dir == 0) return 128 * j + s;
    return j < 2 ? 255 - (128 * j + s) : UT - 1 - 128 * (j - 2) - s;
}
__global__ void nv_scan(const bf16* KP, const bf16* MVT, const float* GATES, bf16* CST, float* NST, float* MST) {
    const int chain = blockIdx.x, b = chain >> 3, h = (chain >> 1) & 3, dir = chain & 1, tid = threadIdx.x;
    const int dk = tid & 127, dv = blockIdx.y * 2 + (tid >> 7);
    __shared__ float wt[128], lf[128], ig[128], scal[2];
    __shared__ int us[128];
    float C = 0.f, n = 0.f;
    if (tid == 0) scal[1] = 0.f;
    __syncthreads();
    for (int j = 0; j < NCHUNK; ++j) {
        CST[((size_t)(chain * NCHUNK + j) * 128 + dv) * 128 + dk] = f2bf(C);
        if (blockIdx.y == 0 && tid < 128) NST[(size_t)(chain * NCHUNK + j) * 128 + dk] = n;
        if (blockIdx.y == 0 && tid == 0) MST[chain * NCHUNK + j] = scal[1];
        if (tid < 128) { const int u = u_of(dir, j, tid); us[tid] = u; const size_t row = (size_t)b * UT + u;
            lf[tid] = logsig_f(GATES[row * 16 + (2 * dir + 1) * 4 + h]); ig[tid] = GATES[row * 16 + (2 * dir) * 4 + h]; }
        __syncthreads();
        if (tid == 0) {
            float run = 0.f; for (int s = 0; s < 128; ++s) { run += lf[s]; lf[s] = run; }
            const float bend = run; float gmax = -1e30f;
            for (int s = 0; s < 128; ++s) { const float g = bend - lf[s] + ig[s]; ig[s] = g; gmax = fmaxf(gmax, g); }
            const float m = scal[1], mn = fmaxf(bend + m, gmax);
            scal[0] = expf(bend + m - mn); scal[1] = mn;
            for (int s = 0; s < 128; ++s) wt[s] = expf(ig[s] - mn);
        }
        __syncthreads();
        const float wo = scal[0]; float accC = 0.f, accn = 0.f;
        for (int s = 0; s < 128; ++s) { const int u = us[s]; const float kk = wt[s] * bf2f(KP[((size_t)b * UT + u) * 512 + h * 128 + dk]);
            accC += kk * bf2f(MVT[((size_t)(b * 4 + h) * 128 + dv) * UT + u]); accn += kk; }
        C = wo * C + accC; n = wo * n + accn;
        __syncthreads();
    }
}

__global__ void nv_mout(const bf16* QP, const bf16* KP, const bf16* MVT, const float* GATES, const bf16* CST, const float* NST, const float* MST, float* HSUM, int last) {
    const int c = blockIdx.x, bh = blockIdx.y, b = bh >> 2, h = bh & 3, tid = threadIdx.x;
    if (last && c < 2) return;
    extern __shared__ float sm[];
    float* S = sm; float* bb = S + 128 * 129; float* ig = bb + 128; float* den = ig + 128; float* wint = den + 128;
    const int p = tid & 127, half = tid >> 7;
    for (int dir = 0; dir < 2; ++dir) {
        const int j = dir == 0 ? c : (c < 2 ? 1 - c : 35 - c), chain = (b * 4 + h) * 2 + dir;
        if (tid < 128) { const int tau = tid, pp = dir ? 127 - tau : tau; const size_t row = (size_t)b * UT + 128 * c + tau;
            bb[pp] = logsig_f(GATES[row * 16 + (2 * dir + 1) * 4 + h]); ig[pp] = GATES[row * 16 + (2 * dir) * 4 + h]; }
        __syncthreads();
        if (tid == 0) { float run = 0.f; for (int s = 0; s < 128; ++s) { run += bb[s]; bb[s] = run; } }
        __syncthreads();
        const float m = MST[chain * NCHUNK + j];
        const size_t rowp = (size_t)b * UT + 128 * c + (dir ? 127 - p : p);
        const bf16* qrow = QP + rowp * 512 + h * 128;
        for (int p2 = 64 * half; p2 < 64 * half + 64; ++p2) {
            if (p2 > p) continue;
            const bf16* krow = KP + ((size_t)b * UT + 128 * c + (dir ? 127 - p2 : p2)) * 512 + h * 128;
            float dot = 0.f; for (int d = 0; d < 128; ++d) dot += bf2f(qrow[d]) * bf2f(krow[d]);
            S[p * 129 + p2] = dot;
        }
        __syncthreads();
        if (tid < 128) {
            const float inter = bb[p] + m; float mx = inter;
            for (int p2 = 0; p2 <= p; ++p2) mx = fmaxf(mx, bb[p] - bb[p2] + ig[p2]);
            float sum = 0.f;
            for (int p2 = 0; p2 <= p; ++p2) { const float dd = expf(bb[p] - bb[p2] + ig[p2] - mx); const float sv = S[p * 129 + p2] * dd; S[p * 129 + p2] = sv; sum += sv; }
            const float wi = expf(inter - mx);
            float qn = 0.f; const float* nn = NST + (size_t)(chain * NCHUNK + j) * 128;
            for (int d = 0; d < 128; ++d) qn += bf2f(qrow[d]) * nn[d];
            qn = sum + wi * qn;
            den[p] = fmaxf(fabsf(qn), expf(-mx)); wint[p] = wi;
        }
        __syncthreads();
        for (int dv = 64 * half; dv < 64 * half + 64; ++dv) {
            const bf16* vt = MVT + ((size_t)(b * 4 + h) * 128 + dv) * UT + 128 * c;
            float acc = 0.f;
            for (int p2 = 0; p2 <= p; ++p2) acc += S[p * 129 + p2] * bf2f(vt[dir ? 127 - p2 : p2]);
            const bf16* cc = CST + ((size_t)(chain * NCHUNK + j) * 128 + dv) * 128;
            float qc = 0.f; for (int d = 0; d < 128; ++d) qc += bf2f(qrow[d]) * bf2f(cc[d]);
            const float hv = (acc + wint[p] * qc) / den[p];
            float* o = HSUM + rowp * 512 + h * 128 + dv;
            if (dir == 0) *o = hv; else *o += hv;
        }
        __syncthreads();
    }
}

__global__ void nv_mnorm(const float* HSUM, const bf16* PA, const float* mnw, bf16* ACT, int skip_ctx) {
    const int row = blockIdx.x, u = row % UT, h = threadIdx.x >> 6, lane = threadIdx.x & 63;
    if (u < CTXL && skip_ctx) return;
    const float a = HSUM[(size_t)row * 512 + h * 128 + lane], bq = HSUM[(size_t)row * 512 + h * 128 + 64 + lane];
    float ss = a * a + bq * bq; for (int o = 32; o >= 1; o >>= 1) ss += __shfl_xor(ss, o);
    const float rstd = rsqrtf(ss * (1.f / 128.f) + EPS);
    for (int k = 0; k < 2; ++k) { const int col = h * 128 + 64 * k + lane; const float v = (k ? bq : a) * rstd * mnw[col] * sigmoid_f(bf2f(PA[(size_t)row * 1536 + col]));
        ACT[(size_t)row * 1024 + col] = f2bf(v); }
}

__global__ void nv_na(const bf16* PA, const bf16* NVT, const float* rpb, bf16* ACT, int ctxq) {
    const int tq = blockIdx.x, hd = blockIdx.y, b = blockIdx.z, tid = threadIdx.x;
    __shared__ float q[64], sc[384], red[4], o2[2][64];
    __shared__ int uk[384];
    const size_t rowq = (size_t)b * UT + (ctxq ? tq : CTXL + tq);
    if (tid < 64) q[tid] = bf2f(PA[rowq * 1536 + 512 + hd * 64 + tid]) * 0.125f;
    __syncthreads();
    const int nkeys = ctxq ? 256 : 384;
    for (int key = tid; key < nkeys; key += 128) {
        int uu; float bias = 0.f;
        if (!ctxq && key < 128) { const int i = key >> 4, j = key & 15, r = tq >> 6, c = tq & 63;
            const int rs = min(max(r - 4, 0), 56), cs = min(max(c - 8, 0), 48);
            uu = CTXL + (rs + i) * 64 + cs + j; bias = rpb[(hd * 15 + (rs + i - r + 7)) * 31 + (cs + j - c + 15)]; }
        else uu = ctxq ? key : key - 128;
        const bf16* kr = PA + ((size_t)b * UT + uu) * 1536 + 1024 + hd * 64;
        float dot = 0.f; for (int d = 0; d < 64; ++d) dot += q[d] * bf2f(kr[d]);
        sc[key] = dot + bias; uk[key] = uu;
    }
    __syncthreads();
    float mx = -1e30f; for (int key = tid; key < nkeys; key += 128) mx = fmaxf(mx, sc[key]);
    for (int o = 32; o >= 1; o >>= 1) mx = fmaxf(mx, __shfl_xor(mx, o));
    if ((tid & 63) == 0) red[tid >> 6] = mx;
    __syncthreads();
    mx = fmaxf(red[0], red[1]);
    float sum = 0.f; for (int key = tid; key < nkeys; key += 128) { const float e = expf(sc[key] - mx); sc[key] = e; sum += e; }
    for (int o = 32; o >= 1; o >>= 1) sum += __shfl_xor(sum, o);
    __syncthreads();
    if ((tid & 63) == 0) red[2 + (tid >> 6)] = sum;
    __syncthreads();
    sum = red[2] + red[3];
    const int dv = tid & 63, part = tid >> 6; const bf16* vt = NVT + ((size_t)(b * 8 + hd) * 64 + dv) * UT;
    float acc = 0.f; for (int key = part * (nkeys / 2); key < (part + 1) * (nkeys / 2); ++key) acc += sc[key] * bf2f(vt[uk[key]]);
    o2[part][dv] = acc;
    __syncthreads();
    if (tid < 64) ACT[rowq * 1024 + 512 + hd * 64 + tid] = f2bf((o2[0][tid] + o2[1][tid]) / sum);
}

__global__ void nv_slots_off(unsigned* CTL, int* SLOT_TOK, float* SLOT_W, int* TILE_E, int lo) {
    __shared__ unsigned off[17];
    if (threadIdx.x == 0) { unsigned o = 0; for (int e = 0; e < 16; ++e) { off[e] = o; CTL[CW_OFF + lo + e] = o; o += (CTL[CW_CNT + lo + e] + 255u) & ~255u; CTL[CW_CUR + lo + e] = 0u; } off[16] = o; CTL[CW_OFF + lo + 16] = o; CTL[CW_NT + lo] = o >> 8; }
    __syncthreads();
    for (int e = 0; e < 16; ++e) {
        const unsigned cnt = CTL[CW_CNT + lo + e];
        for (unsigned i = off[e] + cnt + threadIdx.x; i < off[e + 1]; i += blockDim.x) { SLOT_TOK[i] = 0; SLOT_W[i] = 0.f; }
        for (unsigned t = (off[e] >> 8) + threadIdx.x; t < (off[e + 1] >> 8); t += blockDim.x) TILE_E[t] = e;
    }
}
__global__ void nv_slots_assign(unsigned* CTL, const int* TOK_E, const float* TOK_W, int* TOK_SLOT, int* SLOT_TOK, float* SLOT_W, int skip_ctx, int lo) {
    const int row = blockIdx.x * 256 + threadIdx.x; if (row >= MROWS) return;
    if ((row % UT) < CTXL && skip_ctx) return;
    for (int k = 0; k < 2; ++k) { const int e = TOK_E[row * 2 + k]; const unsigned pos = atomicAdd(&CTL[CW_CUR + lo + e], 1u); const int slot = (int)(CTL[CW_OFF + lo + e] + pos);
        SLOT_TOK[slot] = row; SLOT_W[slot] = TOK_W[row * 2 + k]; TOK_SLOT[row * 2 + k] = slot; }
}
__global__ void nv_moe1(const unsigned* CTL, const bf16* ACT, const int* SLOT_TOK, const float* SLOT_W, const int* TILE_E, const float* w1, const float* w3, bf16* ACTM, int lo) {
    const int slot = blockIdx.x, tid = threadIdx.x; if ((unsigned)slot >= CTL[CW_OFF + lo + 16]) return;
    const float w = SLOT_W[slot]; if (w == 0.f) return;
    const int e = TILE_E[slot >> 8], tok = SLOT_TOK[slot];
    __shared__ float t[1024];
    for (int k = tid; k < 1024; k += 256) t[k] = bf2f(ACT[(size_t)tok * 1024 + k]);
    __syncthreads();
    const float* a1 = w1 + (size_t)e * 1024 * 512; const float* a3 = w3 + (size_t)e * 1024 * 512;
    for (int cc = 0; cc < 2; ++cc) { const int col = tid + 256 * cc; float g1 = 0.f, g3 = 0.f;
        for (int k = 0; k < 1024; ++k) { g1 += t[k] * a1[(size_t)k * 512 + col]; g3 += t[k] * a3[(size_t)k * 512 + col]; }
        ACTM[(size_t)slot * 512 + col] = f2bf(silu_f(g1) * g3); }
}
__global__ void nv_moe2(const unsigned* CTL, const bf16* ACTM, const float* SLOT_W, const int* TILE_E, const float* w2, bf16* Y, int lo) {
    const int slot = blockIdx.x, tid = threadIdx.x; if ((unsigned)slot >= CTL[CW_OFF + lo + 16]) return;
    if (SLOT_W[slot] == 0.f) return;
    const int e = TILE_E[slot >> 8];
    __shared__ float a[512];
    for (int k = tid; k < 512; k += 256) a[k] = bf2f(ACTM[(size_t)slot * 512 + k]);
    __syncthreads();
    const float* ww = w2 + (size_t)e * 512 * 1024;
    for (int cc = 0; cc < 4; ++cc) { const int col = tid + 256 * cc; float acc = 0.f; for (int k = 0; k < 512; ++k) acc += a[k] * ww[(size_t)k * 1024 + col]; Y[(size_t)slot * 1024 + col] = f2bf(acc); }
}
__global__ void nv_combine(float* xl, float* xc, const float* MODl, const int* TOK_SLOT, const float* TOK_W, const bf16* Y, int skip_ctx) {
    const int row = blockIdx.x, b = row / UT, u = row % UT, tid = threadIdx.x; const bool ctx = u < CTXL;
    if (ctx && skip_ctx) return;
    float* xr = ctx ? xc + ((size_t)b * CTXL + u) * DM : xl + ((size_t)b * SEQ + (u - CTXL)) * DM;
    const int s0 = TOK_SLOT[row * 2], s1 = TOK_SLOT[row * 2 + 1]; const float w0 = TOK_W[row * 2], w1 = TOK_W[row * 2 + 1]; const float* md = MODl + (size_t)(ctx ? 8 : b) * 6144 + 5 * 1024;
    for (int i = 0; i < 4; ++i) { const int col = tid + 256 * i; xr[col] += md[col] * (w0 * bf2f(Y[(size_t)s0 * 1024 + col]) + w1 * bf2f(Y[(size_t)s1 * 1024 + col])); }
}
__global__ void nv_final(float* xl, const float* fw) {
    const int row = blockIdx.x, tid = threadIdx.x; __shared__ float red[4];
    float* xr = xl + (size_t)row * DM; float v[4]; float ss = 0.f;
    for (int i = 0; i < 4; ++i) { v[i] = xr[tid + 256 * i]; ss += v[i] * v[i]; }
    ss = block_sum256(ss, red); const float rstd = rsqrtf(ss * (1.f / DM) + EPS);
    for (int i = 0; i < 4; ++i) xr[tid + 256 * i] = v[i] * rstd * fw[tid + 256 * i];
}

#define LAS __attribute__((address_space(3)))
#define GAS __attribute__((address_space(1)))
constexpr int NWAVES = 8, NTHR = 512;
constexpr int RING_BYTES = 131072, SCR_BYTES = 147456, LDSCTL_OFF = SCR_BYTES, MISC_OFF = LDSCTL_OFF + 320, LDS_BYTES = 163840;
constexpr size_t WS_EW13 = 102 * MiB;
constexpr size_t WS_EW2 = 134 * MiB;
constexpr size_t WS_AG = 366 * MiB;
constexpr size_t WS_PARTO = WS_KPT;
constexpr size_t WS_PARTM = 444 * MiB;
constexpr int CW_BAR = 4096;
constexpr int N_BAR_REGIONS = 24;
constexpr int PH_PRO = 0, PH_FINAL = 21, NPHASE = 22;
constexpr int K_NORM1 = 0, K_GEMM_IN = 1, K_PREP = 2, K_SCAN = 3, K_MIX = 4, K_GEMM_OUT = 5, K_NORM2 = 6, K_SLOTS = 7, K_MOE1 = 8, K_MOE2 = 9;

typedef float f32x4 __attribute__((ext_vector_type(4)));
typedef float f32x2 __attribute__((ext_vector_type(2)));
typedef unsigned u32x4 __attribute__((ext_vector_type(4)));
typedef unsigned u32x2 __attribute__((ext_vector_type(2)));
typedef short bf16x8 __attribute__((ext_vector_type(8)));
#define LDS_WAIT() asm volatile("s_waitcnt lgkmcnt(0)" ::: "memory")
#define VM_WAIT() asm volatile("s_waitcnt vmcnt(0)" ::: "memory")
__device__ __forceinline__ unsigned cvt_pk_bf16(float lo, float hi) { unsigned r; asm volatile("v_cvt_pk_bf16_f32 %0, %1, %2" : "=v"(r) : "v"(lo), "v"(hi)); return r; }
__device__ __forceinline__ unsigned ld_u32(const unsigned* p) { return __hip_atomic_load(p, __ATOMIC_RELAXED, __HIP_MEMORY_SCOPE_AGENT); }
__device__ __forceinline__ int ld_i32(const int* p) { return __hip_atomic_load(p, __ATOMIC_RELAXED, __HIP_MEMORY_SCOPE_AGENT); }
__device__ __forceinline__ float ld_f32(const float* p) { return __uint_as_float(__hip_atomic_load((const unsigned*)p, __ATOMIC_RELAXED, __HIP_MEMORY_SCOPE_AGENT)); }
__device__ __forceinline__ int lane_id() { int l; asm volatile("v_mbcnt_lo_u32_b32 %0, -1, 0\n\tv_mbcnt_hi_u32_b32 %0, -1, %0" : "=v"(l)); return l; }
__device__ __forceinline__ float wave_sum(float v) {
#pragma unroll
    for (int o = 1; o < 64; o <<= 1) v += __shfl_xor(v, o);
    return v;
}
__device__ __forceinline__ float fast_silu(float v) { return v * __builtin_amdgcn_rcpf(1.f + __expf(-v)); }

#define XB_TMO      128
#define XB_XCNT(j)  (256  + 64 * (j))
#define XB_XSUB(j)  (1280 + 64 * (j))
#define XB_XGEN(j)  (2304 + 64 * (j))
#define XB_TOP      3328
#define XB_TOPGEN   3392
#define XCD_BAR_WORDS 3456
#define XB_SPIN_CAP (1u << 18)
__device__ __forceinline__ unsigned xb_ld(unsigned* p)              { return __hip_atomic_load(p, __ATOMIC_RELAXED, __HIP_MEMORY_SCOPE_AGENT); }
__device__ __forceinline__ unsigned xb_add(unsigned* p, unsigned v) { return __hip_atomic_fetch_add(p, v, __ATOMIC_RELAXED, __HIP_MEMORY_SCOPE_AGENT); }
__device__ __forceinline__ unsigned xb_xcc_id() { return (unsigned)__builtin_amdgcn_s_getreg((3 << 11) | 20) & 0xFu; }
#define XB_SPIN(cond, bar) do { unsigned _sp = 0; while (cond) { __builtin_amdgcn_s_sleep(1); \
    if ((++_sp & 255u) == 0u) { if (xb_ld(&(bar)[XB_TMO])) break; if (_sp > XB_SPIN_CAP) { atomicAdd(&(bar)[XB_TMO], 1u); break; } } } } while (0)
struct XcdBarrier { unsigned* bar; unsigned x; volatile LAS unsigned* st; };
__device__ __forceinline__ XcdBarrier xcd_barrier_post(unsigned* bar, volatile LAS unsigned* st, bool leader) {
    XcdBarrier b; b.bar = bar; b.x = xb_xcc_id(); b.st = st;
    if (leader) (void)xb_add(&bar[XB_XCNT(b.x)], 1u);
    return b;
}
__device__ __forceinline__ void xcd_barrier_complete(unsigned* bar, unsigned x, unsigned& nloc, unsigned& nx) {
    const unsigned G = gridDim.x * gridDim.y * gridDim.z;
    unsigned sum, cnt, mine, sp = 0u;
    for (;;) {
        sum = 0u; cnt = 0u;
#pragma unroll
        for (unsigned j = 0; j < 16; ++j) { const unsigned c = xb_ld(&bar[XB_XCNT(j)]); sum += c; cnt += (c > 0u) ? 1u : 0u; }
        mine = xb_ld(&bar[XB_XCNT(x)]);
        if (sum == G) break;
        __builtin_amdgcn_s_sleep(1);
        if ((++sp & 255u) == 0u) { if (xb_ld(&bar[XB_TMO])) break; if (sp > XB_SPIN_CAP) { atomicAdd(&bar[XB_TMO], 1u); break; } }
    }
    nloc = mine > 0u ? mine : 1u; nx = cnt > 0u ? cnt : 1u;
}
__device__ __forceinline__ void xcd_barrier(const XcdBarrier& b, bool leader) {
    asm volatile("s_waitcnt vmcnt(0)" ::: "memory");
    __syncthreads();
    if (leader) {
        unsigned* bar = b.bar;
        __builtin_amdgcn_s_waitcnt(0);
        unsigned nloc = b.st[0], nx = b.st[1];
        if (nloc == 0u) { xcd_barrier_complete(bar, b.x, nloc, nx); b.st[0] = nloc; b.st[1] = nx; }
        const unsigned old = xb_add(&bar[XB_XSUB(b.x)], 1u);
        const unsigned gen = old / nloc;
        if (old + 1u == (gen + 1u) * nloc) {
            __builtin_amdgcn_fence(__ATOMIC_RELEASE, "agent");
            asm volatile("s_waitcnt vmcnt(0)" ::: "memory");
            const unsigned og = xb_add(&bar[XB_TOP], 1u);
            const unsigned tg = og / nx;
            if (og + 1u == (tg + 1u) * nx) xb_add(&bar[XB_TOPGEN], 1u);
            else XB_SPIN(xb_ld(&bar[XB_TOPGEN]) == tg, bar);
            __builtin_amdgcn_fence(__ATOMIC_ACQUIRE, "agent");
            xb_add(&bar[XB_XGEN(b.x)], 1u);
            asm volatile("s_waitcnt vmcnt(0)" ::: "memory");
        } else {
            XB_SPIN(xb_ld(&bar[XB_XGEN(b.x)]) == gen, bar);
            __builtin_amdgcn_fence(__ATOMIC_ACQUIRE, "agent");
            asm volatile("s_waitcnt vmcnt(0)" ::: "memory");
        }
    }
    __syncthreads();
}

namespace pg8 {
constexpr int BM = 256, BK = 64, HALF = 128, HTB = HALF * BK * 2, STAGE_BYTES = 8 * HTB, NXCD = 8, WGM = 8;
__host__ __device__ __forceinline__ int lds_byte(int r, int c) { const int st = (r >> 4) * 2 + (c >> 5), rr = r & 15, cc = c & 31, ob = rr * 64 + cc * 2; return st * 1024 + (ob ^ (((ob >> 9) & 1) << 5)); }
__host__ __device__ __forceinline__ void stage_rc(int b, int& R, int& C) { const int st = b / 1024, sb = b % 1024, swz = sb ^ (((sb >> 9) & 1) << 5); R = (st >> 1) * 16 + swz / 64; C = (st & 1) * 32 + (swz % 64) / 2; }
__host__ __device__ __forceinline__ int perm32(int rho) { const int n = rho >> 4, i = rho & 15; return 8 * (i >> 2) + 4 * n + (i & 3); }
struct Unit { int pm, pn; const char* A; const char* B; };
struct GridOrder {
    int nM, nN, nwg, G, c;
    __device__ void init(int nM_, int nN_, int G_, int c_) { nM = nM_; nN = nN_; nwg = nM * nN; G = G_; c = c_; }
    __device__ bool map(int i, int& pm, int& pn) const {
        const long L = (long)i * G + c; if (L >= nwg) return false;
        int wgid = (int)L; { const int q = nwg / NXCD, r = nwg % NXCD, xcd = wgid % NXCD, off = wgid / NXCD; wgid = (xcd < r ? xcd * (q + 1) : r * (q + 1) + (xcd - r) * q) + off; }
        const int nig = WGM * nN, gid = wgid / nig, fm = gid * WGM, gsz = (nM - fm) < WGM ? (nM - fm) : WGM;
        pm = fm + ((wgid % nig) % gsz); pn = (wgid % nig) / gsz; return true;
    }
};
template <class Epi, class Sched, bool ALIGN_EPI = true, bool SP2 = true>
__device__ __forceinline__ void gemm_phase(LAS unsigned char* lds, const int K, const Sched& S, const Epi& E, const int wave_) {
    int tid_ = wave_ * 64 + lane_id(); asm volatile("" : "+v"(tid_));
    const int tid = tid_, wid = __builtin_amdgcn_readfirstlane(tid >> 6), lane = tid & 63, wr = wid >> 2, wc = wid & 3, fr = lane & 15, fq = lane >> 4;
    const int nt = K / BK;
    unsigned voffA[2], voffB[2];
#pragma unroll
    for (int i = 0; i < 2; ++i) { int R, C; stage_rc(tid * 16 + i * 8192, R, C); const int Rb = Epi::PERM ? ((R & ~31) + perm32(R & 31)) : R;
        voffA[i] = (unsigned)(R * K + C) * 2u; voffB[i] = (unsigned)(Rb * K + C) * 2u; }
    const size_t kstep = (size_t)(BK * 2);
    const size_t hstep = (size_t)HALF * K * 2;
    const unsigned ldsw = (unsigned)wid * 1024u;
    const int aoff = lds_byte(wr * 64 + fr, fq * 8), boff = lds_byte(wc * 32 + fr, fq * 8);
#define PG8_SA(b, h) (((b) * 2 + (h)) * HTB)
#define PG8_SB(b, h) ((4 + (b) * 2 + (h)) * HTB)
#define PG8_STAGE(bufoff, gbase, voff) do { _Pragma("unroll") for (int _i = 0; _i < 2; ++_i) \
        __builtin_amdgcn_global_load_lds((const unsigned*)((const char*)(gbase) + (voff)[_i]), (LAS unsigned*)(lds + (bufoff) + ldsw + _i * 8192), 16, 0, 0); } while (0)
#define PG8_LDA(dst, b, h) do { _Pragma("unroll") for (int m = 0; m < 4; ++m) _Pragma("unroll") for (int k = 0; k < 2; ++k) dst[m][k] = *(const LAS bf16x8*)(lds + PG8_SA(b, h) + aoff + m * 2048 + k * 1024); } while (0)
#define PG8_LDB(dst, b, h) do { _Pragma("unroll") for (int n = 0; n < 2; ++n) _Pragma("unroll") for (int k = 0; k < 2; ++k) dst[n][k] = *(const LAS bf16x8*)(lds + PG8_SB(b, h) + boff + n * 2048 + k * 1024); } while (0)
#define PG8_MMA(ai, bj, At, Bt) do { __builtin_amdgcn_s_setprio(1); _Pragma("unroll") for (int m = 0; m < 4; ++m) _Pragma("unroll") for (int n = 0; n < 2; ++n) _Pragma("unroll") for (int k = 0; k < 2; ++k) \
        acc[ai][bj][m][n] = __builtin_amdgcn_mfma_f32_16x16x32_bf16(Bt[n][k], At[m][k], acc[ai][bj][m][n], 0, 0, 0); __builtin_amdgcn_s_setprio(0); } while (0)
#define PG8_WAIT_V(n) asm volatile("s_waitcnt vmcnt(" #n ")" ::: "memory")
#define PG8_WAIT_L(n) asm volatile("s_waitcnt lgkmcnt(" #n ")" ::: "memory")
#define PG8_BAR __builtin_amdgcn_s_barrier()
#define PG8_SCHED __builtin_amdgcn_sched_barrier(0)
    Unit cur, nxt; int ui = 0;
    if (!S.next(0, cur)) return;
    f32x4 acc[2][2][4][2];
#pragma unroll
    for (int a = 0; a < 2; ++a)
#pragma unroll
        for (int b = 0; b < 2; ++b)
#pragma unroll
            for (int m = 0; m < 4; ++m)
#pragma unroll
                for (int n = 0; n < 2; ++n) acc[a][b][m][n] = (f32x4){0.f, 0.f, 0.f, 0.f};
    bf16x8 At[4][2], B0[2][2], B1[2][2];
    const char* cA = cur.A; const char* cB = cur.B;
    if constexpr (SP2) {
        PG8_STAGE(PG8_SB(0, 0), cB, voffB); PG8_STAGE(PG8_SB(0, 1), cB + hstep, voffB); PG8_STAGE(PG8_SA(0, 0), cA, voffA); PG8_STAGE(PG8_SA(0, 1), cA + hstep, voffA);
        if (wr == 1) PG8_BAR;
        PG8_WAIT_V(2); PG8_BAR;
        PG8_STAGE(PG8_SB(1, 0), cB + kstep, voffB); PG8_STAGE(PG8_SA(1, 0), cA + kstep, voffA); PG8_STAGE(PG8_SB(1, 1), cB + hstep + kstep, voffB);
        PG8_WAIT_V(6); PG8_BAR;
    } else {
        PG8_STAGE(PG8_SB(0, 0), cB, voffB); PG8_STAGE(PG8_SA(0, 0), cA, voffA); PG8_STAGE(PG8_SB(0, 1), cB + hstep, voffB); PG8_STAGE(PG8_SA(0, 1), cA + hstep, voffA);
        if (wr == 1) PG8_BAR;
        PG8_WAIT_V(4); PG8_BAR;
        PG8_STAGE(PG8_SB(1, 0), cB + kstep, voffB); PG8_STAGE(PG8_SA(1, 0), cA + kstep, voffA); PG8_STAGE(PG8_SB(1, 1), cB + hstep + kstep, voffB);
        PG8_WAIT_V(6); PG8_BAR;
    }
    for (;;) {
        const bool has_next = S.next(ui + 1, nxt);
        const char* nA = has_next ? nxt.A : cA; const char* nB = has_next ? nxt.B : cB;
        for (int t = 0; t < nt; t += 2) {
            const bool last = (t == nt - 2);
            const char* a1 = cA + (size_t)(t + 1) * kstep;
            const char* a2 = last ? nA : cA + (size_t)(t + 2) * kstep; const char* b2 = last ? nB : cB + (size_t)(t + 2) * kstep;
            const char* a3 = a2 + kstep; const char* b3 = b2 + kstep;
            if constexpr (SP2) {
            PG8_LDB(B0, 0, 0); PG8_LDB(B1, 0, 1); PG8_SCHED; PG8_LDA(At, 0, 0); PG8_STAGE(PG8_SA(1, 1), a1 + hstep, voffA);
            PG8_WAIT_V(8); PG8_WAIT_L(0); PG8_BAR; PG8_MMA(0, 0, At, B0); PG8_MMA(0, 1, At, B1); PG8_BAR; PG8_SCHED;
            PG8_LDA(At, 0, 1); PG8_STAGE(PG8_SB(0, 0), b2, voffB); PG8_STAGE(PG8_SB(0, 1), b2 + hstep, voffB); PG8_STAGE(PG8_SA(0, 0), a2, voffA);
            PG8_WAIT_V(8); PG8_WAIT_L(0); PG8_BAR; PG8_MMA(1, 0, At, B0); PG8_MMA(1, 1, At, B1); PG8_BAR; PG8_SCHED;
            PG8_LDB(B0, 1, 0); PG8_LDB(B1, 1, 1); PG8_SCHED; PG8_LDA(At, 1, 0); PG8_STAGE(PG8_SA(0, 1), a2 + hstep, voffA);
            PG8_WAIT_V(8); PG8_WAIT_L(0); PG8_BAR; PG8_MMA(0, 0, At, B0); PG8_MMA(0, 1, At, B1); PG8_BAR; PG8_SCHED;
            PG8_LDA(At, 1, 1); PG8_STAGE(PG8_SB(1, 0), b3, voffB); PG8_STAGE(PG8_SB(1, 1), b3 + hstep, voffB); PG8_STAGE(PG8_SA(1, 0), a3, voffA);
            PG8_WAIT_V(8); PG8_WAIT_L(0); PG8_BAR; PG8_MMA(1, 0, At, B0); PG8_MMA(1, 1, At, B1); PG8_BAR; PG8_SCHED;
            } else {
            PG8_LDB(B0, 0, 0); PG8_SCHED; PG8_LDA(At, 0, 0); PG8_STAGE(PG8_SA(1, 1), a1 + hstep, voffA);
            PG8_WAIT_L(8); PG8_BAR; PG8_WAIT_L(0); PG8_MMA(0, 0, At, B0); PG8_BAR; PG8_SCHED;
            PG8_LDB(B1, 0, 1); PG8_STAGE(PG8_SB(0, 0), b2, voffB);
            PG8_BAR; PG8_WAIT_L(0); PG8_MMA(0, 1, At, B1); PG8_BAR;
            PG8_LDA(At, 0, 1); PG8_STAGE(PG8_SA(0, 0), a2, voffA);
            PG8_BAR; PG8_WAIT_L(0); PG8_MMA(1, 0, At, B0); PG8_BAR; PG8_SCHED;
            PG8_STAGE(PG8_SB(0, 1), b2 + hstep, voffB);
            PG8_WAIT_V(6); PG8_BAR; PG8_MMA(1, 1, At, B1); PG8_BAR;
            PG8_LDB(B0, 1, 0); PG8_SCHED; PG8_LDA(At, 1, 0); PG8_STAGE(PG8_SA(0, 1), a2 + hstep, voffA);
            PG8_WAIT_L(8); PG8_BAR; PG8_WAIT_L(0); PG8_MMA(0, 0, At, B0); PG8_BAR; PG8_SCHED;
            PG8_LDB(B1, 1, 1); PG8_STAGE(PG8_SB(1, 0), b3, voffB);
            PG8_BAR; PG8_WAIT_L(0); PG8_MMA(0, 1, At, B1); PG8_BAR;
            PG8_LDA(At, 1, 1); PG8_STAGE(PG8_SA(1, 0), a3, voffA);
            PG8_BAR; PG8_WAIT_L(0); PG8_MMA(1, 0, At, B0); PG8_BAR; PG8_SCHED;
            PG8_STAGE(PG8_SB(1, 1), b3 + hstep, voffB);
            PG8_WAIT_V(6); PG8_BAR; PG8_MMA(1, 1, At, B1); PG8_BAR;
            }
        }
        if constexpr (ALIGN_EPI) { if (wr == 0) PG8_BAR; }
        E(acc, cur, wr, wc, fr, fq);
        if (!has_next) break;
#pragma unroll
        for (int a = 0; a < 2; ++a)
#pragma unroll
            for (int b = 0; b < 2; ++b)
#pragma unroll
                for (int m = 0; m < 4; ++m)
#pragma unroll
                    for (int n = 0; n < 2; ++n) acc[a][b][m][n] = (f32x4){0.f, 0.f, 0.f, 0.f};
        cur = nxt; cA = nA; cB = nB; ++ui;
        if constexpr (ALIGN_EPI) { if (wr == 1) PG8_BAR; }
    }
    PG8_WAIT_V(0);
    if constexpr (!ALIGN_EPI) { if (wr == 0) PG8_BAR; }
    PG8_BAR;
#undef PG8_SA
#undef PG8_SB
#undef PG8_STAGE
#undef PG8_LDA
#undef PG8_LDB
#undef PG8_MMA
#undef PG8_WAIT_V
#undef PG8_WAIT_L
#undef PG8_BAR
#undef PG8_SCHED
}
}

struct SchedDense : pg8::GridOrder {
    const char* A; const char* B; size_t tstep;
    __device__ bool next(int i, pg8::Unit& u) const { int pm, pn; if (!map(i, pm, pn)) return false; u.pm = pm; u.pn = pn; u.A = A + (size_t)pm * tstep; u.B = B + (size_t)pn * tstep; return true; }
};
struct SchedLatent : pg8::GridOrder {
    const char* A; const char* B; size_t tstep; int lat;
    __device__ bool next(int i, pg8::Unit& u) const { int pm, pn; if (!map(i, pm, pn)) return false; if (lat) pm = pm + (pm >> 4) + 1; u.pm = pm; u.pn = pn; u.A = A + (size_t)pm * tstep; u.B = B + (size_t)pn * tstep; return true; }
};
struct SchedMoe : pg8::GridOrder {
    const char* A; const char* B; size_t tstep; const int* TILE_E;
    __device__ bool next(int i, pg8::Unit& u) const { int pm, pn; if (!map(i, pm, pn)) return false; const int e = __builtin_amdgcn_readfirstlane(ld_i32(TILE_E + pm)); u.pm = pm; u.pn = pn;
        u.A = A + (size_t)pm * tstep; u.B = B + ((size_t)e * 4 + pn) * tstep; return true; }
};

struct EpiInP {
    static constexpr bool PERM = true;
    bf16* QKRAW; bf16* PA; bf16* MVT; bf16* NVT; float* GATES; const float* gate_b;
    __device__ __forceinline__ void operator()(const f32x4 (&acc)[2][2][4][2], const pg8::Unit& u, int wr, int wc, int fr, int fq) const {
        const int pn = u.pn;
        if (pn < 10) {
            bf16* base; int ldc, colt; if (pn < 4) { base = QKRAW; ldc = 1024; colt = pn * 256; } else { base = PA; ldc = 1536; colt = (pn - 4) * 256; }
            const int row0 = u.pm * 256 + wr * 64 + fr, col0 = colt + wc * 32 + 8 * fq;
#pragma unroll
            for (int ai = 0; ai < 2; ++ai)
#pragma unroll
                for (int m = 0; m < 4; ++m) { bf16* rowp = base + (size_t)(row0 + ai * 128 + m * 16) * ldc + col0;
#pragma unroll
                    for (int bj = 0; bj < 2; ++bj) { const f32x4 v0 = acc[ai][bj][m][0], v1 = acc[ai][bj][m][1];
                        u32x4 w; w.x = cvt_pk_bf16(v0[0], v0[1]); w.y = cvt_pk_bf16(v0[2], v0[3]); w.z = cvt_pk_bf16(v1[0], v1[1]); w.w = cvt_pk_bf16(v1[2], v1[3]);
                        *(u32x4*)(rowp + bj * 128) = w; } }
        } else if (pn < 14) {
            const int b = u.pm / 17, ub = (u.pm % 17) * 256 + wr * 64 + fr;
#pragma unroll
            for (int bj = 0; bj < 2; ++bj)
#pragma unroll
                for (int n = 0; n < 2; ++n)
#pragma unroll
                    for (int j = 0; j < 4; ++j) {
                        bf16* dst;
                        if (pn < 12) { const int head = (pn - 10) * 2 + bj, dv = wc * 32 + fq * 8 + n * 4 + j; dst = MVT + ((size_t)(b * 4 + head) * 128 + dv) * UT; }
                        else { const int head = (pn - 12) * 4 + bj * 2 + (wc >> 1), dv = (wc & 1) * 32 + fq * 8 + n * 4 + j; dst = NVT + ((size_t)(b * 8 + head) * 64 + dv) * UT; }
#pragma unroll
                        for (int ai = 0; ai < 2; ++ai)
#pragma unroll
                            for (int m = 0; m < 4; ++m) dst[ub + ai * 128 + m * 16] = f2bf(acc[ai][bj][m][n][j]);
                    }
        } else {
            if (wc == 0 && fq < 2) {
                const int row0 = u.pm * 256 + wr * 64 + fr;
#pragma unroll
                for (int n = 0; n < 2; ++n) { const f32x4 gb = *(const f32x4*)(gate_b + fq * 8 + n * 4);
#pragma unroll
                    for (int ai = 0; ai < 2; ++ai)
#pragma unroll
                        for (int m = 0; m < 4; ++m) *(f32x4*)(GATES + (size_t)(row0 + ai * 128 + m * 16) * 16 + fq * 8 + n * 4) = acc[ai][0][m][n] + gb; }
            }
        }
    }
};
struct EpiOutP {
    static constexpr bool PERM = false;
    const float* sl; const float* sc; float* dl; float* dc; const float* MODl;
    __device__ __forceinline__ void operator()(const f32x4 (&acc)[2][2][4][2], const pg8::Unit& u, int wr, int wc, int fr, int fq) const {
        const int b = u.pm / 17, pu = u.pm % 17; const bool ctx = (pu == 0);
        const size_t rbase = ctx ? (size_t)b * CTXL : (size_t)b * SEQ + (size_t)(pu - 1) * 256;
        const float* src = (ctx ? sc : sl) + rbase * DM; float* dst = (ctx ? dc : dl) + rbase * DM;
        const float* md = MODl + (size_t)(ctx ? 8 : b) * 6144 + 2048;
        const int col0 = u.pn * 256 + wc * 32 + 4 * fq, r0 = wr * 64 + fr;
#pragma unroll
        for (int bj = 0; bj < 2; ++bj)
#pragma unroll
            for (int n = 0; n < 2; ++n) { const f32x4 mv = *(const f32x4*)(md + col0 + bj * 128 + n * 16);
#pragma unroll
                for (int ai = 0; ai < 2; ++ai) {
#pragma unroll
                    for (int m = 0; m < 4; ++m) { const size_t off = (size_t)(r0 + ai * 128 + m * 16) * DM + col0 + bj * 128 + n * 16;
                        const f32x4 bs = *(const f32x4*)(src + off); *(f32x4*)(dst + off) = bs + mv * acc[ai][bj][m][n]; }
                    asm volatile("" ::: "memory"); } }
    }
};
struct EpiMoe1 {
    static constexpr bool PERM = true;
    bf16* ACTM;
    __device__ __forceinline__ void operator()(const f32x4 (&acc)[2][2][4][2], const pg8::Unit& u, int wr, int wc, int fr, int fq) const {
        const int row0 = u.pm * 256 + wr * 64 + fr;
#pragma unroll
        for (int ai = 0; ai < 2; ++ai)
#pragma unroll
            for (int m = 0; m < 4; ++m) { bf16* rowp = ACTM + (size_t)(row0 + ai * 128 + m * 16) * 512;
#pragma unroll
                for (int bj = 0; bj < 2; ++bj) { const int j0 = (u.pn * 256 + bj * 128 + wc * 32 + fq * 8) >> 1; const f32x4 g1 = acc[ai][bj][m][0], g3 = acc[ai][bj][m][1];
                    u32x2 w; w.x = cvt_pk_bf16(fast_silu(g1[0]) * g3[0], fast_silu(g1[1]) * g3[1]); w.y = cvt_pk_bf16(fast_silu(g1[2]) * g3[2], fast_silu(g1[3]) * g3[3]);
                    *(u32x2*)(rowp + j0) = w; } }
    }
};
struct EpiMoe2 {
    static constexpr bool PERM = true;
    bf16* Y;
    __device__ __forceinline__ void operator()(const f32x4 (&acc)[2][2][4][2], const pg8::Unit& u, int wr, int wc, int fr, int fq) const {
        const int row0 = u.pm * 256 + wr * 64 + fr, col0 = u.pn * 256 + wc * 32 + 8 * fq;
#pragma unroll
        for (int ai = 0; ai < 2; ++ai)
#pragma unroll
            for (int m = 0; m < 4; ++m) { bf16* rowp = Y + (size_t)(row0 + ai * 128 + m * 16) * 1024 + col0;
#pragma unroll
                for (int bj = 0; bj < 2; ++bj) { const f32x4 v0 = acc[ai][bj][m][0], v1 = acc[ai][bj][m][1];
                    u32x4 w; w.x = cvt_pk_bf16(v0[0], v0[1]); w.y = cvt_pk_bf16(v0[2], v0[3]); w.z = cvt_pk_bf16(v1[0], v1[1]); w.w = cvt_pk_bf16(v1[2], v1[3]);
                    *(u32x4*)(rowp + bj * 128) = w; } }
    }
};

struct Args { const float* in[21]; float* out; unsigned char* ws; int ph_lo, ph_hi, bar_region, mixflags; };
typedef const Args __attribute__((address_space(4)))* KargP;
__device__ __forceinline__ KargP kargs() { KargP p = (KargP)__builtin_amdgcn_kernarg_segment_ptr(); asm volatile("" : "+s"(p)); return p; }
struct Ctx { LAS unsigned char* lds; int wave, G, gw, ngw; };

__device__ __forceinline__ void conv_item(const float* sp, float msk, size_t ld, bf16* dst, int K, int n0, int k0, LAS float* scr, int lane) {
#pragma unroll 8
    for (int i = 0; i < 32; ++i) { const int kk = 2 * i + (lane >> 5); scr[kk * 33 + (lane & 31)] = sp[(size_t)(k0 + kk) * ld] * msk; }
    LDS_WAIT(); asm volatile("" ::: "memory");
    const int c = lane & 7;
#pragma unroll
    for (int j = 0; j < 4; ++j) { const int n = (lane >> 3) + 8 * j; const LAS float* s = scr + (8 * c) * 33 + n;
        u32x4 o; o.x = cvt_pk_bf16(s[0 * 33], s[1 * 33]); o.y = cvt_pk_bf16(s[2 * 33], s[3 * 33]); o.z = cvt_pk_bf16(s[4 * 33], s[5 * 33]); o.w = cvt_pk_bf16(s[6 * 33], s[7 * 33]);
        *(u32x4*)(dst + (size_t)(n0 + n) * K + k0 + 8 * c) = o; }
    LDS_WAIT(); asm volatile("" ::: "memory");
}
__device__ __forceinline__ int win_src(int n) {
    if (n < 512) return n;
    if (n < 1024) return 1536 + (n - 512);
    if (n < 1536) return 512 + (n - 1024);
    if (n < 2048) return 1024 + (n - 1536);
    if (n < 2560) return 2576 + (n - 2048);
    if (n < 3072) return 2048 + (n - 2560);
    if (n < 3584) return 3088 + (n - 3072);
    if (n < 3600) return 2560 + (n - 3584);
    return -1;
}
__device__ __forceinline__ void phase_prologue(const Ctx& X) {
    KargP ka = kargs(); unsigned char* const ws = ka->ws; (void)ka; (void)ws;
    int tid_ = X.wave * 64 + lane_id(); asm volatile("" : "+v"(tid_)); const int TID = tid_, LANE = tid_ & 63;
    LAS float* s = (LAS float*)X.lds;
    LAS float* red = s + 9 * 1024;
    for (int i = TID; i < 9 * 1024; i += NTHR) { const int r = i >> 10, k = i & 1023; const float v = r < 8 ? ka->in[1][r * 1024 + k] : ka->in[3][k]; s[i] = v / (1.f + __expf(-v)); }
    __syncthreads();
    const int gc0 = blockIdx.x * 48, l = gc0 / 6144, j0 = gc0 % 6144;
    if (blockIdx.x < 256) {
        const int kq = TID / 48, col = TID % 48;
        if (kq < 10) {
            float a[9];
#pragma unroll
            for (int r = 0; r < 9; ++r) a[r] = 0.f;
            const float* w = ka->in[4] + (size_t)l * 1024 * 6144 + j0 + col;
            for (int k = kq; k < 1024; k += 10) { const float wv = w[(size_t)k * 6144];
#pragma unroll
                for (int r = 0; r < 9; ++r) a[r] += s[r * 1024 + k] * wv; }
#pragma unroll
            for (int r = 0; r < 9; ++r) red[(kq * 9 + r) * 48 + col] = a[r];
        }
        __syncthreads();
        if (TID < 432) { const int r = TID / 48, col = TID % 48; float a = 0.f;
#pragma unroll
            for (int q = 0; q < 10; ++q) a += red[(q * 9 + r) * 48 + col];
            ((float*)(ws + WS_MOD))[((size_t)l * 9 + r) * 6144 + j0 + col] = a + ka->in[5][l * 6144 + j0 + col]; }
    }
    __syncthreads();
    LAS float* scr = (LAS float*)(X.lds + X.wave * 16384);
    constexpr int I_IN = 120 * 16, I_OUT = 32 * 16, NIT = 2 * (I_IN + I_OUT);
    for (int it = X.gw; it < NIT; it += X.ngw) {
        int r = it; const int ly = r / (I_IN + I_OUT); r -= ly * (I_IN + I_OUT);
        if (r < I_IN) { const int nb = r / 16, kb = r % 16, n = nb * 32 + (LANE & 31), sc = win_src(n);
            conv_item(ka->in[7] + (size_t)ly * 1024 * N_IN + (sc < 0 ? 0 : sc), sc < 0 ? 0.f : 1.f, N_IN, (bf16*)(ws + WS_WIN) + (size_t)ly * 3840 * 1024, 1024, nb * 32, kb * 64, scr, LANE); }
        else { r -= I_IN; const int nb = r / 16, kb = r % 16;
            conv_item(ka->in[13] + (size_t)ly * 1024 * 1024 + nb * 32 + (LANE & 31), 1.f, 1024, (bf16*)(ws + WS_WOUT) + (size_t)ly * 1024 * 1024, 1024, nb * 32, kb * 64, scr, LANE); }
    }
}
__device__ __forceinline__ void convert_experts(const Ctx& X, int ly) {
    KargP ka = kargs(); unsigned char* const ws = ka->ws; (void)ka; (void)ws;
    int tid_ = X.wave * 64 + lane_id(); asm volatile("" : "+v"(tid_)); const int TID = tid_, LANE = tid_ & 63;
    LAS float* scr = (LAS float*)(X.lds + X.wave * 16384);
    constexpr int I13 = 16 * 32 * 16, I2 = 16 * 32 * 8;
    for (int it = X.gw; it < I13 + I2; it += X.ngw) {
        if (it < I13) { const int e = it / 512, r = it % 512, nb = r / 16, kb = r % 16, n = nb * 32 + (LANE & 31), g = n >> 3, i = n & 7;
            const float* src = (i < 4 ? ka->in[17] : ka->in[18]) + ((size_t)ly * 16 + e) * 1024 * 512 + 4 * g + (i & 3);
            conv_item(src, 1.f, 512, (bf16*)(ws + WS_EW13) + (size_t)e * 1024 * 1024, 1024, nb * 32, kb * 64, scr, LANE); }
        else { const int r0 = it - I13, e = r0 / 256, r = r0 % 256, nb = r / 8, kb = r % 8;
            conv_item(ka->in[19] + ((size_t)ly * 16 + e) * 512 * 1024 + nb * 32 + (LANE & 31), 1.f, 1024, (bf16*)(ws + WS_EW2) + (size_t)e * 1024 * 512, 512, nb * 32, kb * 64, scr, LANE); }
    }
}

template <bool COMBINE, bool ROUTER, bool FINAL>
__device__ __forceinline__ void rows_phase(const Ctx& X, const float* xl_src, const float* xc_src, float* xl_dst, float* xc_dst, const float* nw, const float* MODn, int sh, int sc,
                                           const float* MODc  , bool latent_only, int lyr) {
    KargP ka = kargs(); unsigned char* const ws = ka->ws; (void)ka; (void)ws;
    int tid_ = X.wave * 64 + lane_id(); asm volatile("" : "+v"(tid_)); const int TID = tid_, LANE = tid_ & 63;
    bf16* ACT = (bf16*)(ws + WS_ACT); const bf16* Y = (const bf16*)(ws + WS_Y);
    const int* TOK_SLOT = (const int*)(ws + WS_ROUTE + RT_TOK_SLOT); const float* TOK_Wc = (const float*)(ws + WS_ROUTE + RT_TOK_W);
    int* TOK_E = (int*)(ws + WS_ROUTE + RT_TOK_E); float* TOK_W = (float*)(ws + WS_ROUTE + RT_TOK_W);
    LAS float* rwL = (LAS float*)X.lds;
    LAS unsigned* hist = (LAS unsigned*)(X.lds + 65536);
    if (ROUTER) {
        for (int i = TID; i < 16384; i += NTHR) { const int cidx = i >> 4, e = i & 15; const int ji = (cidx >> 8) * 4 + (cidx & 3), ln = (cidx & 255) >> 2;
            rwL[((ji * 4 + (e >> 2)) * 64 + ln) * 4 + (e & 3)] = ka->in[15][i]; }
        if (TID < 16) hist[TID] = 0u;
        __syncthreads();
    }
    const int nrow = latent_only ? 16 : 17;
    int key = -1; f32x4 wv[4], shv[4], m5[4];
    for (int i = 0; i < nrow; ++i) {
        int row, b, u;
        if (latent_only) { const int lr = X.gw * 16 + i; b = lr >> 12; u = CTXL + (lr & 4095); row = b * UT + u; }
        else { row = X.gw * 17 + i; b = row / UT; u = row - b * UT; }
        const bool ctx = u < CTXL; const int k2 = ctx ? 8 : b;
        if (k2 != key) { key = k2;
#pragma unroll
            for (int j = 0; j < 4; ++j) { const int col = 4 * LANE + 256 * j;
                if (FINAL) wv[j] = *(const f32x4*)(nw + col);
                else { const f32x4 w = *(const f32x4*)(nw + col), s1 = *(const f32x4*)(MODn + (size_t)k2 * 6144 + sc * 1024 + col); wv[j] = w * (1.f + s1); shv[j] = *(const f32x4*)(MODn + (size_t)k2 * 6144 + sh * 1024 + col); }
                if (COMBINE) m5[j] = *(const f32x4*)(MODc + (size_t)k2 * 6144 + 5 * 1024 + col); } }
        const size_t xoff = ctx ? ((size_t)b * CTXL + u) * DM : ((size_t)b * SEQ + (u - CTXL)) * DM;
        const float* xs = (ctx ? xc_src : xl_src) + xoff;
        f32x4 v[4];
#pragma unroll
        for (int j = 0; j < 4; ++j) v[j] = *(const f32x4*)(xs + 4 * LANE + 256 * j);
        if (COMBINE) {
            const int s0 = __builtin_amdgcn_readfirstlane(ld_i32(TOK_SLOT + row * 2)), s1 = __builtin_amdgcn_readfirstlane(ld_i32(TOK_SLOT + row * 2 + 1));
            const float w0 = ld_f32(TOK_Wc + row * 2), w1 = ld_f32(TOK_Wc + row * 2 + 1);
#pragma unroll
            for (int j = 0; j < 4; ++j) { const u32x2 a = *(const u32x2*)(Y + (size_t)s0 * 1024 + 4 * LANE + 256 * j), bq = *(const u32x2*)(Y + (size_t)s1 * 1024 + 4 * LANE + 256 * j);
                f32x4 ya, yb; ya[0] = __uint_as_float(a.x << 16); ya[1] = __uint_as_float(a.x & 0xffff0000u); ya[2] = __uint_as_float(a.y << 16); ya[3] = __uint_as_float(a.y & 0xffff0000u);
                yb[0] = __uint_as_float(bq.x << 16); yb[1] = __uint_as_float(bq.x & 0xffff0000u); yb[2] = __uint_as_float(bq.y << 16); yb[3] = __uint_as_float(bq.y & 0xffff0000u);
                v[j] = v[j] + m5[j] * (w0 * ya + w1 * yb); }
            if (!FINAL) { float* xd = (ctx ? xc_dst : xl_dst) + xoff;
#pragma unroll
                for (int j = 0; j < 4; ++j) *(f32x4*)(xd + 4 * LANE + 256 * j) = v[j]; }
        }
        float ss = 0.f;
#pragma unroll
        for (int j = 0; j < 4; ++j) ss += (v[j][0] * v[j][0] + v[j][1] * v[j][1]) + (v[j][2] * v[j][2] + v[j][3] * v[j][3]);
        const float rstd = rsqrtf(wave_sum(ss) * (1.f / DM) + EPS);
        if (FINAL) { float* xd = xl_dst + xoff;
#pragma unroll
            for (int j = 0; j < 4; ++j) *(f32x4*)(xd + 4 * LANE + 256 * j) = v[j] * rstd * wv[j];
            continue; }
        f32x4 h[4];
#pragma unroll
        for (int j = 0; j < 4; ++j) { h[j] = v[j] * rstd * wv[j] + shv[j]; u32x2 o; o.x = cvt_pk_bf16(h[j][0], h[j][1]); o.y = cvt_pk_bf16(h[j][2], h[j][3]); *(u32x2*)(ACT + (size_t)row * DM + 4 * LANE + 256 * j) = o; }
        if (ROUTER) {
            float p[16];
#pragma unroll
            for (int e = 0; e < 16; ++e) p[e] = 0.f;
#pragma unroll
            for (int j = 0; j < 4; ++j)
#pragma unroll
                for (int ii = 0; ii < 4; ++ii)
#pragma unroll
                    for (int q = 0; q < 4; ++q) { const f32x4 w = *(const LAS f32x4*)(rwL + (((j * 4 + ii) * 4 + q) * 64 + LANE) * 4);
                        p[4 * q + 0] += h[j][ii] * w[0]; p[4 * q + 1] += h[j][ii] * w[1]; p[4 * q + 2] += h[j][ii] * w[2]; p[4 * q + 3] += h[j][ii] * w[3]; }
            float q8[8], q4[4], q2[2], q1;
            { const bool hi = (LANE & 32) != 0;
#pragma unroll
              for (int t = 0; t < 8; ++t) { const float snd = hi ? p[t] : p[t + 8], kp = hi ? p[t + 8] : p[t]; q8[t] = kp + __shfl_xor(snd, 32); } }
            { const bool hi = (LANE & 16) != 0;
#pragma unroll
              for (int t = 0; t < 4; ++t) { const float snd = hi ? q8[t] : q8[t + 4], kp = hi ? q8[t + 4] : q8[t]; q4[t] = kp + __shfl_xor(snd, 16); } }
            { const bool hi = (LANE & 8) != 0;
#pragma unroll
              for (int t = 0; t < 2; ++t) { const float snd = hi ? q4[t] : q4[t + 2], kp = hi ? q4[t + 2] : q4[t]; q2[t] = kp + __shfl_xor(snd, 8); } }
            { const bool hi = (LANE & 4) != 0; const float snd = hi ? q2[0] : q2[1], kp = hi ? q2[1] : q2[0]; q1 = kp + __shfl_xor(snd, 4); }
            q1 += __shfl_xor(q1, 1); q1 += __shfl_xor(q1, 2);
            float lg[16]; float mx = -1e30f;
#pragma unroll
            for (int e = 0; e < 16; ++e) { lg[e] = __uint_as_float(__builtin_amdgcn_readlane(__float_as_uint(q1), 4 * e)); mx = fmaxf(mx, lg[e]); }
            float sum = 0.f;
#pragma unroll
            for (int e = 0; e < 16; ++e) { lg[e] = expf(lg[e] - mx); sum += lg[e]; }
            float sel[16];
#pragma unroll
            for (int e = 0; e < 16; ++e) { lg[e] = lg[e] / sum; sel[e] = lg[e] + ka->in[16][e]; }
            int best = 0; float bgs = -1e30f;
#pragma unroll
            for (int g = 0; g < 4; ++g) { float m1 = -1e30f, m2 = -1e30f;
#pragma unroll
                for (int k = 0; k < 4; ++k) { const float sv = sel[4 * g + k]; const bool gt1 = sv > m1, gt2 = sv > m2; m2 = gt1 ? m1 : (gt2 ? sv : m2); m1 = gt1 ? sv : m1; }
                if (m1 + m2 > bgs) { bgs = m1 + m2; best = g; } }
            float sg[4], pg[4];
#pragma unroll
            for (int k = 0; k < 4; ++k) { sg[k] = best == 0 ? sel[k] : best == 1 ? sel[4 + k] : best == 2 ? sel[8 + k] : sel[12 + k]; pg[k] = best == 0 ? lg[k] : best == 1 ? lg[4 + k] : best == 2 ? lg[8 + k] : lg[12 + k]; }
            int i0 = 0; float s0v = sg[0], p0 = pg[0];
#pragma unroll
            for (int k = 1; k < 4; ++k) if (sg[k] > s0v) { s0v = sg[k]; i0 = k; p0 = pg[k]; }
            int i1 = -1; float s1v = -1e30f, p1 = 0.f;
#pragma unroll
            for (int k = 0; k < 4; ++k) if (k != i0 && (i1 < 0 || sg[k] > s1v)) { s1v = sg[k]; i1 = k; p1 = pg[k]; }
            if (LANE == 0) { const int e0 = 4 * best + i0, e1 = 4 * best + i1; const float wsum = p0 + p1;
                TOK_E[row * 2] = e0; TOK_E[row * 2 + 1] = e1; TOK_W[row * 2] = p0 / wsum; TOK_W[row * 2 + 1] = p1 / wsum;
                __hip_atomic_fetch_add(hist + e0, 1u, __ATOMIC_RELAXED, __HIP_MEMORY_SCOPE_WORKGROUP); __hip_atomic_fetch_add(hist + e1, 1u, __ATOMIC_RELAXED, __HIP_MEMORY_SCOPE_WORKGROUP); }
        }
    }
    if (ROUTER) {
        __syncthreads();
        if (TID < 16) __hip_atomic_fetch_add(((unsigned*)ws) + CW_CNT + 32 * lyr + TID, hist[TID], __ATOMIC_RELAXED, __HIP_MEMORY_SCOPE_AGENT);
    }
}

__device__ __forceinline__ void phase_slots(const Ctx& X, int lyr, bool latent_only) {
    KargP ka = kargs(); unsigned char* const ws = ka->ws; (void)ka; (void)ws;
    int tid_ = X.wave * 64 + lane_id(); asm volatile("" : "+v"(tid_)); const int TID = tid_, LANE = tid_ & 63;
    LAS unsigned* off = (LAS unsigned*)X.lds;
    LAS unsigned* lcnt = off + 32;
    LAS unsigned* lbase = off + 64;
    const int* TOK_E = (const int*)(ws + WS_ROUTE + RT_TOK_E); const float* TOK_W = (const float*)(ws + WS_ROUTE + RT_TOK_W);
    int* TOK_SLOT = (int*)(ws + WS_ROUTE + RT_TOK_SLOT); int* SLOT_TOK = (int*)(ws + WS_ROUTE + RT_SLOT_TOK); float* SLOT_W = (float*)(ws + WS_ROUTE + RT_SLOT_W); int* TILE_E = (int*)(ws + WS_ROUTE + RT_TILE_E) + 512 * lyr;
    const bf16* ACT = (const bf16*)(ws + WS_ACT); bf16* AG = (bf16*)(ws + WS_AG);
    unsigned* CNT = ((unsigned*)ws) + CW_CNT + 32 * lyr; unsigned* CUR = ((unsigned*)ws) + CW_CUR + 32 * lyr;
    if (TID == 0) { unsigned o = 0; for (int e = 0; e < 16; ++e) { off[e] = o; o += (ld_u32(CNT + e) + 255u) & ~255u; } off[16] = o; }
    if (TID < 16) lcnt[TID] = 0u;
    __syncthreads();
    if (blockIdx.x == 0) {
        if (TID == 0) { for (int e = 0; e <= 16; ++e) ((unsigned*)ws)[CW_OFF + 32 * lyr + e] = off[e]; ((unsigned*)ws)[CW_NT + 32 * lyr] = off[16] >> 8; }
        for (int e = 0; e < 16; ++e) { const unsigned cnt = ld_u32(CNT + e);
            for (unsigned i = off[e] + cnt + TID; i < off[e + 1]; i += NTHR) { SLOT_TOK[i] = 0; SLOT_W[i] = 0.f; }
            for (unsigned t = (off[e] >> 8) + TID; t < (off[e + 1] >> 8); t += NTHR) TILE_E[t] = e; }
    }
    const int nrow = latent_only ? 16 : 17;
    int row = -1, e0 = 0, e1 = 0; unsigned lp0 = 0, lp1 = 0;
    if (LANE < nrow) {
        if (latent_only) { const int lr = X.gw * 16 + LANE; row = (lr >> 12) * UT + CTXL + (lr & 4095); } else row = X.gw * 17 + LANE;
        e0 = TOK_E[row * 2]; e1 = TOK_E[row * 2 + 1];
        lp0 = __hip_atomic_fetch_add(lcnt + e0, 1u, __ATOMIC_RELAXED, __HIP_MEMORY_SCOPE_WORKGROUP); lp1 = __hip_atomic_fetch_add(lcnt + e1, 1u, __ATOMIC_RELAXED, __HIP_MEMORY_SCOPE_WORKGROUP);
    }
    __syncthreads();
    if (TID < 16) lbase[TID] = off[TID] + __hip_atomic_fetch_add(CUR + TID, lcnt[TID], __ATOMIC_RELAXED, __HIP_MEMORY_SCOPE_AGENT);
    __syncthreads();
    int s0 = 0, s1 = 0;
    if (LANE < nrow) { s0 = (int)(lbase[e0] + lp0); s1 = (int)(lbase[e1] + lp1); TOK_SLOT[row * 2] = s0; TOK_SLOT[row * 2 + 1] = s1;
        SLOT_TOK[s0] = row; SLOT_TOK[s1] = row; SLOT_W[s0] = TOK_W[row * 2]; SLOT_W[s1] = TOK_W[row * 2 + 1]; }
    for (int i = 0; i < nrow; ++i) {
        const int r = __shfl(row, i), a = __shfl(s0, i), bq = __shfl(s1, i);
        const u32x4* src = (const u32x4*)(ACT + (size_t)r * DM);
        const u32x4 v0 = src[LANE], v1 = src[64 + LANE];
        u32x4* d0 = (u32x4*)(AG + (size_t)a * DM); u32x4* d1 = (u32x4*)(AG + (size_t)bq * DM);
        d0[LANE] = v0; d0[64 + LANE] = v1; d1[LANE] = v0; d1[64 + LANE] = v1;
    }
}


__device__ __forceinline__ void unpack8(const u32x4 v, float (&f)[8]) {
    f[0] = __uint_as_float(v.x << 16); f[1] = __uint_as_float(v.x & 0xffff0000u); f[2] = __uint_as_float(v.y << 16); f[3] = __uint_as_float(v.y & 0xffff0000u);
    f[4] = __uint_as_float(v.z << 16); f[5] = __uint_as_float(v.z & 0xffff0000u); f[6] = __uint_as_float(v.w << 16); f[7] = __uint_as_float(v.w & 0xffff0000u);
}
__device__ __forceinline__ void phase_prep(const Ctx& X, int l) {
    KargP ka = kargs(); unsigned char* const ws = ka->ws; (void)ka; (void)ws;
    int tid_ = X.wave * 64 + lane_id(); asm volatile("" : "+v"(tid_)); const int TID = tid_, LANE = tid_ & 63;
    LAS float* tcos = (LAS float*)X.lds; LAS float* tsin = tcos + 2048;
    for (int i = TID; i < 2048; i += NTHR) { const int pos = i >> 5, ii = i & 31; const float inv = exp2f(-(float)(2 * ii) * (13.287712379549449f / 64.f)); const float ang = (float)pos * inv; tcos[i] = cosf(ang); tsin[i] = sinf(ang); }
    __syncthreads();
    const bf16* QKRAW = (const bf16*)(ws + WS_QKRAW); bf16* QP = (bf16*)(ws + WS_QP); bf16* KP = (bf16*)(ws + WS_KP); bf16* KPT = (bf16*)(ws + WS_KPT);
    const float* cw = ka->in[8] + l * 3072; const float* cb = ka->in[9] + l * 1024;
    const int r0 = X.gw * 17;
    const int hd = LANE >> 4, d0 = 8 * (LANE & 15), blk = (LANE & 15) >> 3, i0 = 8 * (LANE & 3); const bool low = (LANE & 7) < 4;
#pragma unroll 1
    for (int hf = 0; hf < 2; ++hf) {
        const int col0 = hf * 512 + 8 * LANE;
        float w0[8], w1[8], w2[8], bb[8];
#pragma unroll
        for (int j = 0; j < 8; ++j) { w0[j] = cw[col0 + j]; w1[j] = cw[1024 + col0 + j]; w2[j] = cw[2048 + col0 + j]; bb[j] = cb[col0 + j]; }
        float xp[8], xc[8], xr[8];
        { const int b = r0 / UT, u = r0 - b * UT; const int lo = u < CTXL ? 0 : CTXL;
          if (u > lo) unpack8(*(const u32x4*)(QKRAW + (size_t)(r0 - 1) * 1024 + col0), xp); else {
#pragma unroll
              for (int j = 0; j < 8; ++j) xp[j] = 0.f; }
          unpack8(*(const u32x4*)(QKRAW + (size_t)r0 * 1024 + col0), xc); }
#pragma unroll 1
        for (int i = 0; i < 17; ++i) {
            const int row = r0 + i, b = row / UT, u = row - b * UT; const int hi = u < CTXL ? CTXL - 1 : UT - 1; const bool inner = u < hi;
            if (row + 1 < MROWS) unpack8(*(const u32x4*)(QKRAW + (size_t)(row + 1) * 1024 + col0), xr); else {
#pragma unroll
                for (int j = 0; j < 8; ++j) xr[j] = 0.f; }
            float s[8];
#pragma unroll
            for (int j = 0; j < 8; ++j) { const float y = bb[j] + w0[j] * xp[j] + w1[j] * xc[j] + (inner ? w2[j] * xr[j] : 0.f); s[j] = y / (1.f + __expf(-y)); }
            if (u >= CTXL) {
                const int t = u - CTXL, pos = blk ? (t & 63) : (t >> 6);
                const f32x4 c0 = *(const LAS f32x4*)(tcos + pos * 32 + i0), c1 = *(const LAS f32x4*)(tcos + pos * 32 + i0 + 4), s0 = *(const LAS f32x4*)(tsin + pos * 32 + i0), s1 = *(const LAS f32x4*)(tsin + pos * 32 + i0 + 4);
#pragma unroll
                for (int j = 0; j < 8; ++j) { const float pv = __shfl_xor(s[j], 4); const float cs = j < 4 ? c0[j & 3] : c1[j & 3], sn = j < 4 ? s0[j & 3] : s1[j & 3]; s[j] = s[j] * cs + (low ? -pv : pv) * sn; }
            }
            if (hf == 1) {
#pragma unroll
                for (int j = 0; j < 8; ++j) s[j] *= 0.08838834764831845f; }
            u32x4 o; o.x = cvt_pk_bf16(s[0], s[1]); o.y = cvt_pk_bf16(s[2], s[3]); o.z = cvt_pk_bf16(s[4], s[5]); o.w = cvt_pk_bf16(s[6], s[7]);
            if (hf == 0) *(u32x4*)(QP + (size_t)row * 512 + 8 * LANE) = o;
            else { *(u32x4*)(KP + (size_t)row * 512 + 8 * LANE) = o;
                bf16* kt = KPT + ((size_t)(b * 4 + hd) * 128 + d0) * UT + u;
                kt[0] = (bf16)(o.x & 0xffffu); kt[UT] = (bf16)(o.x >> 16); kt[2 * UT] = (bf16)(o.y & 0xffffu); kt[3 * UT] = (bf16)(o.y >> 16);
                kt[4 * UT] = (bf16)(o.z & 0xffffu); kt[5 * UT] = (bf16)(o.z >> 16); kt[6 * UT] = (bf16)(o.w & 0xffffu); kt[7 * UT] = (bf16)(o.w >> 16); }
#pragma unroll
            for (int j = 0; j < 8; ++j) { xp[j] = inner ? xc[j] : 0.f; xc[j] = xr[j]; }
        }
    }
}


__device__ __forceinline__ f32x4 mfma16(bf16x8 a, bf16x8 b, f32x4 c) { return __builtin_amdgcn_mfma_f32_16x16x32_bf16(a, b, c, 0, 0, 0); }
__device__ __forceinline__ float logsig_fast(float x) { return fminf(x, 0.f) - __logf(1.f + __expf(-fabsf(x))); }
__device__ __forceinline__ int chunk_of(int dir, int k) { return dir == 0 ? k : (k < 2 ? 1 - k : 35 - k); }
__device__ __forceinline__ void phase_scan(const Ctx& X) {
    KargP ka = kargs(); unsigned char* const ws = ka->ws; (void)ka; (void)ws;
    int tid_ = X.wave * 64 + lane_id(); asm volatile("" : "+v"(tid_)); const int TID = tid_, LANE = tid_ & 63;
    const int bid = blockIdx.x, chain = (bid & 7) + 8 * (bid >> 5), q4 = (bid >> 3) & 3, b = chain >> 3, h = (chain >> 1) & 3, dir = chain & 1;
    LAS float* gl = (LAS float*)X.lds;
    LAS float* bend = gl + NCHUNK * 128; LAS float* gmx = bend + 64; LAS float* wold = gmx + 64; LAS float* mst = wold + 64; LAS float* mnx = mst + 64;
    const float* GATES = (const float*)(ws + WS_GATES);
    for (int k = X.wave; k < NCHUNK; k += NWAVES) {
        const int c = chunk_of(dir, k), p0 = 2 * LANE, t0 = dir ? 127 - p0 : p0, t1 = dir ? 126 - p0 : p0 + 1;
        const size_t row0 = (size_t)b * UT + 128 * c;
        const float f0 = GATES[(row0 + t0) * 16 + (2 * dir + 1) * 4 + h], f1 = GATES[(row0 + t1) * 16 + (2 * dir + 1) * 4 + h];
        const float i0 = GATES[(row0 + t0) * 16 + (2 * dir) * 4 + h], i1 = GATES[(row0 + t1) * 16 + (2 * dir) * 4 + h];
        const float l0 = logsig_fast(f0), l1 = logsig_fast(f1);
        float v = l0 + l1;
#pragma unroll
        for (int o = 1; o < 64; o <<= 1) { const float t = __shfl_up(v, o); if (LANE >= o) v += t; }
        const float be = __shfl(v, 63), b1 = v, b0 = v - l1;
        const float g0 = be - b0 + i0, g1 = be - b1 + i1;
        float gm = fmaxf(g0, g1);
#pragma unroll
        for (int o = 1; o < 64; o <<= 1) gm = fmaxf(gm, __shfl_xor(gm, o));
        gl[k * 128 + t0] = g0; gl[k * 128 + t1] = g1;
        if (LANE == 0) { bend[k] = be; gmx[k] = gm; }
    }
    __syncthreads();
    if (TID == 0) { float m = 0.f; for (int k = 0; k < NCHUNK; ++k) { mst[k] = m; const float mn = fmaxf(bend[k] + m, gmx[k]); wold[k] = __expf(bend[k] + m - mn); mnx[k] = mn; m = mn; } }
    __syncthreads();
    for (int i = TID; i < NCHUNK * 128; i += NTHR) gl[i] = __expf(gl[i] - mnx[i >> 7]);
    if (q4 == 0 && TID < NCHUNK) ((float*)(ws + WS_MST))[chain * NCHUNK + TID] = mst[TID];
    __syncthreads();
    const bf16* KPT = (const bf16*)(ws + WS_KPT); const bf16* MVT = (const bf16*)(ws + WS_MVT); bf16* CST = (bf16*)(ws + WS_CST); float* NST = (float*)(ws + WS_NST);
    const int n = LANE & 15, g = LANE >> 4;
    const bf16* kbase = KPT + ((size_t)(b * 4 + h) * 128 + 16 * X.wave + n) * UT + 8 * g;
    const bf16* vbase = MVT + ((size_t)(b * 4 + h) * 128 + 32 * q4 + n) * UT + 8 * g;
    f32x4 C0 = {0.f, 0.f, 0.f, 0.f}, C1 = {0.f, 0.f, 0.f, 0.f}, Cn = {0.f, 0.f, 0.f, 0.f};
    bf16x8 ones;
#pragma unroll
    for (int j = 0; j < 8; ++j) ones[j] = (short)0x3F80;
    u32x4 kc[4], va[2][4], kn[4], vn[2][4];
    { const int u0 = 128 * chunk_of(dir, 0);
#pragma unroll
      for (int ks = 0; ks < 4; ++ks) { kc[ks] = *(const u32x4*)(kbase + u0 + 32 * ks); va[0][ks] = *(const u32x4*)(vbase + u0 + 32 * ks); va[1][ks] = *(const u32x4*)(vbase + (size_t)16 * UT + u0 + 32 * ks); } }
#pragma unroll 1
    for (int k = 0; k < NCHUNK; ++k) {
        if (k + 1 < NCHUNK) { const int u1 = 128 * chunk_of(dir, k + 1);
#pragma unroll
            for (int ks = 0; ks < 4; ++ks) { kn[ks] = *(const u32x4*)(kbase + u1 + 32 * ks); vn[0][ks] = *(const u32x4*)(vbase + u1 + 32 * ks); vn[1][ks] = *(const u32x4*)(vbase + (size_t)16 * UT + u1 + 32 * ks); } }
        { bf16* cs = CST + ((size_t)(chain * NCHUNK + k) * 128 + 32 * q4 + 4 * g) * 128 + 16 * X.wave + n;
#pragma unroll
          for (int r = 0; r < 4; ++r) { cs[(size_t)r * 128] = f2bf(C0[r]); cs[(size_t)(16 + r) * 128] = f2bf(C1[r]); }
          if (q4 == 0 && g == 0) NST[(size_t)(chain * NCHUNK + k) * 128 + 16 * X.wave + n] = Cn[0]; }
        const float wo = wold[k];
        C0 = C0 * wo; C1 = C1 * wo; Cn = Cn * wo;
#pragma unroll
        for (int ks = 0; ks < 4; ++ks) {
            const f32x4 wa = *(const LAS f32x4*)(gl + k * 128 + 32 * ks + 8 * g), wb = *(const LAS f32x4*)(gl + k * 128 + 32 * ks + 8 * g + 4);
            float kf[8]; unpack8(kc[ks], kf);
            u32x4 kw; kw.x = cvt_pk_bf16(kf[0] * wa[0], kf[1] * wa[1]); kw.y = cvt_pk_bf16(kf[2] * wa[2], kf[3] * wa[3]); kw.z = cvt_pk_bf16(kf[4] * wb[0], kf[5] * wb[1]); kw.w = cvt_pk_bf16(kf[6] * wb[2], kf[7] * wb[3]);
            const bf16x8 bfr = __builtin_bit_cast(bf16x8, kw);
            C0 = mfma16(__builtin_bit_cast(bf16x8, va[0][ks]), bfr, C0); C1 = mfma16(__builtin_bit_cast(bf16x8, va[1][ks]), bfr, C1); Cn = mfma16(ones, bfr, Cn);
        }
#pragma unroll
        for (int ks = 0; ks < 4; ++ks) { kc[ks] = kn[ks]; va[0][ks] = vn[0][ks]; va[1][ks] = vn[1][ks]; }
    }
}


__device__ __forceinline__ unsigned swz_b(unsigned row, unsigned ch) { return 256u * row + 16u * (ch ^ (((row & 3u) << 2) | ((row >> 2) & 3u))); }
__device__ __forceinline__ void stage_tile128(LAS unsigned char* dst, const char* src, size_t gpitch, int TID) {
#pragma unroll
    for (int i = 0; i < 4; ++i) { const int nn = TID + NTHR * i, row = nn >> 4, ch = nn & 15; const u32x4 v = *(const u32x4*)(src + (size_t)row * gpitch + ch * 16); *(LAS u32x4*)(dst + swz_b(row, ch)) = v; }
}
constexpr int GA_OFF = 0;
__device__ __forceinline__ void mlstm_unit(const Ctx& X, LAS float* ga, int b, int h, int c, int l, int TID, int LANE) {
    KargP ka = kargs(); unsigned char* const ws = ka->ws; (void)ka; (void)ws;
    const bf16* QP = (const bf16*)(ws + WS_QP); const bf16* KP = (const bf16*)(ws + WS_KP); const bf16* MVT = (const bf16*)(ws + WS_MVT); const bf16* CST = (const bf16*)(ws + WS_CST);
    const float* NST = (const float*)(ws + WS_NST); const float* MST = (const float*)(ws + WS_MST); const float* GATES = (const float*)(ws + WS_GATES);
    const bf16* PA = (const bf16*)(ws + WS_PA); bf16* ACT = (bf16*)(ws + WS_ACT);
    LAS unsigned char* TK = X.lds; LAS unsigned char* TV = X.lds + 32768; LAS unsigned char* TCF = X.lds + 65536; LAS unsigned char* TCB = X.lds + 98304;
    LAS float* aF = ga; LAS float* aB = ga + 128; LAS float* MF = ga + 256; LAS float* MB = ga + 384; LAS float* bF = ga + 512; LAS float* bB = ga + 640;
    const int chF = (b * 4 + h) * 2, chB = chF + 1, jf = c, jb = c < 2 ? 1 - c : 35 - c;
    const size_t row0 = (size_t)b * UT + 128 * c;
    const float mf = MST[chF * NCHUNK + jf], mb = MST[chB * NCHUNK + jb];
    stage_tile128(TK, (const char*)(KP + row0 * 512 + h * 128), 1024, TID);
    stage_tile128(TV, (const char*)(MVT + (size_t)(b * 4 + h) * 128 * UT + 128 * c), (size_t)UT * 2, TID);
    stage_tile128(TCF, (const char*)(CST + (size_t)(chF * NCHUNK + jf) * 16384), 256, TID);
    stage_tile128(TCB, (const char*)(CST + (size_t)(chB * NCHUNK + jb) * 16384), 256, TID);
    if (X.wave < 2) {
        const int dir = X.wave, p0 = 2 * LANE, t0 = dir ? 127 - p0 : p0, t1 = dir ? 126 - p0 : p0 + 1;
        const float f0 = GATES[(row0 + t0) * 16 + (2 * dir + 1) * 4 + h], f1 = GATES[(row0 + t1) * 16 + (2 * dir + 1) * 4 + h];
        const float i0 = GATES[(row0 + t0) * 16 + (2 * dir) * 4 + h], i1 = GATES[(row0 + t1) * 16 + (2 * dir) * 4 + h];
        const float l0 = logsig_fast(f0), l1 = logsig_fast(f1);
        float v = l0 + l1;
#pragma unroll
        for (int o = 1; o < 64; o <<= 1) { const float t = __shfl_up(v, o); if (LANE >= o) v += t; }
        const float b1 = v, b0 = v - l1, a0 = i0 - b0, a1 = i1 - b1;
        float mx = fmaxf(a0, a1);
#pragma unroll
        for (int o = 1; o < 64; o <<= 1) { const float t = __shfl_up(mx, o); if (LANE >= o) mx = fmaxf(mx, t); }
        float mprev = __shfl_up(mx, 1); if (LANE == 0) mprev = -1e30f;
        const float mm = dir ? mb : mf;
        const float M0 = fmaxf(mm, fmaxf(mprev, a0)), M1 = fmaxf(mm, mx);
        LAS float* aa = dir ? aB : aF; LAS float* MM = dir ? MB : MF; LAS float* bbp = dir ? bB : bF;
        aa[t0] = a0; aa[t1] = a1; MM[t0] = M0; MM[t1] = M1; bbp[t0] = b0; bbp[t1] = b1;
    }
    __syncthreads();
    const int n = LANE & 15, g = LANE >> 4, t = 16 * (TID >> 6) + n, dblk = X.wave >> 1;
    const size_t rowt = row0 + t;
    unsigned rb[4], ka_[4], kb_[4];
#pragma unroll
    for (int ks = 0; ks < 4; ++ks) { const unsigned cx = 64u * (unsigned)(ks ^ (n & 3));
        rb[ks] = 256u * n + cx + 16u * (unsigned)(g ^ ((n >> 2) & 3));
        ka_[ks] = 256u * (8 * (n >> 2) + (n & 3)) + cx + 16u * (unsigned)(g ^ ((2 * (n >> 2)) & 3));
        kb_[ks] = 256u * (8 * (n >> 2) + (n & 3) + 4) + cx + 16u * (unsigned)(g ^ ((2 * (n >> 2) + 1) & 3)); }
    u32x4 qf[4];
#pragma unroll
    for (int ks = 0; ks < 4; ++ks) qf[ks] = *(const u32x4*)(QP + rowt * 512 + h * 128 + 32 * ks + 8 * g);
    float qnf = 0.f, qnb = 0.f;
    { const float* nf = NST + (size_t)(chF * NCHUNK + jf) * 128; const float* nb = NST + (size_t)(chB * NCHUNK + jb) * 128;
#pragma unroll
      for (int ks = 0; ks < 4; ++ks) { float q8[8]; unpack8(qf[ks], q8);
          const f32x4 a0 = *(const f32x4*)(nf + 32 * ks + 8 * g), a1 = *(const f32x4*)(nf + 32 * ks + 8 * g + 4), c0 = *(const f32x4*)(nb + 32 * ks + 8 * g), c1 = *(const f32x4*)(nb + 32 * ks + 8 * g + 4);
#pragma unroll
          for (int j = 0; j < 4; ++j) { qnf += q8[j] * a0[j] + q8[4 + j] * a1[j]; qnb += q8[j] * c0[j] + q8[4 + j] * c1[j]; } }
      qnf += __shfl_xor(qnf, 16); qnf += __shfl_xor(qnf, 32); qnb += __shfl_xor(qnb, 16); qnb += __shfl_xor(qnb, 32); }
    const float MFt = MF[t], MBt = MB[t], bFt = bF[t], bBt = bB[t];
    float pp[4][8], pdb[8]; float sumF = 0.f, sumB = 0.f;
#pragma unroll
    for (int j = 0; j < 8; ++j) pdb[j] = 0.f;
#pragma unroll
    for (int blk = 0; blk < 4; ++blk) {
        f32x4 sa = {0.f, 0.f, 0.f, 0.f}, sb = {0.f, 0.f, 0.f, 0.f};
#pragma unroll
        for (int ks = 0; ks < 4; ++ks) { const bf16x8 A0 = *(const LAS bf16x8*)(TK + ka_[ks] + blk * 8192), A1 = *(const LAS bf16x8*)(TK + kb_[ks] + blk * 8192);
            sa = mfma16(A0, __builtin_bit_cast(bf16x8, qf[ks]), sa); sb = mfma16(A1, __builtin_bit_cast(bf16x8, qf[ks]), sb); }
        if (blk <= dblk) {
            const f32x4 af0 = *(const LAS f32x4*)(aF + 32 * blk + 8 * g), af1 = *(const LAS f32x4*)(aF + 32 * blk + 8 * g + 4);
#pragma unroll
            for (int j = 0; j < 8; ++j) { const int s = 32 * blk + 8 * g + j; const float sv = j < 4 ? sa[j & 3] : sb[j & 3]; const float afs = j < 4 ? af0[j & 3] : af1[j & 3];
                const float v = (s <= t) ? sv * __expf(afs - MFt) : 0.f; pp[blk][j] = v; sumF += v; }
        }
        if (blk >= dblk) {
            const f32x4 ab0 = *(const LAS f32x4*)(aB + 32 * blk + 8 * g), ab1 = *(const LAS f32x4*)(aB + 32 * blk + 8 * g + 4);
#pragma unroll
            for (int j = 0; j < 8; ++j) { const int s = 32 * blk + 8 * g + j; const float sv = j < 4 ? sa[j & 3] : sb[j & 3]; const float abs_ = j < 4 ? ab0[j & 3] : ab1[j & 3];
                const float v = (s >= t) ? sv * __expf(abs_ - MBt) : 0.f; if (blk == dblk) pdb[j] = v; else pp[blk][j] = v; sumB += v; }
        }
    }
    sumF += __shfl_xor(sumF, 16); sumF += __shfl_xor(sumF, 32); sumB += __shfl_xor(sumB, 16); sumB += __shfl_xor(sumB, 32);
    const float wiF = __expf(mf - MFt), wiB = __expf(mb - MBt);
    const float rF = 1.f / fmaxf(fabsf(sumF + wiF * qnf), __expf(-bFt - MFt)), rB = 1.f / fmaxf(fabsf(sumB + wiB * qnb), __expf(-bBt - MBt));
    bf16x8 pfr[4];
#pragma unroll
    for (int blk = 0; blk < 4; ++blk) { const float sc = blk <= dblk ? rF : rB; const float sd = blk == dblk ? rB : 0.f; float q[8];
#pragma unroll
        for (int j = 0; j < 8; ++j) q[j] = pp[blk][j] * sc + pdb[j] * sd;
        u32x4 w; w.x = cvt_pk_bf16(q[0], q[1]); w.y = cvt_pk_bf16(q[2], q[3]); w.z = cvt_pk_bf16(q[4], q[5]); w.w = cvt_pk_bf16(q[6], q[7]); pfr[blk] = __builtin_bit_cast(bf16x8, w); }
    const float cF = wiF * rF, cB = wiB * rB;
    f32x4 O[8]; float ss = 0.f;
#pragma unroll
    for (int mt = 0; mt < 8; ++mt) {
        f32x4 o = {0.f, 0.f, 0.f, 0.f}, af = {0.f, 0.f, 0.f, 0.f}, ab = {0.f, 0.f, 0.f, 0.f};
#pragma unroll
        for (int ks = 0; ks < 4; ++ks) {
            o = mfma16(*(const LAS bf16x8*)(TV + rb[ks] + mt * 4096), pfr[ks], o);
            af = mfma16(*(const LAS bf16x8*)(TCF + rb[ks] + mt * 4096), __builtin_bit_cast(bf16x8, qf[ks]), af);
            ab = mfma16(*(const LAS bf16x8*)(TCB + rb[ks] + mt * 4096), __builtin_bit_cast(bf16x8, qf[ks]), ab); }
        O[mt] = o + cF * af + cB * ab;
        ss += (O[mt][0] * O[mt][0] + O[mt][1] * O[mt][1]) + (O[mt][2] * O[mt][2] + O[mt][3] * O[mt][3]);
    }
    ss += __shfl_xor(ss, 16); ss += __shfl_xor(ss, 32);
    const float rstd = rsqrtf(ss * (1.f / 128.f) + EPS);
    const float* mnw = ka->in[11] + l * 512 + h * 128;
#pragma unroll
    for (int mt = 0; mt < 8; ++mt) { const int dv0 = 16 * mt + 4 * g; const f32x4 w4 = *(const f32x4*)(mnw + dv0); const u32x2 mo = *(const u32x2*)(PA + rowt * 1536 + h * 128 + dv0);
        const float g0 = __uint_as_float(mo.x << 16), g1 = __uint_as_float(mo.x & 0xffff0000u), g2 = __uint_as_float(mo.y << 16), g3 = __uint_as_float(mo.y & 0xffff0000u);
        const float o0 = O[mt][0] * rstd * w4[0] * __builtin_amdgcn_rcpf(1.f + __expf(-g0)), o1 = O[mt][1] * rstd * w4[1] * __builtin_amdgcn_rcpf(1.f + __expf(-g1));
        const float o2 = O[mt][2] * rstd * w4[2] * __builtin_amdgcn_rcpf(1.f + __expf(-g2)), o3 = O[mt][3] * rstd * w4[3] * __builtin_amdgcn_rcpf(1.f + __expf(-g3));
        u32x2 w; w.x = cvt_pk_bf16(o0, o1); w.y = cvt_pk_bf16(o2, o3); *(u32x2*)(ACT + rowt * 1024 + h * 128 + dv0) = w; }
    __syncthreads();
}

constexpr float NA_C2 = 0.125f * 1.4426950408889634f;
template <bool PARTIAL>
__device__ __forceinline__ void na_ctx_tile(LAS unsigned char* CK, LAS unsigned char* CV, const bf16* qrow  , bf16* orow  , float* pm, int n, int g) {
    u32x4 qf[2];
#pragma unroll
    for (int ks = 0; ks < 2; ++ks) qf[ks] = *(const u32x4*)(qrow + 32 * ks + 8 * g);
    const unsigned ka0 = (unsigned)(8 * (n >> 2) + (n & 3)) * 144u + 16u * g, ka1 = ka0 + 4u * 144u, vb = (unsigned)n * 528u + 16u * g;
    f32x4 s[8][2]; float mx = -1e30f;
#pragma unroll
    for (int blk = 0; blk < 8; ++blk) {
        f32x4 sa = {0.f, 0.f, 0.f, 0.f}, sb = {0.f, 0.f, 0.f, 0.f};
#pragma unroll
        for (int ks = 0; ks < 2; ++ks) { sa = mfma16(*(const LAS bf16x8*)(CK + ka0 + blk * 4608 + ks * 64), __builtin_bit_cast(bf16x8, qf[ks]), sa); sb = mfma16(*(const LAS bf16x8*)(CK + ka1 + blk * 4608 + ks * 64), __builtin_bit_cast(bf16x8, qf[ks]), sb); }
        s[blk][0] = sa * NA_C2; s[blk][1] = sb * NA_C2;
        mx = fmaxf(mx, fmaxf(fmaxf(fmaxf(s[blk][0][0], s[blk][0][1]), fmaxf(s[blk][0][2], s[blk][0][3])), fmaxf(fmaxf(s[blk][1][0], s[blk][1][1]), fmaxf(s[blk][1][2], s[blk][1][3]))));
    }
    mx = fmaxf(mx, __shfl_xor(mx, 16)); mx = fmaxf(mx, __shfl_xor(mx, 32));
    float sum = 0.f; bf16x8 pfr[8];
#pragma unroll
    for (int blk = 0; blk < 8; ++blk) { float e[8];
#pragma unroll
        for (int j = 0; j < 8; ++j) { e[j] = __builtin_amdgcn_exp2f(s[blk][j >> 2][j & 3] - mx); sum += e[j]; }
        u32x4 w; w.x = cvt_pk_bf16(e[0], e[1]); w.y = cvt_pk_bf16(e[2], e[3]); w.z = cvt_pk_bf16(e[4], e[5]); w.w = cvt_pk_bf16(e[6], e[7]); pfr[blk] = __builtin_bit_cast(bf16x8, w); }
    sum += __shfl_xor(sum, 16); sum += __shfl_xor(sum, 32);
    const float inv = 1.f / sum;
#pragma unroll
    for (int mt = 0; mt < 4; ++mt) { f32x4 o = {0.f, 0.f, 0.f, 0.f};
#pragma unroll
        for (int blk = 0; blk < 8; ++blk) o = mfma16(*(const LAS bf16x8*)(CV + vb + mt * 8448 + blk * 64), pfr[blk], o);
        u32x2 w; w.x = cvt_pk_bf16(o[0] * inv, o[1] * inv); w.y = cvt_pk_bf16(o[2] * inv, o[3] * inv); *(u32x2*)(orow + 16 * mt + 4 * g) = w; }
    if (PARTIAL && g == 0) { pm[0] = mx; pm[1] = sum; }
}
__device__ __forceinline__ void na_job(const Ctx& X, int job, int l, int TID, int LANE) {
    KargP ka = kargs(); unsigned char* const ws = ka->ws;
    const int bhd = job >> 2, qq = job & 3, b = bhd >> 3, hd = bhd & 7, n = LANE & 15, g = LANE >> 4;
    const bf16* PA = (const bf16*)(ws + WS_PA); const bf16* NVT = (const bf16*)(ws + WS_NVT); bf16* ACT = (bf16*)(ws + WS_ACT);
    bf16* PARTO = (bf16*)(ws + WS_PARTO) + (size_t)bhd * 4096 * 64; float* PARTM = (float*)(ws + WS_PARTM) + (size_t)bhd * 4096 * 2;
    const bf16* vtb = NVT + (size_t)(b * 8 + hd) * 64 * UT;
    LAS unsigned char* CK = X.lds; LAS unsigned char* CV = X.lds + 36864; LAS float* rpbL = (LAS float*)(X.lds + LDSCTL_OFF + 4096);
#pragma unroll
    for (int i = 0; i < 4; ++i) { const int nn = TID + NTHR * i, key = nn >> 3, ch = nn & 7; *(LAS u32x4*)(CK + key * 144 + ch * 16) = *(const u32x4*)(PA + ((size_t)b * UT + key) * 1536 + 1024 + hd * 64 + ch * 8); }
#pragma unroll
    for (int i = 0; i < 4; ++i) { const int nn = TID + NTHR * i, dv = nn >> 5, ch = nn & 31; *(LAS u32x4*)(CV + dv * 528 + ch * 16) = *(const u32x4*)(vtb + (size_t)dv * UT + ch * 8); }
    if (TID < 528) rpbL[TID] = (TID >= 16 && TID < 481) ? (ka->in[12] + (size_t)l * 8 * 465 + hd * 465)[TID - 16] : 0.f;
    __syncthreads();
#ifndef NA_SKIP_C
#pragma unroll 1
    for (int un = 0; un < 8; ++un) { const int r = 16 * qq + 2 * un + (X.wave >> 2), tq = r * 64 + 16 * (X.wave & 3) + n; const size_t row = (size_t)b * UT + CTXL + tq;
        na_ctx_tile<true>(CK, CV, PA + row * 1536 + 512 + hd * 64, PARTO + (size_t)tq * 64, PARTM + (size_t)tq * 2, n, g); }
    if (l == 0 && qq < 2) { const size_t row = (size_t)b * UT + 128 * qq + 16 * X.wave + n;
        na_ctx_tile<false>(CK, CV, PA + row * 1536 + 512 + hd * 64, ACT + row * 1024 + 512 + hd * 64, nullptr, n, g); }
#endif
    __syncthreads();
#ifndef NA_SKIP_W
    LAS unsigned char* WK = X.lds; LAS unsigned char* WV = X.lds + 73728;
#pragma unroll 1
    for (int un = 0; un < 8; ++un) {
        const int r0 = 16 * qq + 2 * un, rs_lo = min(max(r0 - 4, 0), 56), nrows = min(9, 64 - rs_lo);
        const size_t tok0 = (size_t)b * UT + CTXL + rs_lo * 64;
#pragma unroll
        for (int i = 0; i < 9; ++i) { const int nn = TID + NTHR * i, key = nn >> 3, ch = nn & 7;
            if (key < nrows * 64) *(LAS u32x4*)(WK + key * 128 + ((ch ^ (key & 7)) * 16)) = *(const u32x4*)(PA + (tok0 + key) * 1536 + 1024 + hd * 64 + ch * 8); }
#pragma unroll
        for (int i = 0; i < 9; ++i) { const int nn = TID + NTHR * i, dv = nn / 72, cc = nn - dv * 72;
            if (cc < nrows * 8) *(LAS u32x4*)(WV + dv * 1152 + (((cc & ~7) | ((cc & 7) ^ (dv & 7))) * 16)) = *(const u32x4*)(vtb + (size_t)dv * UT + CTXL + rs_lo * 64 + cc * 8); }
        __syncthreads();
        {
            const int r = r0 + (X.wave >> 2), c0 = 16 * (X.wave & 3), rs = min(max(r - 4, 0), 56), lr0 = rs - rs_lo, cs0 = min(max(c0 - 8, 0), 32);
            const int c = c0 + n, csq = min(max(c - 8, 0), 48), tq = r * 64 + c; const size_t row = (size_t)b * UT + CTXL + tq;
            u32x4 qf[2];
#pragma unroll
            for (int ks = 0; ks < 2; ++ks) qf[ks] = *(const u32x4*)(PA + row * 1536 + 512 + hd * 64 + 32 * ks + 8 * g);
            const float m_c = PARTM[(size_t)tq * 2], l_c = PARTM[(size_t)tq * 2 + 1];
            const unsigned kb0 = (unsigned)(lr0 * 64 + cs0 + 8 * (n >> 2) + (n & 3)) * 128u + 16u * (unsigned)(g ^ (n & 3)), kb1 = kb0 + 4u * 128u;
            const unsigned vb = (unsigned)n * 1152u + (unsigned)lr0 * 128u + 16u * (unsigned)(((cs0 >> 3) + g) ^ (n & 7));
            const int dk0 = cs0 + 8 * g - csq;
            const LAS float* rpl = rpbL + 16 + (rs - r + 7) * 31 + (cs0 + 8 * g - c + 15);
            f32x4 s[8][2]; float mx = m_c;
#pragma unroll
            for (int i = 0; i < 8; ++i) {
                f32x4 sa = {0.f, 0.f, 0.f, 0.f}, sb = {0.f, 0.f, 0.f, 0.f};
#pragma unroll
                for (int ks = 0; ks < 2; ++ks) { sa = mfma16(*(const LAS bf16x8*)(WK + kb0 + i * 8192 + 64 * ks), __builtin_bit_cast(bf16x8, qf[ks]), sa);
                    sb = mfma16(*(const LAS bf16x8*)(WK + kb1 + i * 8192 + 64 * (ks ^ 1)), __builtin_bit_cast(bf16x8, qf[ks]), sb); }
                const LAS float* bp = rpl + i * 31;
#pragma unroll
                for (int j = 0; j < 8; ++j) { const bool ok = (unsigned)(dk0 + j) < 16u; const float bias = bp[j]; const float sv = (j < 4 ? sa[j & 3] : sb[j & 3]);
                    const float x = ok ? (sv * 0.125f + bias) * 1.4426950408889634f : -1e30f; s[i][j >> 2][j & 3] = x; mx = fmaxf(mx, x); }
                asm volatile("" ::: "memory");
            }
            mx = fmaxf(mx, __shfl_xor(mx, 16)); mx = fmaxf(mx, __shfl_xor(mx, 32));
            float sum = 0.f; bf16x8 pfr[8];
#pragma unroll
            for (int i = 0; i < 8; ++i) { float e[8];
#pragma unroll
                for (int j = 0; j < 8; ++j) { e[j] = __builtin_amdgcn_exp2f(s[i][j >> 2][j & 3] - mx); sum += e[j]; }
                u32x4 w; w.x = cvt_pk_bf16(e[0], e[1]); w.y = cvt_pk_bf16(e[2], e[3]); w.z = cvt_pk_bf16(e[4], e[5]); w.w = cvt_pk_bf16(e[6], e[7]); pfr[i] = __builtin_bit_cast(bf16x8, w); }
            sum += __shfl_xor(sum, 16); sum += __shfl_xor(sum, 32);
            const float wc = __builtin_amdgcn_exp2f(m_c - mx) * l_c, inv = 1.f / (wc + sum);
#pragma unroll
            for (int mt = 0; mt < 4; ++mt) { f32x4 o = {0.f, 0.f, 0.f, 0.f};
#pragma unroll
                for (int i = 0; i < 8; ++i) o = mfma16(*(const LAS bf16x8*)(WV + vb + mt * 18432 + i * 128), pfr[i], o);
                const u32x2 pc = *(const u32x2*)(PARTO + (size_t)tq * 64 + 16 * mt + 4 * g);
                const float p0 = __uint_as_float(pc.x << 16), p1 = __uint_as_float(pc.x & 0xffff0000u), p2 = __uint_as_float(pc.y << 16), p3 = __uint_as_float(pc.y & 0xffff0000u);
                u32x2 w; w.x = cvt_pk_bf16((o[0] + wc * p0) * inv, (o[1] + wc * p1) * inv); w.y = cvt_pk_bf16((o[2] + wc * p2) * inv, (o[3] + wc * p3) * inv);
                *(u32x2*)(ACT + row * 1024 + 512 + hd * 64 + 16 * mt + 4 * g) = w; }
        }
        __syncthreads();
    }
#endif
}
__device__ __forceinline__ void phase_mix(const Ctx& X, int l, int flags) {
    int tid_ = X.wave * 64 + lane_id(); asm volatile("" : "+v"(tid_)); const int TID = tid_, LANE = tid_ & 63;
    LAS float* ga = (LAS float*)(X.lds + LDSCTL_OFF + 1024);
#ifdef MIXONLY
    flags &= MIXONLY;
#endif
    if (flags & 1) {
        const int nun = (l == 0) ? 32 * NCHUNK : 32 * 32;
#pragma unroll 1
        for (int v = blockIdx.x; v < nun; v += X.G) {
            int bh, c; if (l == 0) { bh = v / NCHUNK; c = v - bh * NCHUNK; } else { bh = v >> 5; c = 2 + (v & 31); }
            mlstm_unit(X, ga, bh >> 2, bh & 3, c, l, TID, LANE);
        }
    }
    if (flags & 2) { for (int job = blockIdx.x; job < 256; job += X.G) na_job(X, job, l, TID, LANE); }
}

#ifndef CPH
#define CPH 0xFFFFFFFFu
#endif
#define CEN(bit) ((CPH >> (bit)) & 1u)
#define IN(k) (lo <= (k) && (k) < hi)
#define SEAM(k) do { if (IN(k) && IN((k) + 1)) xcd_barrier(bar, LEADER); } while (0)
template <int l>
__device__ __forceinline__ void layer_body(const Ctx& X, const XcdBarrier& bar, const int lo, const int hi, const int mixflags) {
#define LEADER (X.wave == 0 && lane_id() == 0)

        const int pb = 1 + 10 * l; const bool last = (l == 1);
        if (CEN(1) && IN(pb + K_NORM1)) {
            KargP ka = kargs(); unsigned char* const ws = ka->ws; float* MOD = (float*)(ws + WS_MOD); float* CTXB = (float*)(ws + WS_CTX);
            if (l == 0) rows_phase<false, false, false>(X, ka->in[0], ka->in[2], nullptr, nullptr, ka->in[6], MOD, 0, 1, nullptr, false, 0);
            else rows_phase<true, false, false>(X, ka->out, CTXB, ka->out, CTXB, ka->in[6] + 1024, MOD + (size_t)9 * 6144, 0, 1, MOD, false, 0);
        } SEAM(pb + K_NORM1);
        if (CEN(2) && IN(pb + K_GEMM_IN)) {
            KargP ka = kargs(); unsigned char* const ws = ka->ws;
            SchedDense S; S.init(136, 15, X.G, (int)blockIdx.x); S.A = (const char*)(ws + WS_ACT); S.B = (const char*)(ws + WS_WIN) + (size_t)l * 3840 * 1024 * 2; S.tstep = (size_t)256 * 1024 * 2;
            EpiInP E{(bf16*)(ws + WS_QKRAW), (bf16*)(ws + WS_PA), (bf16*)(ws + WS_MVT), (bf16*)(ws + WS_NVT), (float*)(ws + WS_GATES), ka->in[10] + l * 16};
            pg8::gemm_phase<EpiInP, SchedDense>(X.lds, 1024, S, E, X.wave);
        } SEAM(pb + K_GEMM_IN);
        if (CEN(3) && IN(pb + K_PREP)) { phase_prep(X, l); } SEAM(pb + K_PREP);
        if (CEN(4) && IN(pb + K_SCAN)) { phase_scan(X); } SEAM(pb + K_SCAN);
        if (CEN(5) && IN(pb + K_MIX)) { phase_mix(X, l, mixflags); } SEAM(pb + K_MIX);
        if (CEN(6) && IN(pb + K_GEMM_OUT)) {
            KargP ka = kargs(); unsigned char* const ws = ka->ws; float* CTXB = (float*)(ws + WS_CTX);
            EpiOutP E{l == 0 ? ka->in[0] : ka->out, l == 0 ? ka->in[2] : CTXB, ka->out, CTXB, (const float*)(ws + WS_MOD) + (size_t)l * 9 * 6144};
            SchedLatent S; S.init(last ? 128 : 136, 4, X.G, (int)blockIdx.x); S.lat = last ? 1 : 0; S.A = (const char*)(ws + WS_ACT); S.B = (const char*)(ws + WS_WOUT) + (size_t)l * 1024 * 1024 * 2; S.tstep = (size_t)256 * 1024 * 2;
            pg8::gemm_phase<EpiOutP, SchedLatent>(X.lds, 1024, S, E, X.wave);
        } SEAM(pb + K_GEMM_OUT);
        if (CEN(7) && IN(pb + K_NORM2)) {
            { KargP ka = kargs(); unsigned char* const ws = ka->ws;
              rows_phase<false, true, false>(X, ka->out, (float*)(ws + WS_CTX), nullptr, nullptr, ka->in[14] + l * 1024, (const float*)(ws + WS_MOD) + (size_t)l * 9 * 6144, 3, 4, nullptr, last, l); }
            __syncthreads();
            convert_experts(X, l);
        } SEAM(pb + K_NORM2);
        if (CEN(8) && IN(pb + K_SLOTS)) { phase_slots(X, l, last); } SEAM(pb + K_SLOTS);
        if (CEN(9) && IN(pb + K_MOE1)) {
            KargP ka = kargs(); unsigned char* const ws = ka->ws;
            const int nt = (int)ld_u32((unsigned*)ws + CW_NT + 32 * l);
            SchedMoe S; S.init(nt, 4, X.G, (int)blockIdx.x); S.A = (const char*)(ws + WS_AG); S.B = (const char*)(ws + WS_EW13); S.tstep = (size_t)256 * 1024 * 2; S.TILE_E = (const int*)(ws + WS_ROUTE + RT_TILE_E) + 512 * l;
            EpiMoe1 E{(bf16*)(ws + WS_ACTM)};
            pg8::gemm_phase<EpiMoe1, SchedMoe>(X.lds, 1024, S, E, X.wave);
        } SEAM(pb + K_MOE1);
        if (CEN(10) && IN(pb + K_MOE2)) {
            KargP ka = kargs(); unsigned char* const ws = ka->ws;
            const int nt = (int)ld_u32((unsigned*)ws + CW_NT + 32 * l);
            SchedMoe S; S.init(nt, 4, X.G, (int)blockIdx.x); S.A = (const char*)(ws + WS_ACTM); S.B = (const char*)(ws + WS_EW2); S.tstep = (size_t)256 * 512 * 2; S.TILE_E = (const int*)(ws + WS_ROUTE + RT_TILE_E) + 512 * l;
            EpiMoe2 E{(bf16*)(ws + WS_Y)};
            pg8::gemm_phase<EpiMoe2, SchedMoe>(X.lds, 512, S, E, X.wave);
        } SEAM(pb + K_MOE2);
    }
__global__ void __launch_bounds__(NTHR, 2) mk_fwd(Args args) {
    extern __shared__ __attribute__((aligned(16))) unsigned char lds_raw[];
    Ctx X;
    X.lds = (LAS unsigned char*)lds_raw; X.wave = __builtin_amdgcn_readfirstlane(threadIdx.x >> 6); X.G = gridDim.x;
    X.gw = blockIdx.x * NWAVES + X.wave; X.ngw = X.G * NWAVES;
    volatile LAS unsigned* MISC = (volatile LAS unsigned*)(X.lds + MISC_OFF);
    for (int u = X.wave * 64 + lane_id(); u < (LDS_BYTES - LDSCTL_OFF) / 4; u += NTHR) ((LAS unsigned*)(X.lds + LDSCTL_OFF))[u] = 0u;
    __syncthreads();
    const int lo = args.ph_lo, hi = args.ph_hi;
    XcdBarrier bar; bar.bar = (unsigned*)(args.ws + WS_CTL) + CW_BAR + args.bar_region * XCD_BAR_WORDS; bar.x = 0; bar.st = nullptr;
    if (hi - lo > 1) bar = xcd_barrier_post((unsigned*)(args.ws + WS_CTL) + CW_BAR + args.bar_region * XCD_BAR_WORDS, MISC + 8, LEADER);

    if (CEN(0) && IN(PH_PRO)) { phase_prologue(X); } SEAM(PH_PRO);

    layer_body<0>(X, bar, lo, hi, args.mixflags);
    layer_body<1>(X, bar, lo, hi, args.mixflags);
    if (CEN(11) && IN(PH_FINAL)) { KargP ka = kargs(); unsigned char* const ws = ka->ws;
        rows_phase<true, false, true>(X, ka->out, nullptr, ka->out, nullptr, ka->in[20], nullptr, 0, 0, (const float*)(ws + WS_MOD) + (size_t)9 * 6144, true, 1); }
#undef IN
#undef SEAM
}
constexpr unsigned PM_PRO = 1u << 0, PM_NORM1 = 1u << 1, PM_GEMM_IN = 1u << 2, PM_PREP = 1u << 3, PM_SCAN = 1u << 4, PM_MIX = 1u << 5, PM_GEMM_OUT = 1u << 6, PM_NORM2 = 1u << 7,
                   PM_SLOTS = 1u << 8, PM_MOE1 = 1u << 9, PM_MOE2 = 1u << 10, PM_FINAL = 1u << 11;
#ifndef PMASK
#define PMASK (PM_PRO | PM_NORM1 | PM_GEMM_IN | PM_PREP | PM_SCAN | PM_MIX | PM_GEMM_OUT | PM_NORM2 | PM_SLOTS | PM_MOE1 | PM_MOE2 | PM_FINAL)
#endif
#ifndef MIXFLAGS
#define MIXFLAGS 3
#endif
static bool persist_phase(int ph) { if (ph == PH_PRO) return (PMASK & PM_PRO) != 0; if (ph == PH_FINAL) return (PMASK & PM_FINAL) != 0; return (PMASK & (2u << ((ph - 1) % 10))) != 0; }

extern "C" void kernel_launch(void* const* d_in, const int* in_sizes, int n_in, void* d_out, int out_size, void* d_ws, size_t ws_size, hipStream_t stream) {
    const float* x = (const float*)d_in[0]; const float* c = (const float*)d_in[1]; const float* ctx = (const float*)d_in[2]; const float* c_ctx = (const float*)d_in[3];
    const float* ada_w = (const float*)d_in[4]; const float* ada_b = (const float*)d_in[5]; const float* norm1_w = (const float*)d_in[6]; const float* w_in = (const float*)d_in[7];
    const float* conv_w = (const float*)d_in[8]; const float* conv_b = (const float*)d_in[9]; const float* gate_b = (const float*)d_in[10]; const float* mnorm_w = (const float*)d_in[11];
    const float* rpb = (const float*)d_in[12]; const float* w_out = (const float*)d_in[13]; const float* norm2_w = (const float*)d_in[14]; const float* router_w = (const float*)d_in[15];
    const float* router_b = (const float*)d_in[16]; const float* exp_w1 = (const float*)d_in[17]; const float* exp_w3 = (const float*)d_in[18]; const float* exp_w2 = (const float*)d_in[19];
    const float* final_w = (const float*)d_in[20];
    if (ws_size < WS_END) { fprintf(stderr, "kernel_launch: workspace too small (%zu < %zu)\n", ws_size, (size_t)WS_END); return; }
    unsigned char* ws = (unsigned char*)d_ws; float* out = (float*)d_out;
    unsigned* CTL = (unsigned*)(ws + WS_CTL); float* MOD = (float*)(ws + WS_MOD); float* CTXB = (float*)(ws + WS_CTX);
    float* GATES = (float*)(ws + WS_GATES); bf16* ACT = (bf16*)(ws + WS_ACT); bf16* PA = (bf16*)(ws + WS_PA); bf16* QKRAW = (bf16*)(ws + WS_QKRAW); bf16* CST = (bf16*)(ws + WS_CST);
    bf16* MVT = (bf16*)(ws + WS_MVT); bf16* NVT = (bf16*)(ws + WS_NVT); bf16* QP = (bf16*)(ws + WS_QP); bf16* KP = (bf16*)(ws + WS_KP); bf16* KPT = (bf16*)(ws + WS_KPT);
    float* NST = (float*)(ws + WS_NST); float* MST = (float*)(ws + WS_MST); float* HSUM = (float*)(ws + WS_HSUM); bf16* ACTM = (bf16*)(ws + WS_ACTM); bf16* Y = (bf16*)(ws + WS_Y);
    int* TOK_E = (int*)(ws + WS_ROUTE + RT_TOK_E); float* TOK_W = (float*)(ws + WS_ROUTE + RT_TOK_W); int* TOK_SLOT = (int*)(ws + WS_ROUTE + RT_TOK_SLOT);
    int* SLOT_TOK = (int*)(ws + WS_ROUTE + RT_SLOT_TOK); float* SLOT_W = (float*)(ws + WS_ROUTE + RT_SLOT_W); int* TILE_E0 = (int*)(ws + WS_ROUTE + RT_TILE_E);
    static int grid = 0;
    if (grid == 0) {
        int dev = 0, cus = 0; (void)hipGetDevice(&dev); (void)hipDeviceGetAttribute(&cus, hipDeviceAttributeMultiprocessorCount, dev);
        (void)hipFuncSetAttribute((const void*)nv_mout, hipFuncAttributeMaxDynamicSharedMemorySize, 70 * 1024);
        (void)hipFuncSetAttribute((const void*)mk_fwd, hipFuncAttributeMaxDynamicSharedMemorySize, LDS_BYTES);
        int per_cu = 0; (void)hipOccupancyMaxActiveBlocksPerMultiprocessor(&per_cu, (const void*)mk_fwd, NTHR, LDS_BYTES); (void)hipGetLastError();
        grid = (cus == 256 && per_cu >= 1) ? 256 : -1;
        if (grid < 0) fprintf(stderr, "kernel_launch: persistent kernel needs 256 CUs and one resident block per CU (cus %d, per_cu %d); using the naive path\n", cus, per_cu);
    }
    (void)hipMemsetAsync(ws + WS_CTL, 0, 1 * MiB, stream);
    Args a{};
    for (int i = 0; i < 21; ++i) a.in[i] = (const float*)d_in[i];
    a.out = out; a.ws = ws;
    int region = 0;
    for (int ph = 0; ph < NPHASE;) {
        if (grid > 0 && persist_phase(ph)) {
            int ph2 = ph; while (ph2 < NPHASE && persist_phase(ph2)) ++ph2;
            a.ph_lo = ph; a.ph_hi = ph2; a.bar_region = region++; a.mixflags = MIXFLAGS;
            for (int q = ph; q < ph2; ++q) if (q >= 1 && q < PH_FINAL && (q - 1) % 10 == K_MIX && MIXFLAGS != 3) { ph2 = q + 1; break; }
            a.ph_hi = ph2;
            hipLaunchKernelGGL(mk_fwd, dim3(grid), dim3(NTHR), LDS_BYTES, stream, a);
            if (ph2 >= 2 && ph2 - 1 < PH_FINAL && (ph2 - 2) % 10 == K_MIX && MIXFLAGS != 3) {
                const int l = (ph2 - 2) / 10; const bool last = (l == 1);
                if (!(MIXFLAGS & 1)) { nv_mout<<<dim3(NCHUNK, 32), 256, (128 * 129 + 1024) * 4, stream>>>(QP, KP, MVT, GATES, CST, NST, MST, HSUM, last ? 1 : 0);
                    nv_mnorm<<<MROWS, 256, 0, stream>>>(HSUM, PA, mnorm_w + l * 512, ACT, last ? 1 : 0); }
                if (!(MIXFLAGS & 2)) { nv_na<<<dim3(SEQ, 8, 8), 128, 0, stream>>>(PA, NVT, rpb + (size_t)l * 8 * 15 * 31, ACT, 0);
                    if (!last) nv_na<<<dim3(CTXL, 8, 8), 128, 0, stream>>>(PA, NVT, rpb + (size_t)l * 8 * 15 * 31, ACT, 1); }
            }
            ph = ph2; continue;
        }
        if (ph == PH_PRO) { nv_mod<<<dim3(24, 9, 2), 256, 0, stream>>>(c, c_ctx, ada_w, ada_b, MOD); ++ph; continue; }
        if (ph == PH_FINAL) {
            nv_combine<<<MROWS, 256, 0, stream>>>(out, CTXB, MOD + (size_t)9 * 6144, TOK_SLOT, TOK_W, Y, 1);
            nv_final<<<NB * SEQ, 256, 0, stream>>>(out, final_w); ++ph; continue; }
        const int l = (ph - 1) / 10, k = (ph - 1) % 10; const bool last = (l == 1); const int lo = 32 * l;
        const float* MODl = MOD + (size_t)l * 9 * 6144;
        const float* sl = l == 0 ? x : out; const float* scx = l == 0 ? ctx : CTXB;
        int* TILE_E = TILE_E0 + 512 * l;
        switch (k) {
        case K_NORM1:
            if (l == 1) nv_combine<<<MROWS, 256, 0, stream>>>(out, CTXB, MOD, TOK_SLOT, TOK_W, Y, 0);
            nv_norm<<<MROWS, 256, 0, stream>>>(sl, scx, norm1_w + l * 1024, MODl, 0, 1, ACT, 0, nullptr, nullptr, nullptr, nullptr, nullptr, 0); break;
        case K_GEMM_IN: { EpiIn ei{QKRAW, PA, MVT, NVT, GATES, gate_b + l * 16}; EpiOut eo{};
            nv_gemm<0><<<dim3((N_IN + 63) / 64, MROWS / 64), 256, 0, stream>>>(ACT, w_in + (size_t)l * 1024 * N_IN, N_IN, N_IN, 1024, ei, eo); } break;
        case K_PREP: nv_prep<<<MROWS * 1024 / 256, 256, 0, stream>>>(QKRAW, conv_w + l * 3072, conv_b + l * 1024, QP, KP, KPT); break;
        case K_SCAN: nv_scan<<<dim3(64, 64), 256, 0, stream>>>(KP, MVT, GATES, CST, NST, MST); break;
        case K_MIX:
            nv_mout<<<dim3(NCHUNK, 32), 256, (128 * 129 + 1024) * 4, stream>>>(QP, KP, MVT, GATES, CST, NST, MST, HSUM, last ? 1 : 0);
            nv_mnorm<<<MROWS, 256, 0, stream>>>(HSUM, PA, mnorm_w + l * 512, ACT, last ? 1 : 0);
            nv_na<<<dim3(SEQ, 8, 8), 128, 0, stream>>>(PA, NVT, rpb + (size_t)l * 8 * 15 * 31, ACT, 0);
            if (!last) nv_na<<<dim3(CTXL, 8, 8), 128, 0, stream>>>(PA, NVT, rpb + (size_t)l * 8 * 15 * 31, ACT, 1);
            break;
        case K_GEMM_OUT: { EpiOut eo2{sl, scx, out, CTXB, MODl, last ? 1 : 0, 0}; EpiIn ei2{};
            nv_gemm<1><<<dim3(16, MROWS / 64), 256, 0, stream>>>(ACT, w_out + (size_t)l * 1024 * 1024, 1024, 1024, 1024, ei2, eo2); } break;
        case K_NORM2: nv_norm<<<MROWS, 256, 0, stream>>>(out, CTXB, norm2_w + l * 1024, MODl, 3, 4, ACT, 1, router_w, router_b, TOK_E, TOK_W, CTL + CW_CNT + lo, last ? 1 : 0); break;
        case K_SLOTS:
            nv_slots_off<<<1, 256, 0, stream>>>(CTL, SLOT_TOK, SLOT_W, TILE_E, lo);
            nv_slots_assign<<<MROWS / 256, 256, 0, stream>>>(CTL, TOK_E, TOK_W, TOK_SLOT, SLOT_TOK, SLOT_W, last ? 1 : 0, lo); break;
        case K_MOE1: nv_moe1<<<MAXSLOTS, 256, 0, stream>>>(CTL, ACT, SLOT_TOK, SLOT_W, TILE_E, exp_w1 + (size_t)l * 16 * 1024 * 512, exp_w3 + (size_t)l * 16 * 1024 * 512, ACTM, lo); break;
        case K_MOE2: nv_moe2<<<MAXSLOTS, 256, 0, stream>>>(CTL, ACTM, SLOT_W, TILE_E, exp_w2 + (size_t)l * 16 * 512 * 1024, Y, lo); break;
        }
        ++ph;
    }
}
```

```cpp
#include <hip/hip_runtime.h>
#include <cstdio>
#include <cstdint>

typedef unsigned short bf16;
__device__ __forceinline__ float bf2f(bf16 b) { return __uint_as_float(((unsigned)b) << 16); }
__device__ __forceinline__ bf16 f2bf(float f) { unsigned u = __float_as_uint(f); u += 0x7fffu + ((u >> 16) & 1u); return (bf16)(u >> 16); }

constexpr int DM = 1024, NB = 8, SEQ = 4096, CTXL = 256, UT = SEQ + CTXL  ;
constexpr int MROWS = NB * UT;
constexpr int NCHUNK = UT / 128;
constexpr int N_IN = 3600;
constexpr float EPS = 1e-6f;
constexpr int MAXSLOTS = 73728;

constexpr size_t MiB = 1u << 20;
constexpr size_t WS_CTL = 0;
constexpr size_t WS_MOD = 1 * MiB;
constexpr size_t WS_CTX = 2 * MiB;
constexpr size_t WS_WIN = 10 * MiB;
constexpr size_t WS_WOUT = 25 * MiB;
constexpr size_t WS_GATES = 29 * MiB;
constexpr size_t WS_ROUTE = 32 * MiB;
constexpr size_t WS_ACT = 34 * MiB;
constexpr size_t WS_PA = 102 * MiB;
constexpr size_t WS_QKRAW = 204 * MiB;
constexpr size_t WS_CST = 204 * MiB;
constexpr size_t WS_MVT = 272 * MiB;
constexpr size_t WS_NVT = 306 * MiB;
constexpr size_t WS_QP = 340 * MiB;
constexpr size_t WS_KP = 374 * MiB;
constexpr size_t WS_KPT = 408 * MiB;
constexpr size_t WS_NST = 442 * MiB;
constexpr size_t WS_MST = 443 * MiB + 512 * 1024;
constexpr size_t WS_HSUM = 444 * MiB;
constexpr size_t WS_ACTM = 150 * MiB;
constexpr size_t WS_Y = 222 * MiB;
constexpr size_t WS_END = 512 * MiB;
constexpr size_t RT_TOK_E = 0, RT_TOK_W = 300 * 1024, RT_TOK_SLOT = 600 * 1024, RT_SLOT_TOK = 900 * 1024, RT_SLOT_W = 1200 * 1024, RT_TILE_E = 1500 * 1024;
constexpr int CW_CNT = 1024, CW_CUR = 1088, CW_OFF = 1152  , CW_NT = 1216;

__device__ __forceinline__ float silu_f(float v) { return v / (1.f + expf(-v)); }
__device__ __forceinline__ float sigmoid_f(float v) { return 1.f / (1.f + expf(-v)); }
__device__ __forceinline__ float logsig_f(float x) { return fminf(x, 0.f) - log1pf(expf(-fabsf(x))); }

__global__ void nv_mod(const float* c, const float* c_ctx, const float* ada_w, const float* ada_b, float* MOD) {
    const int j = blockIdx.x * 256 + threadIdx.x, r = blockIdx.y, l = blockIdx.z;
    __shared__ float s[1024];
    const float* src = r < 8 ? c + r * 1024 : c_ctx;
    for (int k = threadIdx.x; k < 1024; k += 256) s[k] = silu_f(src[k]);
    __syncthreads();
    const float* w = ada_w + (size_t)l * 1024 * 6144;
    float acc = 0.f;
    for (int k = 0; k < 1024; ++k) acc += s[k] * w[(size_t)k * 6144 + j];
    MOD[((size_t)l * 9 + r) * 6144 + j] = acc + ada_b[l * 6144 + j];
}

__device__ __forceinline__ float block_sum256(float v, float* red) {
    for (int o = 32; o >= 1; o >>= 1) v += __shfl_xor(v, o);
    __syncthreads();
    if ((threadIdx.x & 63) == 0) red[threadIdx.x >> 6] = v;
    __syncthreads();
    return red[0] + red[1] + red[2] + red[3];
}

__global__ void nv_norm(const float* xl, const float* xc, const float* nw, const float* MODl, int sh, int sc, bf16* ACT, int do_router,
                        const float* router_w, const float* router_b, int* TOK_E, float* TOK_W, unsigned* CNT, int skip_ctx) {
    const int row = blockIdx.x, b = row / UT, u = row % UT, tid = threadIdx.x;
    const bool ctx = u < CTXL;
    if (ctx && skip_ctx) return;
    __shared__ float red[4];
    __shared__ float lg[4][16];
    const float* xr = ctx ? xc + ((size_t)b * CTXL + u) * DM : xl + ((size_t)b * SEQ + (u - CTXL)) * DM;
    float v[4]; float ss = 0.f;
    for (int i = 0; i < 4; ++i) { v[i] = xr[tid + 256 * i]; ss += v[i] * v[i]; }
    ss = block_sum256(ss, red);
    const float rstd = rsqrtf(ss * (1.f / DM) + EPS);
    const float* md = MODl + (size_t)(ctx ? 8 : b) * 6144;
    float h[4];
    for (int i = 0; i < 4; ++i) { const int col = tid + 256 * i; h[i] = v[i] * rstd * nw[col] * (1.f + md[sc * 1024 + col]) + md[sh * 1024 + col]; ACT[(size_t)row * DM + col] = f2bf(h[i]); }
    if (!do_router) return;
    float pl[16];
    for (int e = 0; e < 16; ++e) { float a = 0.f; for (int i = 0; i < 4; ++i) a += h[i] * router_w[(tid + 256 * i) * 16 + e]; pl[e] = a; }
    for (int e = 0; e < 16; ++e) { float a = pl[e]; for (int o = 32; o >= 1; o >>= 1) a += __shfl_xor(a, o); if ((tid & 63) == 0) lg[tid >> 6][e] = a; }
    __syncthreads();
    if (tid == 0) {
        float p[16], sel[16], mx = -1e30f, sum = 0.f;
        for (int e = 0; e < 16; ++e) { p[e] = lg[0][e] + lg[1][e] + lg[2][e] + lg[3][e]; mx = fmaxf(mx, p[e]); }
        for (int e = 0; e < 16; ++e) { p[e] = expf(p[e] - mx); sum += p[e]; }
        for (int e = 0; e < 16; ++e) { p[e] /= sum; sel[e] = p[e] + router_b[e]; }
        int best = 0; float bgs = -1e30f;
        for (int g = 0; g < 4; ++g) {
            float m1 = -1e30f, m2 = -1e30f;
            for (int k = 0; k < 4; ++k) { const float s = sel[4 * g + k]; if (s > m1) { m2 = m1; m1 = s; } else if (s > m2) m2 = s; }
            if (m1 + m2 > bgs) { bgs = m1 + m2; best = g; }
        }
        int i0 = 4 * best; for (int k = 1; k < 4; ++k) if (sel[4 * best + k] > sel[i0]) i0 = 4 * best + k;
        int i1 = -1; for (int k = 0; k < 4; ++k) { const int e = 4 * best + k; if (e == i0) continue; if (i1 < 0 || sel[e] > sel[i1]) i1 = e; }
        const float w0 = p[i0], w1 = p[i1], ws = w0 + w1;
        TOK_E[row * 2] = i0; TOK_E[row * 2 + 1] = i1; TOK_W[row * 2] = w0 / ws; TOK_W[row * 2 + 1] = w1 / ws;
        atomicAdd(&CNT[i0], 1u); atomicAdd(&CNT[i1], 1u);
    }
}

struct EpiIn { bf16* QKRAW; bf16* PA; bf16* MVT; bf16* NVT; float* GATES; const float* gate_b; };
struct EpiOut { const float* sl; const float* sc; float* dl; float* dc; const float* MODl; int skip_ctx; int pad; };

template <int MODE> __global__ void nv_gemm(const bf16* A, const float* W, int ldw, int N, int K, EpiIn ei, EpiOut eo) {
    __shared__ float As[16][65], Bs[16][64];
    const int tid = threadIdx.x, tx = tid & 15, ty = tid >> 4, row0 = blockIdx.y * 64, col0 = blockIdx.x * 64;
    float acc[4][4];
    for (int i = 0; i < 4; ++i) for (int j = 0; j < 4; ++j) acc[i][j] = 0.f;
    for (int kt = 0; kt < K; kt += 16) {
        for (int i = 0; i < 4; ++i) { const int idx = tid + 256 * i, m = idx >> 4, k = idx & 15; As[k][m] = bf2f(A[(size_t)(row0 + m) * K + kt + k]); }
        for (int i = 0; i < 4; ++i) { const int idx = tid + 256 * i, k = idx >> 6, n = idx & 63; Bs[k][n] = (col0 + n < N) ? W[(size_t)(kt + k) * ldw + col0 + n] : 0.f; }
        __syncthreads();
        for (int k = 0; k < 16; ++k) {
            float a[4], bb[4];
            for (int i = 0; i < 4; ++i) a[i] = As[k][ty * 4 + i];
            for (int j = 0; j < 4; ++j) bb[j] = Bs[k][tx * 4 + j];
            for (int i = 0; i < 4; ++i) for (int j = 0; j < 4; ++j) acc[i][j] += a[i] * bb[j];
        }
        __syncthreads();
    }
    for (int i = 0; i < 4; ++i) for (int j = 0; j < 4; ++j) {
        const int row = row0 + ty * 4 + i, n = col0 + tx * 4 + j; if (n >= N) continue;
        const float v = acc[i][j]; const int b = row / UT, u = row % UT;
        if (MODE == 0) {
            if (n < 512) ei.QKRAW[(size_t)row * 1024 + n] = f2bf(v);
            else if (n < 1024) ei.PA[(size_t)row * 1536 + (n - 512)] = f2bf(v);
            else if (n < 1536) ei.PA[(size_t)row * 1536 + 512 + (n - 1024)] = f2bf(v);
            else if (n < 2048) ei.QKRAW[(size_t)row * 1024 + 512 + (n - 1536)] = f2bf(v);
            else if (n < 2560) { const int c = n - 2048; ei.MVT[((size_t)(b * 4 + c / 128) * 128 + c % 128) * UT + u] = f2bf(v); }
            else if (n < 2576) ei.GATES[(size_t)row * 16 + (n - 2560)] = v + ei.gate_b[n - 2560];
            else if (n < 3088) ei.PA[(size_t)row * 1536 + 1024 + (n - 2576)] = f2bf(v);
            else { const int c = n - 3088; ei.NVT[((size_t)(b * 8 + c / 64) * 64 + c % 64) * UT + u] = f2bf(v); }
        } else {
            const bool ctx = u < CTXL; if (ctx && eo.skip_ctx) continue;
            const size_t off = ctx ? ((size_t)b * CTXL + u) * DM + n : ((size_t)b * SEQ + (u - CTXL)) * DM + n;
            const float md = eo.MODl[(size_t)(ctx ? 8 : b) * 6144 + 2 * 1024 + n];
            if (ctx) eo.dc[off] = eo.sc[off] + md * v; else eo.dl[off] = eo.sl[off] + md * v;
        }
    }
}

__device__ __forceinline__ float conv_silu(const bf16* QKRAW, int row, int u, int col, const float* cw, const float* cb) {
    const int lo = u < CTXL ? 0 : CTXL, hi = u < CTXL ? CTXL - 1 : UT - 1;
    float y = cb[col] + cw[1024 + col] * bf2f(QKRAW[(size_t)row * 1024 + col]);
    if (u > lo) y += cw[col] * bf2f(QKRAW[(size_t)(row - 1) * 1024 + col]);
    if (u < hi) y += cw[2048 + col] * bf2f(QKRAW[(size_t)(row + 1) * 1024 + col]);
    return silu_f(y);
}
__global__ void nv_prep(const bf16* QKRAW, const float* cw, const float* cb, bf16* QP, bf16* KP, bf16* KPT) {
    const size_t gid = (size_t)blockIdx.x * 256 + threadIdx.x;
    const int row = (int)(gid >> 10), col = (int)(gid & 1023), b = row / UT, u = row % UT;
    const int c = col & 511, head = c >> 7, d = c & 127;
    float val = conv_silu(QKRAW, row, u, col, cw, cb);
    if (u >= CTXL) {
        const int t = u - CTXL, blk = d >> 6, dd = d & 63, i = dd & 31;
        const float pos = (float)(blk == 0 ? (t >> 6) : (t & 63));
        const float inv = powf(10000.f, -(float)(2 * i) / 64.f);
        const float ang = pos * inv, cs = cosf(ang), sn = sinf(ang);
        const float pv = conv_silu(QKRAW, row, u, dd < 32 ? col + 32 : col - 32, cw, cb);
        val = dd < 32 ? val * cs - pv * sn : pv * sn + val * cs;
    }
    if (col < 512) QP[(size_t)row * 512 + c] = f2bf(val);
    else { val *= 0.08838834764831845f; KP[(size_t)row * 512 + c] = f2bf(val); KPT[((size_t)(b * 4 + head) * 128 + d) * UT + u] = f2bf(val); }
}

__device__ __forceinline__ int u_of(int dir, int j, int s) {
    if (dir == 0) return 128 * j + s;
    return j < 2 ? 255 - (128 * j + s) : UT - 1 - 128 * (j - 2) - s;
}
__global__ void nv_scan(const bf16* KP, const bf16* MVT, const float* GATES, bf16* CST, float* NST, float* MST) {
    const int chain = blockIdx.x, b = chain >> 3, h = (chain >> 1) & 3, dir = chain & 1, tid = threadIdx.x;
    const int dk = tid & 127, dv = blockIdx.y * 2 + (tid >> 7);
    __shared__ float wt[128], lf[128], ig[128], scal[2];
    __shared__ int us[128];
    float C = 0.f, n = 0.f;
    if (tid == 0) scal[1] = 0.f;
    __syncthreads();
    for (int j = 0; j < NCHUNK; ++j) {
        CST[((size_t)(chain * NCHUNK + j) * 128 + dv) * 128 + dk] = f2bf(C);
        if (blockIdx.y == 0 && tid < 128) NST[(size_t)(chain * NCHUNK + j) * 128 + dk] = n;
        if (blockIdx.y == 0 && tid == 0) MST[chain * NCHUNK + j] = scal[1];
        if (tid < 128) { const int u = u_of(dir, j, tid); us[tid] = u; const size_t row = (size_t)b * UT + u;
            lf[tid] = logsig_f(GATES[row * 16 + (2 * dir + 1) * 4 + h]); ig[tid] = GATES[row * 16 + (2 * dir) * 4 + h]; }
        __syncthreads();
        if (tid == 0) {
            float run = 0.f; for (int s = 0; s < 128; ++s) { run += lf[s]; lf[s] = run; }
            const float bend = run; float gmax = -1e30f;
            for (int s = 0; s < 128; ++s) { const float g = bend - lf[s] + ig[s]; ig[s] = g; gmax = fmaxf(gmax, g); }
            const float m = scal[1], mn = fmaxf(bend + m, gmax);
            scal[0] = expf(bend + m - mn); scal[1] = mn;
            for (int s = 0; s < 128; ++s) wt[s] = expf(ig[s] - mn);
        }
        __syncthreads();
        const float wo = scal[0]; float accC = 0.f, accn = 0.f;
        for (int s = 0; s < 128; ++s) { const int u = us[s]; const float kk = wt[s] * bf2f(KP[((size_t)b * UT + u) * 512 + h * 128 + dk]);
            accC += kk * bf2f(MVT[((size_t)(b * 4 + h) * 128 + dv) * UT + u]); accn += kk; }
        C = wo * C + accC; n = wo * n + accn;
        __syncthreads();
    }
}

__global__ void nv_mout(const bf16* QP, const bf16* KP, const bf16* MVT, const float* GATES, const bf16* CST, const float* NST, const float* MST, float* HSUM, int last) {
    const int c = blockIdx.x, bh = blockIdx.y, b = bh >> 2, h = bh & 3, tid = threadIdx.x;
    if (last && c < 2) return;
    extern __shared__ float sm[];
    float* S = sm; float* bb = S + 128 * 129; float* ig = bb + 128; float* den = ig + 128; float* wint = den + 128;
    const int p = tid & 127, half = tid >> 7;
    for (int dir = 0; dir < 2; ++dir) {
        const int j = dir == 0 ? c : (c < 2 ? 1 - c : 35 - c), chain = (b * 4 + h) * 2 + dir;
        if (tid < 128) { const int tau = tid, pp = dir ? 127 - tau : tau; const size_t row = (size_t)b * UT + 128 * c + tau;
            bb[pp] = logsig_f(GATES[row * 16 + (2 * dir + 1) * 4 + h]); ig[pp] = GATES[row * 16 + (2 * dir) * 4 + h]; }
        __syncthreads();
        if (tid == 0) { float run = 0.f; for (int s = 0; s < 128; ++s) { run += bb[s]; bb[s] = run; } }
        __syncthreads();
        const float m = MST[chain * NCHUNK + j];
        const size_t rowp = (size_t)b * UT + 128 * c + (dir ? 127 - p : p);
        const bf16* qrow = QP + rowp * 512 + h * 128;
        for (int p2 = 64 * half; p2 < 64 * half + 64; ++p2) {
            if (p2 > p) continue;
            const bf16* krow = KP + ((size_t)b * UT + 128 * c + (dir ? 127 - p2 : p2)) * 512 + h * 128;
            float dot = 0.f; for (int d = 0; d < 128; ++d) dot += bf2f(qrow[d]) * bf2f(krow[d]);
            S[p * 129 + p2] = dot;
        }
        __syncthreads();
        if (tid < 128) {
            const float inter = bb[p] + m; float mx = inter;
            for (int p2 = 0; p2 <= p; ++p2) mx = fmaxf(mx, bb[p] - bb[p2] + ig[p2]);
            float sum = 0.f;
            for (int p2 = 0; p2 <= p; ++p2) { const float dd = expf(bb[p] - bb[p2] + ig[p2] - mx); const float sv = S[p * 129 + p2] * dd; S[p * 129 + p2] = sv; sum += sv; }
            const float wi = expf(inter - mx);
            float qn = 0.f; const float* nn = NST + (size_t)(chain * NCHUNK + j) * 128;
            for (int d = 0; d < 128; ++d) qn += bf2f(qrow[d]) * nn[d];
            qn = sum + wi * qn;
            den[p] = fmaxf(fabsf(qn), expf(-mx)); wint[p] = wi;
        }
        __syncthreads();
        for (int dv = 64 * half; dv < 64 * half + 64; ++dv) {
            const bf16* vt = MVT + ((size_t)(b * 4 + h) * 128 + dv) * UT + 128 * c;
            float acc = 0.f;
            for (int p2 = 0; p2 <= p; ++p2) acc += S[p * 129 + p2] * bf2f(vt[dir ? 127 - p2 : p2]);
            const bf16* cc = CST + ((size_t)(chain * NCHUNK + j) * 128 + dv) * 128;
            float qc = 0.f; for (int d = 0; d < 128; ++d) qc += bf2f(qrow[d]) * bf2f(cc[d]);
            const float hv = (acc + wint[p] * qc) / den[p];
            float* o = HSUM + rowp * 512 + h * 128 + dv;
            if (dir == 0) *o = hv; else *o += hv;
        }
        __syncthreads();
    }
}

__global__ void nv_mnorm(const float* HSUM, const bf16* PA, const float* mnw, bf16* ACT, int skip_ctx) {
    const int row = blockIdx.x, u = row % UT, h = threadIdx.x >> 6, lane = threadIdx.x & 63;
    if (u < CTXL && skip_ctx) return;
    const float a = HSUM[(size_t)row * 512 + h * 128 + lane], bq = HSUM[(size_t)row * 512 + h * 128 + 64 + lane];
    float ss = a * a + bq * bq; for (int o = 32; o >= 1; o >>= 1) ss += __shfl_xor(ss, o);
    const float rstd = rsqrtf(ss * (1.f / 128.f) + EPS);
    for (int k = 0; k < 2; ++k) { const int col = h * 128 + 64 * k + lane; const float v = (k ? bq : a) * rstd * mnw[col] * sigmoid_f(bf2f(PA[(size_t)row * 1536 + col]));
        ACT[(size_t)row * 1024 + col] = f2bf(v); }
}

__global__ void nv_na(const bf16* PA, const bf16* NVT, const float* rpb, bf16* ACT, int ctxq) {
    const int tq = blockIdx.x, hd = blockIdx.y, b = blockIdx.z, tid = threadIdx.x;
    __shared__ float q[64], sc[384], red[4], o2[2][64];
    __shared__ int uk[384];
    const size_t rowq = (size_t)b * UT + (ctxq ? tq : CTXL + tq);
    if (tid < 64) q[tid] = bf2f(PA[rowq * 1536 + 512 + hd * 64 + tid]) * 0.125f;
    __syncthreads();
    const int nkeys = ctxq ? 256 : 384;
    for (int key = tid; key < nkeys; key += 128) {
        int uu; float bias = 0.f;
        if (!ctxq && key < 128) { const int i = key >> 4, j = key & 15, r = tq >> 6, c = tq & 63;
            const int rs = min(max(r - 4, 0), 56), cs = min(max(c - 8, 0), 48);
            uu = CTXL + (rs + i) * 64 + cs + j; bias = rpb[(hd * 15 + (rs + i - r + 7)) * 31 + (cs + j - c + 15)]; }
        else uu = ctxq ? key : key - 128;
        const bf16* kr = PA + ((size_t)b * UT + uu) * 1536 + 1024 + hd * 64;
        float dot = 0.f; for (int d = 0; d < 64; ++d) dot += q[d] * bf2f(kr[d]);
        sc[key] = dot + bias; uk[key] = uu;
    }
    __syncthreads();
    float mx = -1e30f; for (int key = tid; key < nkeys; key += 128) mx = fmaxf(mx, sc[key]);
    for (int o = 32; o >= 1; o >>= 1) mx = fmaxf(mx, __shfl_xor(mx, o));
    if ((tid & 63) == 0) red[tid >> 6] = mx;
    __syncthreads();
    mx = fmaxf(red[0], red[1]);
    float sum = 0.f; for (int key = tid; key < nkeys; key += 128) { const float e = expf(sc[key] - mx); sc[key] = e; sum += e; }
    for (int o = 32; o >= 1; o >>= 1) sum += __shfl_xor(sum, o);
    __syncthreads();
    if ((tid & 63) == 0) red[2 + (tid >> 6)] = sum;
    __syncthreads();
    sum = red[2] + red[3];
    const int dv = tid & 63, part = tid >> 6; const bf16* vt = NVT + ((size_t)(b * 8 + hd) * 64 + dv) * UT;
    float acc = 0.f; for (int key = part * (nkeys / 2); key < (part + 1) * (nkeys / 2); ++key) acc += sc[key] * bf2f(vt[uk[key]]);
    o2[part][dv] = acc;
    __syncthreads();
    if (tid < 64) ACT[rowq * 1024 + 512 + hd * 64 + tid] = f2bf((o2[0][tid] + o2[1][tid]) / sum);
}

__global__ void nv_slots_off(unsigned* CTL, int* SLOT_TOK, float* SLOT_W, int* TILE_E, int lo) {
    __shared__ unsigned off[17];
    if (threadIdx.x == 0) { unsigned o = 0; for (int e = 0; e < 16; ++e) { off[e] = o; CTL[CW_OFF + lo + e] = o; o += (CTL[CW_CNT + lo + e] + 255u) & ~255u; CTL[CW_CUR + lo + e] = 0u; } off[16] = o; CTL[CW_OFF + lo + 16] = o; CTL[CW_NT + lo] = o >> 8; }
    __syncthreads();
    for (int e = 0; e < 16; ++e) {
        const unsigned cnt = CTL[CW_CNT + lo + e];
        for (unsigned i = off[e] + cnt + threadIdx.x; i < off[e + 1]; i += blockDim.x) { SLOT_TOK[i] = 0; SLOT_W[i] = 0.f; }
        for (unsigned t = (off[e] >> 8) + threadIdx.x; t < (off[e + 1] >> 8); t += blockDim.x) TILE_E[t] = e;
    }
}
__global__ void nv_slots_assign(unsigned* CTL, const int* TOK_E, const float* TOK_W, int* TOK_SLOT, int* SLOT_TOK, float* SLOT_W, int skip_ctx, int lo) {
    const int row = blockIdx.x * 256 + threadIdx.x; if (row >= MROWS) return;
    if ((row % UT) < CTXL && skip_ctx) return;
    for (int k = 0; k < 2; ++k) { const int e = TOK_E[row * 2 + k]; const unsigned pos = atomicAdd(&CTL[CW_CUR + lo + e], 1u); const int slot = (int)(CTL[CW_OFF + lo + e] + pos);
        SLOT_TOK[slot] = row; SLOT_W[slot] = TOK_W[row * 2 + k]; TOK_SLOT[row * 2 + k] = slot; }
}
__global__ void nv_moe1(const unsigned* CTL, const bf16* ACT, const int* SLOT_TOK, const float* SLOT_W, const int* TILE_E, const float* w1, const float* w3, bf16* ACTM, int lo) {
    const int slot = blockIdx.x, tid = threadIdx.x; if ((unsigned)slot >= CTL[CW_OFF + lo + 16]) return;
    const float w = SLOT_W[slot]; if (w == 0.f) return;
    const int e = TILE_E[slot >> 8], tok = SLOT_TOK[slot];
    __shared__ float t[1024];
    for (int k = tid; k < 1024; k += 256) t[k] = bf2f(ACT[(size_t)tok * 1024 + k]);
    __syncthreads();
    const float* a1 = w1 + (size_t)e * 1024 * 512; const float* a3 = w3 + (size_t)e * 1024 * 512;
    for (int cc = 0; cc < 2; ++cc) { const int col = tid + 256 * cc; float g1 = 0.f, g3 = 0.f;
        for (int k = 0; k < 1024; ++k) { g1 += t[k] * a1[(size_t)k * 512 + col]; g3 += t[k] * a3[(size_t)k * 512 + col]; }
        ACTM[(size_t)slot * 512 + col] = f2bf(silu_f(g1) * g3); }
}
__global__ void nv_moe2(const unsigned* CTL, const bf16* ACTM, const float* SLOT_W, const int* TILE_E, const float* w2, bf16* Y, int lo) {
    const int slot = blockIdx.x, tid = threadIdx.x; if ((unsigned)slot >= CTL[CW_OFF + lo + 16]) return;
    if (SLOT_W[slot] == 0.f) return;
    const int e = TILE_E[slot >> 8];
    __shared__ float a[512];
    for (int k = tid; k < 512; k += 256) a[k] = bf2f(ACTM[(size_t)slot * 512 + k]);
    __syncthreads();
    const float* ww = w2 + (size_t)e * 512 * 1024;
    for (int cc = 0; cc < 4; ++cc) { const int col = tid + 256 * cc; float acc = 0.f; for (int k = 0; k < 512; ++k) acc += a[k] * ww[(size_t)k * 1024 + col]; Y[(size_t)slot * 1024 + col] = f2bf(acc); }
}
__global__ void nv_combine(float* xl, float* xc, const float* MODl, const int* TOK_SLOT, const float* TOK_W, const bf16* Y, int skip_ctx) {
    const int row = blockIdx.x, b = row / UT, u = row % UT, tid = threadIdx.x; const bool ctx = u < CTXL;
    if (ctx && skip_ctx) return;
    float* xr = ctx ? xc + ((size_t)b * CTXL + u) * DM : xl + ((size_t)b * SEQ + (u - CTXL)) * DM;
    const int s0 = TOK_SLOT[row * 2], s1 = TOK_SLOT[row * 2 + 1]; const float w0 = TOK_W[row * 2], w1 = TOK_W[row * 2 + 1]; const float* md = MODl + (size_t)(ctx ? 8 : b) * 6144 + 5 * 1024;
    for (int i = 0; i < 4; ++i) { const int col = tid + 256 * i; xr[col] += md[col] * (w0 * bf2f(Y[(size_t)s0 * 1024 + col]) + w1 * bf2f(Y[(size_t)s1 * 1024 + col])); }
}
__global__ void nv_final(float* xl, const float* fw) {
    const int row = blockIdx.x, tid = threadIdx.x; __shared__ float red[4];
    float* xr = xl + (size_t)row * DM; float v[4]; float ss = 0.f;
    for (int i = 0; i < 4; ++i) { v[i] = xr[tid + 256 * i]; ss += v[i] * v[i]; }
    ss = block_sum256(ss, red); const float rstd = rsqrtf(ss * (1.f / DM) + EPS);
    for (int i = 0; i < 4; ++i) xr[tid + 256 * i] = v[i] * rstd * fw[tid + 256 * i];
}

#define LAS __attribute__((address_space(3)))
#define GAS __attribute__((address_space(1)))
constexpr int NWAVES = 8, NTHR = 512;
constexpr int RING_BYTES = 131072, SCR_BYTES = 147456, LDSCTL_OFF = SCR_BYTES, MISC_OFF = LDSCTL_OFF + 320, LDS_BYTES = 163840;
constexpr size_t WS_EW13 = 102 * MiB;
constexpr size_t WS_EW2 = 134 * MiB;
constexpr size_t WS_AG = 366 * MiB;
constexpr size_t WS_PARTO = WS_KPT;
constexpr size_t WS_PARTM = 444 * MiB;
constexpr int CW_BAR = 4096;
constexpr int N_BAR_REGIONS = 24;
constexpr int PH_PRO = 0, PH_FINAL = 21, NPHASE = 22;
constexpr int K_NORM1 = 0, K_GEMM_IN = 1, K_PREP = 2, K_SCAN = 3, K_MIX = 4, K_GEMM_OUT = 5, K_NORM2 = 6, K_SLOTS = 7, K_MOE1 = 8, K_MOE2 = 9;

typedef float f32x4 __attribute__((ext_vector_type(4)));
typedef float f32x2 __attribute__((ext_vector_type(2)));
typedef unsigned u32x4 __attribute__((ext_vector_type(4)));
typedef unsigned u32x2 __attribute__((ext_vector_type(2)));
typedef short bf16x8 __attribute__((ext_vector_type(8)));
#define LDS_WAIT() asm volatile("s_waitcnt lgkmcnt(0)" ::: "memory")
#define VM_WAIT() asm volatile("s_waitcnt vmcnt(0)" ::: "memory")
__device__ __forceinline__ unsigned cvt_pk_bf16(float lo, float hi) { unsigned r; asm volatile("v_cvt_pk_bf16_f32 %0, %1, %2" : "=v"(r) : "v"(lo), "v"(hi)); return r; }
__device__ __forceinline__ unsigned ld_u32(const unsigned* p) { return __hip_atomic_load(p, __ATOMIC_RELAXED, __HIP_MEMORY_SCOPE_AGENT); }
__device__ __forceinline__ int ld_i32(const int* p) { return __hip_atomic_load(p, __ATOMIC_RELAXED, __HIP_MEMORY_SCOPE_AGENT); }
__device__ __forceinline__ float ld_f32(const float* p) { return __uint_as_float(__hip_atomic_load((const unsigned*)p, __ATOMIC_RELAXED, __HIP_MEMORY_SCOPE_AGENT)); }
__device__ __forceinline__ int lane_id() { int l; asm volatile("v_mbcnt_lo_u32_b32 %0, -1, 0\n\tv_mbcnt_hi_u32_b32 %0, -1, %0" : "=v"(l)); return l; }
__device__ __forceinline__ float wave_sum(float v) {
#pragma unroll
    for (int o = 1; o < 64; o <<= 1) v += __shfl_xor(v, o);
    return v;
}
__device__ __forceinline__ float fast_silu(float v) { return v * __builtin_amdgcn_rcpf(1.f + __expf(-v)); }

#define XB_TMO      128
#define XB_XCNT(j)  (256  + 64 * (j))
#define XB_XSUB(j)  (1280 + 64 * (j))
#define XB_XGEN(j)  (2304 + 64 * (j))
#define XB_TOP      3328
#define XB_TOPGEN   3392
#define XCD_BAR_WORDS 3456
#define XB_SPIN_CAP (1u << 18)
__device__ __forceinline__ unsigned xb_ld(unsigned* p)              { return __hip_atomic_load(p, __ATOMIC_RELAXED, __HIP_MEMORY_SCOPE_AGENT); }
__device__ __forceinline__ unsigned xb_add(unsigned* p, unsigned v) { return __hip_atomic_fetch_add(p, v, __ATOMIC_RELAXED, __HIP_MEMORY_SCOPE_AGENT); }
__device__ __forceinline__ unsigned xb_xcc_id() { return (unsigned)__builtin_amdgcn_s_getreg((3 << 11) | 20) & 0xFu; }
#define XB_SPIN(cond, bar) do { unsigned _sp = 0; while (cond) { __builtin_amdgcn_s_sleep(1); \
    if ((++_sp & 255u) == 0u) { if (xb_ld(&(bar)[XB_TMO])) break; if (_sp > XB_SPIN_CAP) { atomicAdd(&(bar)[XB_TMO], 1u); break; } } } } while (0)
struct XcdBarrier { unsigned* bar; unsigned x; volatile LAS unsigned* st; };
__device__ __forceinline__ XcdBarrier xcd_barrier_post(unsigned* bar, volatile LAS unsigned* st, bool leader) {
    XcdBarrier b; b.bar = bar; b.x = xb_xcc_id(); b.st = st;
    if (leader) (void)xb_add(&bar[XB_XCNT(b.x)], 1u);
    return b;
}
__device__ __forceinline__ void xcd_barrier_complete(unsigned* bar, unsigned x, unsigned& nloc, unsigned& nx) {
    const unsigned G = gridDim.x * gridDim.y * gridDim.z;
    unsigned sum, cnt, mine, sp = 0u;
    for (;;) {
        sum = 0u; cnt = 0u;
#pragma unroll
        for (unsigned j = 0; j < 16; ++j) { const unsigned c = xb_ld(&bar[XB_XCNT(j)]); sum += c; cnt += (c > 0u) ? 1u : 0u; }
        mine = xb_ld(&bar[XB_XCNT(x)]);
        if (sum == G) break;
        __builtin_amdgcn_s_sleep(1);
        if ((++sp & 255u) == 0u) { if (xb_ld(&bar[XB_TMO])) break; if (sp > XB_SPIN_CAP) { atomicAdd(&bar[XB_TMO], 1u); break; } }
    }
    nloc = mine > 0u ? mine : 1u; nx = cnt > 0u ? cnt : 1u;
}
__device__ __forceinline__ void xcd_barrier(const XcdBarrier& b, bool leader) {
    asm volatile("s_waitcnt vmcnt(0)" ::: "memory");
    __syncthreads();
    if (leader) {
        unsigned* bar = b.bar;
        __builtin_amdgcn_s_waitcnt(0);
        unsigned nloc = b.st[0], nx = b.st[1];
        if (nloc == 0u) { xcd_barrier_complete(bar, b.x, nloc, nx); b.st[0] = nloc; b.st[1] = nx; }
        const unsigned old = xb_add(&bar[XB_XSUB(b.x)], 1u);
        const unsigned gen = old / nloc;
        if (old + 1u == (gen + 1u) * nloc) {
            __builtin_amdgcn_fence(__ATOMIC_RELEASE, "agent");
            asm volatile("s_waitcnt vmcnt(0)" ::: "memory");
            const unsigned og = xb_add(&bar[XB_TOP], 1u);
            const unsigned tg = og / nx;
            if (og + 1u == (tg + 1u) * nx) xb_add(&bar[XB_TOPGEN], 1u);
            else XB_SPIN(xb_ld(&bar[XB_TOPGEN]) == tg, bar);
            __builtin_amdgcn_fence(__ATOMIC_ACQUIRE, "agent");
            xb_add(&bar[XB_XGEN(b.x)], 1u);
            asm volatile("s_waitcnt vmcnt(0)" ::: "memory");
        } else {
            XB_SPIN(xb_ld(&bar[XB_XGEN(b.x)]) == gen, bar);
            __builtin_amdgcn_fence(__ATOMIC_ACQUIRE, "agent");
            asm volatile("s_waitcnt vmcnt(0)" ::: "memory");
        }
    }
    __syncthreads();
}

namespace pg8 {
constexpr int BM = 256, BK = 64, HALF = 128, HTB = HALF * BK * 2, STAGE_BYTES = 8 * HTB, NXCD = 8, WGM = 8;
__host__ __device__ __forceinline__ int lds_byte(int r, int c) { const int st = (r >> 4) * 2 + (c >> 5), rr = r & 15, cc = c & 31, ob = rr * 64 + cc * 2; return st * 1024 + (ob ^ (((ob >> 9) & 1) << 5)); }
__host__ __device__ __forceinline__ void stage_rc(int b, int& R, int& C) { const int st = b / 1024, sb = b % 1024, swz = sb ^ (((sb >> 9) & 1) << 5); R = (st >> 1) * 16 + swz / 64; C = (st & 1) * 32 + (swz % 64) / 2; }
__host__ __device__ __forceinline__ int perm32(int rho) { const int n = rho >> 4, i = rho & 15; return 8 * (i >> 2) + 4 * n + (i & 3); }
struct Unit { int pm, pn; const char* A; const char* B; };
struct GridOrder {
    int nM, nN, nwg, G, c;
    __device__ void init(int nM_, int nN_, int G_, int c_) { nM = nM_; nN = nN_; nwg = nM * nN; G = G_; c = c_; }
    __device__ bool map(int i, int& pm, int& pn) const {
        const long L = (long)i * G + c; if (L >= nwg) return false;
        int wgid = (int)L; { const int q = nwg / NXCD, r = nwg % NXCD, xcd = wgid % NXCD, off = wgid / NXCD; wgid = (xcd < r ? xcd * (q + 1) : r * (q + 1) + (xcd - r) * q) + off; }
        const int nig = WGM * nN, gid = wgid / nig, fm = gid * WGM, gsz = (nM - fm) < WGM ? (nM - fm) : WGM;
        pm = fm + ((wgid % nig) % gsz); pn = (wgid % nig) / gsz; return true;
    }
};
template <class Epi, class Sched, bool ALIGN_EPI = true, bool SP2 = true>
__device__ __forceinline__ void gemm_phase(LAS unsigned char* lds, const int K, const Sched& S, const Epi& E, const int wave_) {
    int tid_ = wave_ * 64 + lane_id(); asm volatile("" : "+v"(tid_));
    const int tid = tid_, wid = __builtin_amdgcn_readfirstlane(tid >> 6), lane = tid & 63, wr = wid >> 2, wc = wid & 3, fr = lane & 15, fq = lane >> 4;
    const int nt = K / BK;
    unsigned voffA[2], voffB[2];
#pragma unroll
    for (int i = 0; i < 2; ++i) { int R, C; stage_rc(tid * 16 + i * 8192, R, C); const int Rb = Epi::PERM ? ((R & ~31) + perm32(R & 31)) : R;
        voffA[i] = (unsigned)(R * K + C) * 2u; voffB[i] = (unsigned)(Rb * K + C) * 2u; }
    const size_t kstep = (size_t)(BK * 2);
    const size_t hstep = (size_t)HALF * K * 2;
    const unsigned ldsw = (unsigned)wid * 1024u;
    const int aoff = lds_byte(wr * 64 + fr, fq * 8), boff = lds_byte(wc * 32 + fr, fq * 8);
#define PG8_SA(b, h) (((b) * 2 + (h)) * HTB)
#define PG8_SB(b, h) ((4 + (b) * 2 + (h)) * HTB)
#define PG8_STAGE(bufoff, gbase, voff) do { _Pragma("unroll") for (int _i = 0; _i < 2; ++_i) \
        __builtin_amdgcn_global_load_lds((const unsigned*)((const char*)(gbase) + (voff)[_i]), (LAS unsigned*)(lds + (bufoff) + ldsw + _i * 8192), 16, 0, 0); } while (0)
#define PG8_LDA(dst, b, h) do { _Pragma("unroll") for (int m = 0; m < 4; ++m) _Pragma("unroll") for (int k = 0; k < 2; ++k) dst[m][k] = *(const LAS bf16x8*)(lds + PG8_SA(b, h) + aoff + m * 2048 + k * 1024); } while (0)
#define PG8_LDB(dst, b, h) do { _Pragma("unroll") for (int n = 0; n < 2; ++n) _Pragma("unroll") for (int k = 0; k < 2; ++k) dst[n][k] = *(const LAS bf16x8*)(lds + PG8_SB(b, h) + boff + n * 2048 + k * 1024); } while (0)
#define PG8_MMA(ai, bj, At, Bt) do { __builtin_amdgcn_s_setprio(1); _Pragma("unroll") for (int m = 0; m < 4; ++m) _Pragma("unroll") for (int n = 0; n < 2; ++n) _Pragma("unroll") for (int k = 0; k < 2; ++k) \
        acc[ai][bj][m][n] = __builtin_amdgcn_mfma_f32_16x16x32_bf16(Bt[n][k], At[m][k], acc[ai][bj][m][n], 0, 0, 0); __builtin_amdgcn_s_setprio(0); } while (0)
#define PG8_WAIT_V(n) asm volatile("s_waitcnt vmcnt(" #n ")" ::: "memory")
#define PG8_WAIT_L(n) asm volatile("s_waitcnt lgkmcnt(" #n ")" ::: "memory")
#define PG8_BAR __builtin_amdgcn_s_barrier()
#define PG8_SCHED __builtin_amdgcn_sched_barrier(0)
    Unit cur, nxt; int ui = 0;
    if (!S.next(0, cur)) return;
    f32x4 acc[2][2][4][2];
#pragma unroll
    for (int a = 0; a < 2; ++a)
#pragma unroll
        for (int b = 0; b < 2; ++b)
#pragma unroll
            for (int m = 0; m < 4; ++m)
#pragma unroll
                for (int n = 0; n < 2; ++n) acc[a][b][m][n] = (f32x4){0.f, 0.f, 0.f, 0.f};
    bf16x8 At[4][2], B0[2][2], B1[2][2];
    const char* cA = cur.A; const char* cB = cur.B;
    if constexpr (SP2) {
        PG8_STAGE(PG8_SB(0, 0), cB, voffB); PG8_STAGE(PG8_SB(0, 1), cB + hstep, voffB); PG8_STAGE(PG8_SA(0, 0), cA, voffA); PG8_STAGE(PG8_SA(0, 1), cA + hstep, voffA);
        if (wr == 1) PG8_BAR;
        PG8_WAIT_V(2); PG8_BAR;
        PG8_STAGE(PG8_SB(1, 0), cB + kstep, voffB); PG8_STAGE(PG8_SA(1, 0), cA + kstep, voffA); PG8_STAGE(PG8_SB(1, 1), cB + hstep + kstep, voffB);
        PG8_WAIT_V(6); PG8_BAR;
    } else {
        PG8_STAGE(PG8_SB(0, 0), cB, voffB); PG8_STAGE(PG8_SA(0, 0), cA, voffA); PG8_STAGE(PG8_SB(0, 1), cB + hstep, voffB); PG8_STAGE(PG8_SA(0, 1), cA + hstep, voffA);
        if (wr == 1) PG8_BAR;
        PG8_WAIT_V(4); PG8_BAR;
        PG8_STAGE(PG8_SB(1, 0), cB + kstep, voffB); PG8_STAGE(PG8_SA(1, 0), cA + kstep, voffA); PG8_STAGE(PG8_SB(1, 1), cB + hstep + kstep, voffB);
        PG8_WAIT_V(6); PG8_BAR;
    }
    for (;;) {
        const bool has_next = S.next(ui + 1, nxt);
        const char* nA = has_next ? nxt.A : cA; const char* nB = has_next ? nxt.B : cB;
        for (int t = 0; t < nt; t += 2) {
            const bool last = (t == nt - 2);
            const char* a1 = cA + (size_t)(t + 1) * kstep;
            const char* a2 = last ? nA : cA + (size_t)(t + 2) * kstep; const char* b2 = last ? nB : cB + (size_t)(t + 2) * kstep;
            const char* a3 = a2 + kstep; const char* b3 = b2 + kstep;
            if constexpr (SP2) {
            PG8_LDB(B0, 0, 0); PG8_LDB(B1, 0, 1); PG8_SCHED; PG8_LDA(At, 0, 0); PG8_STAGE(PG8_SA(1, 1), a1 + hstep, voffA);
            PG8_WAIT_V(8); PG8_WAIT_L(0); PG8_BAR; PG8_MMA(0, 0, At, B0); PG8_MMA(0, 1, At, B1); PG8_BAR; PG8_SCHED;
            PG8_LDA(At, 0, 1); PG8_STAGE(PG8_SB(0, 0), b2, voffB); PG8_STAGE(PG8_SB(0, 1), b2 + hstep, voffB); PG8_STAGE(PG8_SA(0, 0), a2, voffA);
            PG8_WAIT_V(8); PG8_WAIT_L(0); PG8_BAR; PG8_MMA(1, 0, At, B0); PG8_MMA(1, 1, At, B1); PG8_BAR; PG8_SCHED;
            PG8_LDB(B0, 1, 0); PG8_LDB(B1, 1, 1); PG8_SCHED; PG8_LDA(At, 1, 0); PG8_STAGE(PG8_SA(0, 1), a2 + hstep, voffA);
            PG8_WAIT_V(8); PG8_WAIT_L(0); PG8_BAR; PG8_MMA(0, 0, At, B0); PG8_MMA(0, 1, At, B1); PG8_BAR; PG8_SCHED;
            PG8_LDA(At, 1, 1); PG8_STAGE(PG8_SB(1, 0), b3, voffB); PG8_STAGE(PG8_SB(1, 1), b3 + hstep, voffB); PG8_STAGE(PG8_SA(1, 0), a3, voffA);
            PG8_WAIT_V(8); PG8_WAIT_L(0); PG8_BAR; PG8_MMA(1, 0, At, B0); PG8_MMA(1, 1, At, B1); PG8_BAR; PG8_SCHED;
            } else {
            PG8_LDB(B0, 0, 0); PG8_SCHED; PG8_LDA(At, 0, 0); PG8_STAGE(PG8_SA(1, 1), a1 + hstep, voffA);
            PG8_WAIT_L(8); PG8_BAR; PG8_WAIT_L(0); PG8_MMA(0, 0, At, B0); PG8_BAR; PG8_SCHED;
            PG8_LDB(B1, 0, 1); PG8_STAGE(PG8_SB(0, 0), b2, voffB);
            PG8_BAR; PG8_WAIT_L(0); PG8_MMA(0, 1, At, B1); PG8_BAR;
            PG8_LDA(At, 0, 1); PG8_STAGE(PG8_SA(0, 0), a2, voffA);
            PG8_BAR; PG8_WAIT_L(0); PG8_MMA(1, 0, At, B0); PG8_BAR; PG8_SCHED;
            PG8_STAGE(PG8_SB(0, 1), b2 + hstep, voffB);
            PG8_WAIT_V(6); PG8_BAR; PG8_MMA(1, 1, At, B1); PG8_BAR;
            PG8_LDB(B0, 1, 0); PG8_SCHED; PG8_LDA(At, 1, 0); PG8_STAGE(PG8_SA(0, 1), a2 + hstep, voffA);
            PG8_WAIT_L(8); PG8_BAR; PG8_WAIT_L(0); PG8_MMA(0, 0, At, B0); PG8_BAR; PG8_SCHED;
            PG8_LDB(B1, 1, 1); PG8_STAGE(PG8_SB(1, 0), b3, voffB);
            PG8_BAR; PG8_WAIT_L(0); PG8_MMA(0, 1, At, B1); PG8_BAR;
            PG8_LDA(At, 1, 1); PG8_STAGE(PG8_SA(1, 0), a3, voffA);
            PG8_BAR; PG8_WAIT_L(0); PG8_MMA(1, 0, At, B0); PG8_BAR; PG8_SCHED;
            PG8_STAGE(PG8_SB(1, 1), b3 + hstep, voffB);
            PG8_WAIT_V(6); PG8_BAR; PG8_MMA(1, 1, At, B1); PG8_BAR;
            }
        }
        if constexpr (ALIGN_EPI) { if (wr == 0) PG8_BAR; }
        E(acc, cur, wr, wc, fr, fq);
        if (!has_next) break;
#pragma unroll
        for (int a = 0; a < 2; ++a)
#pragma unroll
            for (int b = 0; b < 2; ++b)
#pragma unroll
                for (int m = 0; m < 4; ++m)
#pragma unroll
                    for (int n = 0; n < 2; ++n) acc[a][b][m][n] = (f32x4){0.f, 0.f, 0.f, 0.f};
        cur = nxt; cA = nA; cB = nB; ++ui;
        if constexpr (ALIGN_EPI) { if (wr == 1) PG8_BAR; }
    }
    PG8_WAIT_V(0);
    if constexpr (!ALIGN_EPI) { if (wr == 0) PG8_BAR; }
    PG8_BAR;
#undef PG8_SA
#undef PG8_SB
#undef PG8_STAGE
#undef PG8_LDA
#undef PG8_LDB
#undef PG8_MMA
#undef PG8_WAIT_V
#undef PG8_WAIT_L
#undef PG8_BAR
#undef PG8_SCHED
}
}

struct SchedDense : pg8::GridOrder {
    const char* A; const char* B; size_t tstep;
    __device__ bool next(int i, pg8::Unit& u) const { int pm, pn; if (!map(i, pm, pn)) return false; u.pm = pm; u.pn = pn; u.A = A + (size_t)pm * tstep; u.B = B + (size_t)pn * tstep; return true; }
};
struct SchedLatent : pg8::GridOrder {
    const char* A; const char* B; size_t tstep; int lat;
    __device__ bool next(int i, pg8::Unit& u) const { int pm, pn; if (!map(i, pm, pn)) return false; if (lat) pm = pm + (pm >> 4) + 1; u.pm = pm; u.pn = pn; u.A = A + (size_t)pm * tstep; u.B = B + (size_t)pn * tstep; return true; }
};
struct SchedMoe : pg8::GridOrder {
    const char* A; const char* B; size_t tstep; const int* TILE_E;
    __device__ bool next(int i, pg8::Unit& u) const { int pm, pn; if (!map(i, pm, pn)) return false; const int e = __builtin_amdgcn_readfirstlane(ld_i32(TILE_E + pm)); u.pm = pm; u.pn = pn;
        u.A = A + (size_t)pm * tstep; u.B = B + ((size_t)e * 4 + pn) * tstep; return true; }
};

struct EpiInP {
    static constexpr bool PERM = true;
    bf16* QKRAW; bf16* PA; bf16* MVT; bf16* NVT; float* GATES; const float* gate_b;
    __device__ __forceinline__ void operator()(const f32x4 (&acc)[2][2][4][2], const pg8::Unit& u, int wr, int wc, int fr, int fq) const {
        const int pn = u.pn;
        if (pn < 10) {
            bf16* base; int ldc, colt; if (pn < 4) { base = QKRAW; ldc = 1024; colt = pn * 256; } else { base = PA; ldc = 1536; colt = (pn - 4) * 256; }
            const int row0 = u.pm * 256 + wr * 64 + fr, col0 = colt + wc * 32 + 8 * fq;
#pragma unroll
            for (int ai = 0; ai < 2; ++ai)
#pragma unroll
                for (int m = 0; m < 4; ++m) { bf16* rowp = base + (size_t)(row0 + ai * 128 + m * 16) * ldc + col0;
#pragma unroll
                    for (int bj = 0; bj < 2; ++bj) { const f32x4 v0 = acc[ai][bj][m][0], v1 = acc[ai][bj][m][1];
                        u32x4 w; w.x = cvt_pk_bf16(v0[0], v0[1]); w.y = cvt_pk_bf16(v0[2], v0[3]); w.z = cvt_pk_bf16(v1[0], v1[1]); w.w = cvt_pk_bf16(v1[2], v1[3]);
                        *(u32x4*)(rowp + bj * 128) = w; } }
        } else if (pn < 14) {
            const int b = u.pm / 17, ub = (u.pm % 17) * 256 + wr * 64 + fr;
#pragma unroll
            for (int bj = 0; bj < 2; ++bj)
#pragma unroll
                for (int n = 0; n < 2; ++n)
#pragma unroll
                    for (int j = 0; j < 4; ++j) {
                        bf16* dst;
                        if (pn < 12) { const int head = (pn - 10) * 2 + bj, dv = wc * 32 + fq * 8 + n * 4 + j; dst = MVT + ((size_t)(b * 4 + head) * 128 + dv) * UT; }
                        else { const int head = (pn - 12) * 4 + bj * 2 + (wc >> 1), dv = (wc & 1) * 32 + fq * 8 + n * 4 + j; dst = NVT + ((size_t)(b * 8 + head) * 64 + dv) * UT; }
#pragma unroll
                        for (int ai = 0; ai < 2; ++ai)
#pragma unroll
                            for (int m = 0; m < 4; ++m) dst[ub + ai * 128 + m * 16] = f2bf(acc[ai][bj][m][n][j]);
                    }
        } else {
            if (wc == 0 && fq < 2) {
                const int row0 = u.pm * 256 + wr * 64 + fr;
#pragma unroll
                for (int n = 0; n < 2; ++n) { const f32x4 gb = *(const f32x4*)(gate_b + fq * 8 + n * 4);
#pragma unroll
                    for (int ai = 0; ai < 2; ++ai)
#pragma unroll
                        for (int m = 0; m < 4; ++m) *(f32x4*)(GATES + (size_t)(row0 + ai * 128 + m * 16) * 16 + fq * 8 + n * 4) = acc[ai][0][m][n] + gb; }
            }
        }
    }
};
struct EpiOutP {
    static constexpr bool PERM = false;
    const float* sl; const float* sc; float* dl; float* dc; const float* MODl;
    __device__ __forceinline__ void operator()(const f32x4 (&acc)[2][2][4][2], const pg8::Unit& u, int wr, int wc, int fr, int fq) const {
        const int b = u.pm / 17, pu = u.pm % 17; const bool ctx = (pu == 0);
        const size_t rbase = ctx ? (size_t)b * CTXL : (size_t)b * SEQ + (size_t)(pu - 1) * 256;
        const float* src = (ctx ? sc : sl) + rbase * DM; float* dst = (ctx ? dc : dl) + rbase * DM;
        const float* md = MODl + (size_t)(ctx ? 8 : b) * 6144 + 2048;
        const int col0 = u.pn * 256 + wc * 32 + 4 * fq, r0 = wr * 64 + fr;
#pragma unroll
        for (int bj = 0; bj < 2; ++bj)
#pragma unroll
            for (int n = 0; n < 2; ++n) { const f32x4 mv = *(const f32x4*)(md + col0 + bj * 128 + n * 16);
#pragma unroll
                for (int ai = 0; ai < 2; ++ai) {
#pragma unroll
                    for (int m = 0; m < 4; ++m) { const size_t off = (size_t)(r0 + ai * 128 + m * 16) * DM + col0 + bj * 128 + n * 16;
                        const f32x4 bs = *(const f32x4*)(src + off); *(f32x4*)(dst + off) = bs + mv * acc[ai][bj][m][n]; }
                    asm volatile("" ::: "memory"); } }
    }
};
struct EpiMoe1 {
    static constexpr bool PERM = true;
    bf16* ACTM;
    __device__ __forceinline__ void operator()(const f32x4 (&acc)[2][2][4][2], const pg8::Unit& u, int wr, int wc, int fr, int fq) const {
        const int row0 = u.pm * 256 + wr * 64 + fr;
#pragma unroll
        for (int ai = 0; ai < 2; ++ai)
#pragma unroll
            for (int m = 0; m < 4; ++m) { bf16* rowp = ACTM + (size_t)(row0 + ai * 128 + m * 16) * 512;
#pragma unroll
                for (int bj = 0; bj < 2; ++bj) { const int j0 = (u.pn * 256 + bj * 128 + wc * 32 + fq * 8) >> 1; const f32x4 g1 = acc[ai][bj][m][0], g3 = acc[ai][bj][m][1];
                    u32x2 w; w.x = cvt_pk_bf16(fast_silu(g1[0]) * g3[0], fast_silu(g1[1]) * g3[1]); w.y = cvt_pk_bf16(fast_silu(g1[2]) * g3[2], fast_silu(g1[3]) * g3[3]);
                    *(u32x2*)(rowp + j0) = w; } }
    }
};
struct EpiMoe2 {
    static constexpr bool PERM = true;
    bf16* Y;
    __device__ __forceinline__ void operator()(const f32x4 (&acc)[2][2][4][2], const pg8::Unit& u, int wr, int wc, int fr, int fq) const {
        const int row0 = u.pm * 256 + wr * 64 + fr, col0 = u.pn * 256 + wc * 32 + 8 * fq;
#pragma unroll
        for (int ai = 0; ai < 2; ++ai)
#pragma unroll
            for (int m = 0; m < 4; ++m) { bf16* rowp = Y + (size_t)(row0 + ai * 128 + m * 16) * 1024 + col0;
#pragma unroll
                for (int bj = 0; bj < 2; ++bj) { const f32x4 v0 = acc[ai][bj][m][0], v1 = acc[ai][bj][m][1];
                    u32x4 w; w.x = cvt_pk_bf16(v0[0], v0[1]); w.y = cvt_pk_bf16(v0[2], v0[3]); w.z = cvt_pk_bf16(v1[0], v1[1]); w.w = cvt_pk_bf16(v1[2], v1[3]);
                    *(u32x4*)(rowp + bj * 128) = w; } }
    }
};

struct Args { const float* in[21]; float* out; unsigned char* ws; int ph_lo, ph_hi, bar_region, mixflags; };
typedef const Args __attribute__((address_space(4)))* KargP;
__device__ __forceinline__ KargP kargs() { KargP p = (KargP)__builtin_amdgcn_kernarg_segment_ptr(); asm volatile("" : "+s"(p)); return p; }
struct Ctx { LAS unsigned char* lds; int wave, G, gw, ngw; };

__device__ __forceinline__ void conv_item(const float* sp, float msk, size_t ld, bf16* dst, int K, int n0, int k0, LAS float* scr, int lane) {
#pragma unroll 8
    for (int i = 0; i < 32; ++i) { const int kk = 2 * i + (lane >> 5); scr[kk * 33 + (lane & 31)] = sp[(size_t)(k0 + kk) * ld] * msk; }
    LDS_WAIT(); asm volatile("" ::: "memory");
    const int c = lane & 7;
#pragma unroll
    for (int j = 0; j < 4; ++j) { const int n = (lane >> 3) + 8 * j; const LAS float* s = scr + (8 * c) * 33 + n;
        u32x4 o; o.x = cvt_pk_bf16(s[0 * 33], s[1 * 33]); o.y = cvt_pk_bf16(s[2 * 33], s[3 * 33]); o.z = cvt_pk_bf16(s[4 * 33], s[5 * 33]); o.w = cvt_pk_bf16(s[6 * 33], s[7 * 33]);
        *(u32x4*)(dst + (size_t)(n0 + n) * K + k0 + 8 * c) = o; }
    LDS_WAIT(); asm volatile("" ::: "memory");
}
__device__ __forceinline__ int win_src(int n) {
    if (n < 512) return n;
    if (n < 1024) return 1536 + (n - 512);
    if (n < 1536) return 512 + (n - 1024);
    if (n < 2048) return 1024 + (n - 1536);
    if (n < 2560) return 2576 + (n - 2048);
    if (n < 3072) return 2048 + (n - 2560);
    if (n < 3584) return 3088 + (n - 3072);
    if (n < 3600) return 2560 + (n - 3584);
    return -1;
}
__device__ __forceinline__ void phase_prologue(const Ctx& X) {
    KargP ka = kargs(); unsigned char* const ws = ka->ws; (void)ka; (void)ws;
    int tid_ = X.wave * 64 + lane_id(); asm volatile("" : "+v"(tid_)); const int TID = tid_, LANE = tid_ & 63;
    LAS float* s = (LAS float*)X.lds;
    LAS float* red = s + 9 * 1024;
    for (int i = TID; i < 9 * 1024; i += NTHR) { const int r = i >> 10, k = i & 1023; const float v = r < 8 ? ka->in[1][r * 1024 + k] : ka->in[3][k]; s[i] = v / (1.f + __expf(-v)); }
    __syncthreads();
    const int gc0 = blockIdx.x * 48, l = gc0 / 6144, j0 = gc0 % 6144;
    if (blockIdx.x < 256) {
        const int kq = TID / 48, col = TID % 48;
        if (kq < 10) {
            float a[9];
#pragma unroll
            for (int r = 0; r < 9; ++r) a[r] = 0.f;
            const float* w = ka->in[4] + (size_t)l * 1024 * 6144 + j0 + col;
            for (int k = kq; k < 1024; k += 10) { const float wv = w[(size_t)k * 6144];
#pragma unroll
                for (int r = 0; r < 9; ++r) a[r] += s[r * 1024 + k] * wv; }
#pragma unroll
            for (int r = 0; r < 9; ++r) red[(kq * 9 + r) * 48 + col] = a[r];
        }
        __syncthreads();
        if (TID < 432) { const int r = TID / 48, col = TID % 48; float a = 0.f;
#pragma unroll
            for (int q = 0; q < 10; ++q) a += red[(q * 9 + r) * 48 + col];
            ((float*)(ws + WS_MOD))[((size_t)l * 9 + r) * 6144 + j0 + col] = a + ka->in[5][l * 6144 + j0 + col]; }
    }
    __syncthreads();
    LAS float* scr = (LAS float*)(X.lds + X.wave * 16384);
    constexpr int I_IN = 120 * 16, I_OUT = 32 * 16, NIT = 2 * (I_IN + I_OUT);
    for (int it = X.gw; it < NIT; it += X.ngw) {
        int r = it; const int ly = r / (I_IN + I_OUT); r -= ly * (I_IN + I_OUT);
        if (r < I_IN) { const int nb = r / 16, kb = r % 16, n = nb * 32 + (LANE & 31), sc = win_src(n);
            conv_item(ka->in[7] + (size_t)ly * 1024 * N_IN + (sc < 0 ? 0 : sc), sc < 0 ? 0.f : 1.f, N_IN, (bf16*)(ws + WS_WIN) + (size_t)ly * 3840 * 1024, 1024, nb * 32, kb * 64, scr, LANE); }
        else { r -= I_IN; const int nb = r / 16, kb = r % 16;
            conv_item(ka->in[13] + (size_t)ly * 1024 * 1024 + nb * 32 + (LANE & 31), 1.f, 1024, (bf16*)(ws + WS_WOUT) + (size_t)ly * 1024 * 1024, 1024, nb * 32, kb * 64, scr, LANE); }
    }
}
__device__ __forceinline__ void convert_experts(const Ctx& X, int ly) {
    KargP ka = kargs(); unsigned char* const ws = ka->ws; (void)ka; (void)ws;
    int tid_ = X.wave * 64 + lane_id(); asm volatile("" : "+v"(tid_)); const int TID = tid_, LANE = tid_ & 63;
    LAS float* scr = (LAS float*)(X.lds + X.wave * 16384);
    constexpr int I13 = 16 * 32 * 16, I2 = 16 * 32 * 8;
    for (int it = X.gw; it < I13 + I2; it += X.ngw) {
        if (it < I13) { const int e = it / 512, r = it % 512, nb = r / 16, kb = r % 16, n = nb * 32 + (LANE & 31), g = n >> 3, i = n & 7;
            const float* src = (i < 4 ? ka->in[17] : ka->in[18]) + ((size_t)ly * 16 + e) * 1024 * 512 + 4 * g + (i & 3);
            conv_item(src, 1.f, 512, (bf16*)(ws + WS_EW13) + (size_t)e * 1024 * 1024, 1024, nb * 32, kb * 64, scr, LANE); }
        else { const int r0 = it - I13, e = r0 / 256, r = r0 % 256, nb = r / 8, kb = r % 8;
            conv_item(ka->in[19] + ((size_t)ly * 16 + e) * 512 * 1024 + nb * 32 + (LANE & 31), 1.f, 1024, (bf16*)(ws + WS_EW2) + (size_t)e * 1024 * 512, 512, nb * 32, kb * 64, scr, LANE); }
    }
}

template <bool COMBINE, bool ROUTER, bool FINAL>
__device__ __forceinline__ void rows_phase(const Ctx& X, const float* xl_src, const float* xc_src, float* xl_dst, float* xc_dst, const float* nw, const float* MODn, int sh, int sc,
                                           const float* MODc  , bool latent_only, int lyr) {
    KargP ka = kargs(); unsigned char* const ws = ka->ws; (void)ka; (void)ws;
    int tid_ = X.wave * 64 + lane_id(); asm volatile("" : "+v"(tid_)); const int TID = tid_, LANE = tid_ & 63;
    bf16* ACT = (bf16*)(ws + WS_ACT); const bf16* Y = (const bf16*)(ws + WS_Y);
    const int* TOK_SLOT = (const int*)(ws + WS_ROUTE + RT_TOK_SLOT); const float* TOK_Wc = (const float*)(ws + WS_ROUTE + RT_TOK_W);
    int* TOK_E = (int*)(ws + WS_ROUTE + RT_TOK_E); float* TOK_W = (float*)(ws + WS_ROUTE + RT_TOK_W);
    LAS float* rwL = (LAS float*)X.lds;
    LAS unsigned* hist = (LAS unsigned*)(X.lds + 65536);
    if (ROUTER) {
        for (int i = TID; i < 16384; i += NTHR) { const int cidx = i >> 4, e = i & 15; const int ji = (cidx >> 8) * 4 + (cidx & 3), ln = (cidx & 255) >> 2;
            rwL[((ji * 4 + (e >> 2)) * 64 + ln) * 4 + (e & 3)] = ka->in[15][i]; }
        if (TID < 16) hist[TID] = 0u;
        __syncthreads();
    }
    const int nrow = latent_only ? 16 : 17;
    int key = -1; f32x4 wv[4], shv[4], m5[4];
    for (int i = 0; i < nrow; ++i) {
        int row, b, u;
        if (latent_only) { const int lr = X.gw * 16 + i; b = lr >> 12; u = CTXL + (lr & 4095); row = b * UT + u; }
        else { row = X.gw * 17 + i; b = row / UT; u = row - b * UT; }
        const bool ctx = u < CTXL; const int k2 = ctx ? 8 : b;
        if (k2 != key) { key = k2;
#pragma unroll
            for (int j = 0; j < 4; ++j) { const int col = 4 * LANE + 256 * j;
                if (FINAL) wv[j] = *(const f32x4*)(nw + col);
                else { const f32x4 w = *(const f32x4*)(nw + col), s1 = *(const f32x4*)(MODn + (size_t)k2 * 6144 + sc * 1024 + col); wv[j] = w * (1.f + s1); shv[j] = *(const f32x4*)(MODn + (size_t)k2 * 6144 + sh * 1024 + col); }
                if (COMBINE) m5[j] = *(const f32x4*)(MODc + (size_t)k2 * 6144 + 5 * 1024 + col); } }
        const size_t xoff = ctx ? ((size_t)b * CTXL + u) * DM : ((size_t)b * SEQ + (u - CTXL)) * DM;
        const float* xs = (ctx ? xc_src : xl_src) + xoff;
        f32x4 v[4];
#pragma unroll
        for (int j = 0; j < 4; ++j) v[j] = *(const f32x4*)(xs + 4 * LANE + 256 * j);
        if (COMBINE) {
            const int s0 = __builtin_amdgcn_readfirstlane(ld_i32(TOK_SLOT + row * 2)), s1 = __builtin_amdgcn_readfirstlane(ld_i32(TOK_SLOT + row * 2 + 1));
            const float w0 = ld_f32(TOK_Wc + row * 2), w1 = ld_f32(TOK_Wc + row * 2 + 1);
#pragma unroll
            for (int j = 0; j < 4; ++j) { const u32x2 a = *(const u32x2*)(Y + (size_t)s0 * 1024 + 4 * LANE + 256 * j), bq = *(const u32x2*)(Y + (size_t)s1 * 1024 + 4 * LANE + 256 * j);
                f32x4 ya, yb; ya[0] = __uint_as_float(a.x << 16); ya[1] = __uint_as_float(a.x & 0xffff0000u); ya[2] = __uint_as_float(a.y << 16); ya[3] = __uint_as_float(a.y & 0xffff0000u);
                yb[0] = __uint_as_float(bq.x << 16); yb[1] = __uint_as_float(bq.x & 0xffff0000u); yb[2] = __uint_as_float(bq.y << 16); yb[3] = __uint_as_float(bq.y & 0xffff0000u);
                v[j] = v[j] + m5[j] * (w0 * ya + w1 * yb); }
            if (!FINAL) { float* xd = (ctx ? xc_dst : xl_dst) + xoff;
#pragma unroll
                for (int j = 0; j < 4; ++j) *(f32x4*)(xd + 4 * LANE + 256 * j) = v[j]; }
        }
        float ss = 0.f;
#pragma unroll
        for (int j = 0; j < 4; ++j) ss += (v[j][0] * v[j][0] + v[j][1] * v[j][1]) + (v[j][2] * v[j][2] + v[j][3] * v[j][3]);
        const float rstd = rsqrtf(wave_sum(ss) * (1.f / DM) + EPS);
        if (FINAL) { float* xd = xl_dst + xoff;
#pragma unroll
            for (int j = 0; j < 4; ++j) *(f32x4*)(xd + 4 * LANE + 256 * j) = v[j] * rstd * wv[j];
            continue; }
        f32x4 h[4];
#pragma unroll
        for (int j = 0; j < 4; ++j) { h[j] = v[j] * rstd * wv[j] + shv[j]; u32x2 o; o.x = cvt_pk_bf16(h[j][0], h[j][1]); o.y = cvt_pk_bf16(h[j][2], h[j][3]); *(u32x2*)(ACT + (size_t)row * DM + 4 * LANE + 256 * j) = o; }
        if (ROUTER) {
            float p[16];
#pragma unroll
            for (int e = 0; e < 16; ++e) p[e] = 0.f;
#pragma unroll
            for (int j = 0; j < 4; ++j)
#pragma unroll
                for (int ii = 0; ii < 4; ++ii)
#pragma unroll
                    for (int q = 0; q < 4; ++q) { const f32x4 w = *(const LAS f32x4*)(rwL + (((j * 4 + ii) * 4 + q) * 64 + LANE) * 4);
                        p[4 * q + 0] += h[j][ii] * w[0]; p[4 * q + 1] += h[j][ii] * w[1]; p[4 * q + 2] += h[j][ii] * w[2]; p[4 * q + 3] += h[j][ii] * w[3]; }
            float q8[8], q4[4], q2[2], q1;
            { const bool hi = (LANE & 32) != 0;
#pragma unroll
              for (int t = 0; t < 8; ++t) { const float snd = hi ? p[t] : p[t + 8], kp = hi ? p[t + 8] : p[t]; q8[t] = kp + __shfl_xor(snd, 32); } }
            { const bool hi = (LANE & 16) != 0;
#pragma unroll
              for (int t = 0; t < 4; ++t) { const float snd = hi ? q8[t] : q8[t + 4], kp = hi ? q8[t + 4] : q8[t]; q4[t] = kp + __shfl_xor(snd, 16); } }
            { const bool hi = (LANE & 8) != 0;
#pragma unroll
              for (int t = 0; t < 2; ++t) { const float snd = hi ? q4[t] : q4[t + 2], kp = hi ? q4[t + 2] : q4[t]; q2[t] = kp + __shfl_xor(snd, 8); } }
            { const bool hi = (LANE & 4) != 0; const float snd = hi ? q2[0] : q2[1], kp = hi ? q2[1] : q2[0]; q1 = kp + __shfl_xor(snd, 4); }
            q1 += __shfl_xor(q1, 1); q1 += __shfl_xor(q1, 2);
            float lg[16]; float mx = -1e30f;
#pragma unroll
            for (int e = 0; e < 16; ++e) { lg[e] = __uint_as_float(__builtin_amdgcn_readlane(__float_as_uint(q1), 4 * e)); mx = fmaxf(mx, lg[e]); }
            float sum = 0.f;
#pragma unroll
            for (int e = 0; e < 16; ++e) { lg[e] = expf(lg[e] - mx); sum += lg[e]; }
            float sel[16];
#pragma unroll
            for (int e = 0; e < 16; ++e) { lg[e] = lg[e] / sum; sel[e] = lg[e] + ka->in[16][e]; }
            int best = 0; float bgs = -1e30f;
#pragma unroll
            for (int g = 0; g < 4; ++g) { float m1 = -1e30f, m2 = -1e30f;
#pragma unroll
                for (int k = 0; k < 4; ++k) { const float sv = sel[4 * g + k]; const bool gt1 = sv > m1, gt2 = sv > m2; m2 = gt1 ? m1 : (gt2 ? sv : m2); m1 = gt1 ? sv : m1; }
                if (m1 + m2 > bgs) { bgs = m1 + m2; best = g; } }
            float sg[4], pg[4];
#pragma unroll
            for (int k = 0; k < 4; ++k) { sg[k] = best == 0 ? sel[k] : best == 1 ? sel[4 + k] : best == 2 ? sel[8 + k] : sel[12 + k]; pg[k] = best == 0 ? lg[k] : best == 1 ? lg[4 + k] : best == 2 ? lg[8 + k] : lg[12 + k]; }
            int i0 = 0; float s0v = sg[0], p0 = pg[0];
#pragma unroll
            for (int k = 1; k < 4; ++k) if (sg[k] > s0v) { s0v = sg[k]; i0 = k; p0 = pg[k]; }
            int i1 = -1; float s1v = -1e30f, p1 = 0.f;
#pragma unroll
            for (int k = 0; k < 4; ++k) if (k != i0 && (i1 < 0 || sg[k] > s1v)) { s1v = sg[k]; i1 = k; p1 = pg[k]; }
            if (LANE == 0) { const int e0 = 4 * best + i0, e1 = 4 * best + i1; const float wsum = p0 + p1;
                TOK_E[row * 2] = e0; TOK_E[row * 2 + 1] = e1; TOK_W[row * 2] = p0 / wsum; TOK_W[row * 2 + 1] = p1 / wsum;
                __hip_atomic_fetch_add(hist + e0, 1u, __ATOMIC_RELAXED, __HIP_MEMORY_SCOPE_WORKGROUP); __hip_atomic_fetch_add(hist + e1, 1u, __ATOMIC_RELAXED, __HIP_MEMORY_SCOPE_WORKGROUP); }
        }
    }
    if (ROUTER) {
        __syncthreads();
        if (TID < 16) __hip_atomic_fetch_add(((unsigned*)ws) + CW_CNT + 32 * lyr + TID, hist[TID], __ATOMIC_RELAXED, __HIP_MEMORY_SCOPE_AGENT);
    }
}

__device__ __forceinline__ void phase_slots(const Ctx& X, int lyr, bool latent_only) {
    KargP ka = kargs(); unsigned char* const ws = ka->ws; (void)ka; (void)ws;
    int tid_ = X.wave * 64 + lane_id(); asm volatile("" : "+v"(tid_)); const int TID = tid_, LANE = tid_ & 63;
    LAS unsigned* off = (LAS unsigned*)X.lds;
    LAS unsigned* lcnt = off + 32;
    LAS unsigned* lbase = off + 64;
    const int* TOK_E = (const int*)(ws + WS_ROUTE + RT_TOK_E); const float* TOK_W = (const float*)(ws + WS_ROUTE + RT_TOK_W);
    int* TOK_SLOT = (int*)(ws + WS_ROUTE + RT_TOK_SLOT); int* SLOT_TOK = (int*)(ws + WS_ROUTE + RT_SLOT_TOK); float* SLOT_W = (float*)(ws + WS_ROUTE + RT_SLOT_W); int* TILE_E = (int*)(ws + WS_ROUTE + RT_TILE_E) + 512 * lyr;
    const bf16* ACT = (const bf16*)(ws + WS_ACT); bf16* AG = (bf16*)(ws + WS_AG);
    unsigned* CNT = ((unsigned*)ws) + CW_CNT + 32 * lyr; unsigned* CUR = ((unsigned*)ws) + CW_CUR + 32 * lyr;
    if (TID == 0) { unsigned o = 0; for (int e = 0; e < 16; ++e) { off[e] = o; o += (ld_u32(CNT + e) + 255u) & ~255u; } off[16] = o; }
    if (TID < 16) lcnt[TID] = 0u;
    __syncthreads();
    if (blockIdx.x == 0) {
        if (TID == 0) { for (int e = 0; e <= 16; ++e) ((unsigned*)ws)[CW_OFF + 32 * lyr + e] = off[e]; ((unsigned*)ws)[CW_NT + 32 * lyr] = off[16] >> 8; }
        for (int e = 0; e < 16; ++e) { const unsigned cnt = ld_u32(CNT + e);
            for (unsigned i = off[e] + cnt + TID; i < off[e + 1]; i += NTHR) { SLOT_TOK[i] = 0; SLOT_W[i] = 0.f; }
            for (unsigned t = (off[e] >> 8) + TID; t < (off[e + 1] >> 8); t += NTHR) TILE_E[t] = e; }
    }
    const int nrow = latent_only ? 16 : 17;
    int row = -1, e0 = 0, e1 = 0; unsigned lp0 = 0, lp1 = 0;
    if (LANE < nrow) {
        if (latent_only) { const int lr = X.gw * 16 + LANE; row = (lr >> 12) * UT + CTXL + (lr & 4095); } else row = X.gw * 17 + LANE;
        e0 = TOK_E[row * 2]; e1 = TOK_E[row * 2 + 1];
        lp0 = __hip_atomic_fetch_add(lcnt + e0, 1u, __ATOMIC_RELAXED, __HIP_MEMORY_SCOPE_WORKGROUP); lp1 = __hip_atomic_fetch_add(lcnt + e1, 1u, __ATOMIC_RELAXED, __HIP_MEMORY_SCOPE_WORKGROUP);
    }
    __syncthreads();
    if (TID < 16) lbase[TID] = off[TID] + __hip_atomic_fetch_add(CUR + TID, lcnt[TID], __ATOMIC_RELAXED, __HIP_MEMORY_SCOPE_AGENT);
    __syncthreads();
    int s0 = 0, s1 = 0;
    if (LANE < nrow) { s0 = (int)(lbase[e0] + lp0); s1 = (int)(lbase[e1] + lp1); TOK_SLOT[row * 2] = s0; TOK_SLOT[row * 2 + 1] = s1;
        SLOT_TOK[s0] = row; SLOT_TOK[s1] = row; SLOT_W[s0] = TOK_W[row * 2]; SLOT_W[s1] = TOK_W[row * 2 + 1]; }
    for (int i = 0; i < nrow; ++i) {
        const int r = __shfl(row, i), a = __shfl(s0, i), bq = __shfl(s1, i);
        const u32x4* src = (const u32x4*)(ACT + (size_t)r * DM);
        const u32x4 v0 = src[LANE], v1 = src[64 + LANE];
        u32x4* d0 = (u32x4*)(AG + (size_t)a * DM); u32x4* d1 = (u32x4*)(AG + (size_t)bq * DM);
        d0[LANE] = v0; d0[64 + LANE] = v1; d1[LANE] = v0; d1[64 + LANE] = v1;
    }
}


__device__ __forceinline__ void unpack8(const u32x4 v, float (&f)[8]) {
    f[0] = __uint_as_float(v.x << 16); f[1] = __uint_as_float(v.x & 0xffff0000u); f[2] = __uint_as_float(v.y << 16); f[3] = __uint_as_float(v.y & 0xffff0000u);
    f[4] = __uint_as_float(v.z << 16); f[5] = __uint_as_float(v.z & 0xffff0000u); f[6] = __uint_as_float(v.w << 16); f[7] = __uint_as_float(v.w & 0xffff0000u);
}
__device__ __forceinline__ void phase_prep(const Ctx& X, int l) {
    KargP ka = kargs(); unsigned char* const ws = ka->ws; (void)ka; (void)ws;
    int tid_ = X.wave * 64 + lane_id(); asm volatile("" : "+v"(tid_)); const int TID = tid_, LANE = tid_ & 63;
    LAS float* tcos = (LAS float*)X.lds; LAS float* tsin = tcos + 2048;
    for (int i = TID; i < 2048; i += NTHR) { const int pos = i >> 5, ii = i & 31; const float inv = exp2f(-(float)(2 * ii) * (13.287712379549449f / 64.f)); const float ang = (float)pos * inv; tcos[i] = cosf(ang); tsin[i] = sinf(ang); }
    __syncthreads();
    const bf16* QKRAW = (const bf16*)(ws + WS_QKRAW); bf16* QP = (bf16*)(ws + WS_QP); bf16* KP = (bf16*)(ws + WS_KP); bf16* KPT = (bf16*)(ws + WS_KPT);
    const float* cw = ka->in[8] + l * 3072; const float* cb = ka->in[9] + l * 1024;
    const int hd = LANE >> 4, d0 = 8 * (LANE & 15), blk = (LANE & 15) >> 3, i0 = 8 * (LANE & 3); const bool low = (LANE & 7) < 4;
#pragma unroll 1
    for (int it = X.gw; it < 2 * (MROWS / 8); it += X.ngw) {
        const int hf = it & 1, grp = it >> 1, b = grp / (UT / 8), u0 = (grp - b * (UT / 8)) * 8, col0 = hf * 512 + 8 * LANE;
        const int seglo = u0 < CTXL ? 0 : CTXL, seghi = u0 < CTXL ? CTXL : UT;
        const size_t rowb = (size_t)b * UT + u0;
        float w0[8], w1[8], w2[8], bb[8];
#pragma unroll
        for (int j = 0; j < 8; ++j) { w0[j] = cw[col0 + j]; w1[j] = cw[1024 + col0 + j]; w2[j] = cw[2048 + col0 + j]; bb[j] = cb[col0 + j]; }
        float xp[8], xc[8], xr[8];
        if (u0 > seglo) unpack8(*(const u32x4*)(QKRAW + (rowb - 1) * 1024 + col0), xp); else {
#pragma unroll
            for (int j = 0; j < 8; ++j) xp[j] = 0.f; }
        unpack8(*(const u32x4*)(QKRAW + rowb * 1024 + col0), xc);
        u32x4 o[8];
#pragma unroll
        for (int i = 0; i < 8; ++i) {
            const int u = u0 + i;
            if (u + 1 < seghi) unpack8(*(const u32x4*)(QKRAW + (rowb + i + 1) * 1024 + col0), xr); else {
#pragma unroll
                for (int j = 0; j < 8; ++j) xr[j] = 0.f; }
            float s[8];
#pragma unroll
            for (int j = 0; j < 8; ++j) { const float y = bb[j] + w0[j] * xp[j] + w1[j] * xc[j] + w2[j] * xr[j]; s[j] = y * __builtin_amdgcn_rcpf(1.f + __expf(-y)); }
            if (u0 >= CTXL) {
                const int t = u - CTXL, pos = blk ? (t & 63) : (t >> 6);
                const f32x4 c0 = *(const LAS f32x4*)(tcos + pos * 32 + i0), c1 = *(const LAS f32x4*)(tcos + pos * 32 + i0 + 4), s0 = *(const LAS f32x4*)(tsin + pos * 32 + i0), s1 = *(const LAS f32x4*)(tsin + pos * 32 + i0 + 4);
#pragma unroll
                for (int j = 0; j < 8; ++j) { const float pv = __shfl_xor(s[j], 4); const float cs = j < 4 ? c0[j & 3] : c1[j & 3], sn = j < 4 ? s0[j & 3] : s1[j & 3]; s[j] = s[j] * cs + (low ? -pv : pv) * sn; }
            }
            if (hf == 1) {
#pragma unroll
                for (int j = 0; j < 8; ++j) s[j] *= 0.08838834764831845f; }
            o[i].x = cvt_pk_bf16(s[0], s[1]); o[i].y = cvt_pk_bf16(s[2], s[3]); o[i].z = cvt_pk_bf16(s[4], s[5]); o[i].w = cvt_pk_bf16(s[6], s[7]);
            if (hf == 0) *(u32x4*)(QP + (rowb + i) * 512 + 8 * LANE) = o[i]; else *(u32x4*)(KP + (rowb + i) * 512 + 8 * LANE) = o[i];
#pragma unroll
            for (int j = 0; j < 8; ++j) { xp[j] = xc[j]; xc[j] = xr[j]; }
        }
        if (hf == 1) {
            bf16* kt = KPT + ((size_t)(b * 4 + hd) * 128 + d0) * UT + u0;
#pragma unroll
            for (int j = 0; j < 8; ++j) { u32x4 tv;
#pragma unroll
                for (int q = 0; q < 4; ++q) { const unsigned a = j < 2 ? o[2 * q].x : j < 4 ? o[2 * q].y : j < 6 ? o[2 * q].z : o[2 * q].w, c = j < 2 ? o[2 * q + 1].x : j < 4 ? o[2 * q + 1].y : j < 6 ? o[2 * q + 1].z : o[2 * q + 1].w;
                    const unsigned w = (j & 1) ? ((a >> 16) | (c & 0xffff0000u)) : ((a & 0xffffu) | (c << 16)); if (q == 0) tv.x = w; else if (q == 1) tv.y = w; else if (q == 2) tv.z = w; else tv.w = w; }
                *(u32x4*)(kt + (size_t)j * UT) = tv; }
        }
    }
}

__device__ __forceinline__ f32x4 mfma16(bf16x8 a, bf16x8 b, f32x4 c) { return __builtin_amdgcn_mfma_f32_16x16x32_bf16(a, b, c, 0, 0, 0); }
__device__ __forceinline__ float logsig_fast(float x) { return fminf(x, 0.f) - __logf(1.f + __expf(-fabsf(x))); }
__device__ __forceinline__ int chunk_of(int dir, int k) { return dir == 0 ? k : (k < 2 ? 1 - k : 35 - k); }
__device__ __forceinline__ void phase_scan(const Ctx& X) {
    KargP ka = kargs(); unsigned char* const ws = ka->ws; (void)ka; (void)ws;
    int tid_ = X.wave * 64 + lane_id(); asm volatile("" : "+v"(tid_)); const int TID = tid_, LANE = tid_ & 63;
    const int bid = blockIdx.x, chain = (bid & 7) + 8 * (bid >> 5), q4 = (bid >> 3) & 3, b = chain >> 3, h = (chain >> 1) & 3, dir = chain & 1;
    LAS float* gl = (LAS float*)X.lds;
    LAS float* bend = gl + NCHUNK * 128; LAS float* gmx = bend + 64; LAS float* wold = gmx + 64; LAS float* mst = wold + 64; LAS float* mnx = mst + 64;
    const float* GATES = (const float*)(ws + WS_GATES);
    for (int k = X.wave; k < NCHUNK; k += NWAVES) {
        const int c = chunk_of(dir, k), p0 = 2 * LANE, t0 = dir ? 127 - p0 : p0, t1 = dir ? 126 - p0 : p0 + 1;
        const size_t row0 = (size_t)b * UT + 128 * c;
        const float f0 = GATES[(row0 + t0) * 16 + (2 * dir + 1) * 4 + h], f1 = GATES[(row0 + t1) * 16 + (2 * dir + 1) * 4 + h];
        const float i0 = GATES[(row0 + t0) * 16 + (2 * dir) * 4 + h], i1 = GATES[(row0 + t1) * 16 + (2 * dir) * 4 + h];
        const float l0 = logsig_fast(f0), l1 = logsig_fast(f1);
        float v = l0 + l1;
#pragma unroll
        for (int o = 1; o < 64; o <<= 1) { const float t = __shfl_up(v, o); if (LANE >= o) v += t; }
        const float be = __shfl(v, 63), b1 = v, b0 = v - l1;
        const float g0 = be - b0 + i0, g1 = be - b1 + i1;
        float gm = fmaxf(g0, g1);
#pragma unroll
        for (int o = 1; o < 64; o <<= 1) gm = fmaxf(gm, __shfl_xor(gm, o));
        gl[k * 128 + t0] = g0; gl[k * 128 + t1] = g1;
        if (LANE == 0) { bend[k] = be; gmx[k] = gm; }
    }
    __syncthreads();
    if (TID == 0) { float m = 0.f; for (int k = 0; k < NCHUNK; ++k) { mst[k] = m; const float mn = fmaxf(bend[k] + m, gmx[k]); wold[k] = __expf(bend[k] + m - mn); mnx[k] = mn; m = mn; } }
    __syncthreads();
    for (int i = TID; i < NCHUNK * 128; i += NTHR) gl[i] = __expf(gl[i] - mnx[i >> 7]);
    if (q4 == 0 && TID < NCHUNK) ((float*)(ws + WS_MST))[chain * NCHUNK + TID] = mst[TID];
    __syncthreads();
    const bf16* KPT = (const bf16*)(ws + WS_KPT); const bf16* MVT = (const bf16*)(ws + WS_MVT); bf16* CST = (bf16*)(ws + WS_CST); float* NST = (float*)(ws + WS_NST);
    const int n = LANE & 15, g = LANE >> 4;
    const bf16* kbase = KPT + ((size_t)(b * 4 + h) * 128 + 16 * X.wave + n) * UT + 8 * g;
    const bf16* vbase = MVT + ((size_t)(b * 4 + h) * 128 + 32 * q4 + n) * UT + 8 * g;
    f32x4 C0 = {0.f, 0.f, 0.f, 0.f}, C1 = {0.f, 0.f, 0.f, 0.f}, Cn = {0.f, 0.f, 0.f, 0.f};
    bf16x8 ones;
#pragma unroll
    for (int j = 0; j < 8; ++j) ones[j] = (short)0x3F80;
    u32x4 kc[4], va[2][4], kn[4], vn[2][4];
    { const int u0 = 128 * chunk_of(dir, 0);
#pragma unroll
      for (int ks = 0; ks < 4; ++ks) { kc[ks] = *(const u32x4*)(kbase + u0 + 32 * ks); va[0][ks] = *(const u32x4*)(vbase + u0 + 32 * ks); va[1][ks] = *(const u32x4*)(vbase + (size_t)16 * UT + u0 + 32 * ks); } }
#pragma unroll 1
    for (int k = 0; k < NCHUNK; ++k) {
        if (k + 1 < NCHUNK) { const int u1 = 128 * chunk_of(dir, k + 1);
#pragma unroll
            for (int ks = 0; ks < 4; ++ks) { kn[ks] = *(const u32x4*)(kbase + u1 + 32 * ks); vn[0][ks] = *(const u32x4*)(vbase + u1 + 32 * ks); vn[1][ks] = *(const u32x4*)(vbase + (size_t)16 * UT + u1 + 32 * ks); } }
        { bf16* cs = CST + ((size_t)(chain * NCHUNK + k) * 128 + 32 * q4 + 4 * g) * 128 + 16 * X.wave + n;
#pragma unroll
          for (int r = 0; r < 4; ++r) { cs[(size_t)r * 128] = f2bf(C0[r]); cs[(size_t)(16 + r) * 128] = f2bf(C1[r]); }
          if (q4 == 0 && g == 0) NST[(size_t)(chain * NCHUNK + k) * 128 + 16 * X.wave + n] = Cn[0]; }
        const float wo = wold[k];
        C0 = C0 * wo; C1 = C1 * wo; Cn = Cn * wo;
#pragma unroll
        for (int ks = 0; ks < 4; ++ks) {
            const f32x4 wa = *(const LAS f32x4*)(gl + k * 128 + 32 * ks + 8 * g), wb = *(const LAS f32x4*)(gl + k * 128 + 32 * ks + 8 * g + 4);
            float kf[8]; unpack8(kc[ks], kf);
            u32x4 kw; kw.x = cvt_pk_bf16(kf[0] * wa[0], kf[1] * wa[1]); kw.y = cvt_pk_bf16(kf[2] * wa[2], kf[3] * wa[3]); kw.z = cvt_pk_bf16(kf[4] * wb[0], kf[5] * wb[1]); kw.w = cvt_pk_bf16(kf[6] * wb[2], kf[7] * wb[3]);
            const bf16x8 bfr = __builtin_bit_cast(bf16x8, kw);
            C0 = mfma16(__builtin_bit_cast(bf16x8, va[0][ks]), bfr, C0); C1 = mfma16(__builtin_bit_cast(bf16x8, va[1][ks]), bfr, C1); Cn = mfma16(ones, bfr, Cn);
        }
#pragma unroll
        for (int ks = 0; ks < 4; ++ks) { kc[ks] = kn[ks]; va[0][ks] = vn[0][ks]; va[1][ks] = vn[1][ks]; }
    }
}


__device__ __forceinline__ unsigned swz_b(unsigned row, unsigned ch) { return 256u * row + 16u * (ch ^ (((row & 3u) << 2) | ((row >> 2) & 3u))); }
__device__ __forceinline__ void stage_tile128(LAS unsigned char* dst, const char* src, size_t gpitch, int TID) {
#pragma unroll
    for (int i = 0; i < 4; ++i) { const int nn = TID + NTHR * i, row = nn >> 4, ch = nn & 15; const u32x4 v = *(const u32x4*)(src + (size_t)row * gpitch + ch * 16); *(LAS u32x4*)(dst + swz_b(row, ch)) = v; }
}
constexpr int GA_OFF = 0;
__device__ __forceinline__ void mlstm_unit(const Ctx& X, LAS float* ga, int b, int h, int c, int l, int TID, int LANE) {
    KargP ka = kargs(); unsigned char* const ws = ka->ws; (void)ka; (void)ws;
    const bf16* QP = (const bf16*)(ws + WS_QP); const bf16* KP = (const bf16*)(ws + WS_KP); const bf16* MVT = (const bf16*)(ws + WS_MVT); const bf16* CST = (const bf16*)(ws + WS_CST);
    const float* NST = (const float*)(ws + WS_NST); const float* MST = (const float*)(ws + WS_MST); const float* GATES = (const float*)(ws + WS_GATES);
    const bf16* PA = (const bf16*)(ws + WS_PA); bf16* ACT = (bf16*)(ws + WS_ACT);
    LAS unsigned char* TK = X.lds; LAS unsigned char* TV = X.lds + 32768; LAS unsigned char* TCF = X.lds + 65536; LAS unsigned char* TCB = X.lds + 98304;
    LAS float* aF = ga; LAS float* aB = ga + 128; LAS float* MF = ga + 256; LAS float* MB = ga + 384; LAS float* bF = ga + 512; LAS float* bB = ga + 640;
    const int chF = (b * 4 + h) * 2, chB = chF + 1, jf = c, jb = c < 2 ? 1 - c : 35 - c;
    const size_t row0 = (size_t)b * UT + 128 * c;
    const float mf = MST[chF * NCHUNK + jf], mb = MST[chB * NCHUNK + jb];
    stage_tile128(TK, (const char*)(KP + row0 * 512 + h * 128), 1024, TID);
    stage_tile128(TV, (const char*)(MVT + (size_t)(b * 4 + h) * 128 * UT + 128 * c), (size_t)UT * 2, TID);
    stage_tile128(TCF, (const char*)(CST + (size_t)(chF * NCHUNK + jf) * 16384), 256, TID);
    stage_tile128(TCB, (const char*)(CST + (size_t)(chB * NCHUNK + jb) * 16384), 256, TID);
    if (X.wave < 2) {
        const int dir = X.wave, p0 = 2 * LANE, t0 = dir ? 127 - p0 : p0, t1 = dir ? 126 - p0 : p0 + 1;
        const float f0 = GATES[(row0 + t0) * 16 + (2 * dir + 1) * 4 + h], f1 = GATES[(row0 + t1) * 16 + (2 * dir + 1) * 4 + h];
        const float i0 = GATES[(row0 + t0) * 16 + (2 * dir) * 4 + h], i1 = GATES[(row0 + t1) * 16 + (2 * dir) * 4 + h];
        const float l0 = logsig_fast(f0), l1 = logsig_fast(f1);
        float v = l0 + l1;
#pragma unroll
        for (int o = 1; o < 64; o <<= 1) { const float t = __shfl_up(v, o); if (LANE >= o) v += t; }
        const float b1 = v, b0 = v - l1, a0 = i0 - b0, a1 = i1 - b1;
        float mx = fmaxf(a0, a1);
#pragma unroll
        for (int o = 1; o < 64; o <<= 1) { const float t = __shfl_up(mx, o); if (LANE >= o) mx = fmaxf(mx, t); }
        float mprev = __shfl_up(mx, 1); if (LANE == 0) mprev = -1e30f;
        const float mm = dir ? mb : mf;
        const float M0 = fmaxf(mm, fmaxf(mprev, a0)), M1 = fmaxf(mm, mx);
        LAS float* aa = dir ? aB : aF; LAS float* MM = dir ? MB : MF; LAS float* bbp = dir ? bB : bF;
        aa[t0] = a0; aa[t1] = a1; MM[t0] = M0; MM[t1] = M1; bbp[t0] = b0; bbp[t1] = b1;
    }
    __syncthreads();
    const int n = LANE & 15, g = LANE >> 4, t = 16 * (TID >> 6) + n, dblk = X.wave >> 1;
    const size_t rowt = row0 + t;
    unsigned rb[4], ka_[4], kb_[4];
#pragma unroll
    for (int ks = 0; ks < 4; ++ks) { const unsigned cx = 64u * (unsigned)(ks ^ (n & 3));
        rb[ks] = 256u * n + cx + 16u * (unsigned)(g ^ ((n >> 2) & 3));
        ka_[ks] = 256u * (8 * (n >> 2) + (n & 3)) + cx + 16u * (unsigned)(g ^ ((2 * (n >> 2)) & 3));
        kb_[ks] = 256u * (8 * (n >> 2) + (n & 3) + 4) + cx + 16u * (unsigned)(g ^ ((2 * (n >> 2) + 1) & 3)); }
    u32x4 qf[4];
#pragma unroll
    for (int ks = 0; ks < 4; ++ks) qf[ks] = *(const u32x4*)(QP + rowt * 512 + h * 128 + 32 * ks + 8 * g);
    float qnf = 0.f, qnb = 0.f;
    { const float* nf = NST + (size_t)(chF * NCHUNK + jf) * 128; const float* nb = NST + (size_t)(chB * NCHUNK + jb) * 128;
#pragma unroll
      for (int ks = 0; ks < 4; ++ks) { float q8[8]; unpack8(qf[ks], q8);
          const f32x4 a0 = *(const f32x4*)(nf + 32 * ks + 8 * g), a1 = *(const f32x4*)(nf + 32 * ks + 8 * g + 4), c0 = *(const f32x4*)(nb + 32 * ks + 8 * g), c1 = *(const f32x4*)(nb + 32 * ks + 8 * g + 4);
#pragma unroll
          for (int j = 0; j < 4; ++j) { qnf += q8[j] * a0[j] + q8[4 + j] * a1[j]; qnb += q8[j] * c0[j] + q8[4 + j] * c1[j]; } }
      qnf += __shfl_xor(qnf, 16); qnf += __shfl_xor(qnf, 32); qnb += __shfl_xor(qnb, 16); qnb += __shfl_xor(qnb, 32); }
    const float MFt = MF[t], MBt = MB[t], bFt = bF[t], bBt = bB[t];
    float pp[4][8], pdb[8]; float sumF = 0.f, sumB = 0.f;
#pragma unroll
    for (int j = 0; j < 8; ++j) pdb[j] = 0.f;
#pragma unroll
    for (int blk = 0; blk < 4; ++blk) {
        f32x4 sa = {0.f, 0.f, 0.f, 0.f}, sb = {0.f, 0.f, 0.f, 0.f};
#pragma unroll
        for (int ks = 0; ks < 4; ++ks) { const bf16x8 A0 = *(const LAS bf16x8*)(TK + ka_[ks] + blk * 8192), A1 = *(const LAS bf16x8*)(TK + kb_[ks] + blk * 8192);
            sa = mfma16(A0, __builtin_bit_cast(bf16x8, qf[ks]), sa); sb = mfma16(A1, __builtin_bit_cast(bf16x8, qf[ks]), sb); }
        if (blk <= dblk) {
            const f32x4 af0 = *(const LAS f32x4*)(aF + 32 * blk + 8 * g), af1 = *(const LAS f32x4*)(aF + 32 * blk + 8 * g + 4);
#pragma unroll
            for (int j = 0; j < 8; ++j) { const int s = 32 * blk + 8 * g + j; const float sv = j < 4 ? sa[j & 3] : sb[j & 3]; const float afs = j < 4 ? af0[j & 3] : af1[j & 3];
                const float v = (s <= t) ? sv * __expf(afs - MFt) : 0.f; pp[blk][j] = v; sumF += v; }
        }
        if (blk >= dblk) {
            const f32x4 ab0 = *(const LAS f32x4*)(aB + 32 * blk + 8 * g), ab1 = *(const LAS f32x4*)(aB + 32 * blk + 8 * g + 4);
#pragma unroll
            for (int j = 0; j < 8; ++j) { const int s = 32 * blk + 8 * g + j; const float sv = j < 4 ? sa[j & 3] : sb[j & 3]; const float abs_ = j < 4 ? ab0[j & 3] : ab1[j & 3];
                const float v = (s >= t) ? sv * __expf(abs_ - MBt) : 0.f; if (blk == dblk) pdb[j] = v; else pp[blk][j] = v; sumB += v; }
        }
    }
    sumF += __shfl_xor(sumF, 16); sumF += __shfl_xor(sumF, 32); sumB += __shfl_xor(sumB, 16); sumB += __shfl_xor(sumB, 32);
    const float wiF = __expf(mf - MFt), wiB = __expf(mb - MBt);
    const float rF = 1.f / fmaxf(fabsf(sumF + wiF * qnf), __expf(-bFt - MFt)), rB = 1.f / fmaxf(fabsf(sumB + wiB * qnb), __expf(-bBt - MBt));
    bf16x8 pfr[4];
#pragma unroll
    for (int blk = 0; blk < 4; ++blk) { const float sc = blk <= dblk ? rF : rB; const float sd = blk == dblk ? rB : 0.f; float q[8];
#pragma unroll
        for (int j = 0; j < 8; ++j) q[j] = pp[blk][j] * sc + pdb[j] * sd;
        u32x4 w; w.x = cvt_pk_bf16(q[0], q[1]); w.y = cvt_pk_bf16(q[2], q[3]); w.z = cvt_pk_bf16(q[4], q[5]); w.w = cvt_pk_bf16(q[6], q[7]); pfr[blk] = __builtin_bit_cast(bf16x8, w); }
    const float cF = wiF * rF, cB = wiB * rB;
    f32x4 O[8]; float ss = 0.f;
#pragma unroll
    for (int mt = 0; mt < 8; ++mt) {
        f32x4 o = {0.f, 0.f, 0.f, 0.f}, af = {0.f, 0.f, 0.f, 0.f}, ab = {0.f, 0.f, 0.f, 0.f};
#pragma unroll
        for (int ks = 0; ks < 4; ++ks) {
            o = mfma16(*(const LAS bf16x8*)(TV + rb[ks] + mt * 4096), pfr[ks], o);
            af = mfma16(*(const LAS bf16x8*)(TCF + rb[ks] + mt * 4096), __builtin_bit_cast(bf16x8, qf[ks]), af);
            ab = mfma16(*(const LAS bf16x8*)(TCB + rb[ks] + mt * 4096), __builtin_bit_cast(bf16x8, qf[ks]), ab); }
        O[mt] = o + cF * af + cB * ab;
        ss += (O[mt][0] * O[mt][0] + O[mt][1] * O[mt][1]) + (O[mt][2] * O[mt][2] + O[mt][3] * O[mt][3]);
    }
    ss += __shfl_xor(ss, 16); ss += __shfl_xor(ss, 32);
    const float rstd = rsqrtf(ss * (1.f / 128.f) + EPS);
    const float* mnw = ka->in[11] + l * 512 + h * 128;
#pragma unroll
    for (int mt = 0; mt < 8; ++mt) { const int dv0 = 16 * mt + 4 * g; const f32x4 w4 = *(const f32x4*)(mnw + dv0); const u32x2 mo = *(const u32x2*)(PA + rowt * 1536 + h * 128 + dv0);
        const float g0 = __uint_as_float(mo.x << 16), g1 = __uint_as_float(mo.x & 0xffff0000u), g2 = __uint_as_float(mo.y << 16), g3 = __uint_as_float(mo.y & 0xffff0000u);
        const float o0 = O[mt][0] * rstd * w4[0] * __builtin_amdgcn_rcpf(1.f + __expf(-g0)), o1 = O[mt][1] * rstd * w4[1] * __builtin_amdgcn_rcpf(1.f + __expf(-g1));
        const float o2 = O[mt][2] * rstd * w4[2] * __builtin_amdgcn_rcpf(1.f + __expf(-g2)), o3 = O[mt][3] * rstd * w4[3] * __builtin_amdgcn_rcpf(1.f + __expf(-g3));
        u32x2 w; w.x = cvt_pk_bf16(o0, o1); w.y = cvt_pk_bf16(o2, o3); *(u32x2*)(ACT + rowt * 1024 + h * 128 + dv0) = w; }
    __syncthreads();
}

constexpr float NA_C2 = 0.125f * 1.4426950408889634f;
template <bool PARTIAL>
__device__ __forceinline__ void na_ctx_tile(LAS unsigned char* CK, LAS unsigned char* CV, const bf16* qrow  , bf16* orow  , float* pm, int n, int g) {
    u32x4 qf[2];
#pragma unroll
    for (int ks = 0; ks < 2; ++ks) qf[ks] = *(const u32x4*)(qrow + 32 * ks + 8 * g);
    const unsigned ka0 = (unsigned)(8 * (n >> 2) + (n & 3)) * 144u + 16u * g, ka1 = ka0 + 4u * 144u, vb = (unsigned)n * 528u + 16u * g;
    f32x4 s[8][2]; float mx = -1e30f;
#pragma unroll
    for (int blk = 0; blk < 8; ++blk) {
        f32x4 sa = {0.f, 0.f, 0.f, 0.f}, sb = {0.f, 0.f, 0.f, 0.f};
#pragma unroll
        for (int ks = 0; ks < 2; ++ks) { sa = mfma16(*(const LAS bf16x8*)(CK + ka0 + blk * 4608 + ks * 64), __builtin_bit_cast(bf16x8, qf[ks]), sa); sb = mfma16(*(const LAS bf16x8*)(CK + ka1 + blk * 4608 + ks * 64), __builtin_bit_cast(bf16x8, qf[ks]), sb); }
        s[blk][0] = sa * NA_C2; s[blk][1] = sb * NA_C2;
        mx = fmaxf(mx, fmaxf(fmaxf(fmaxf(s[blk][0][0], s[blk][0][1]), fmaxf(s[blk][0][2], s[blk][0][3])), fmaxf(fmaxf(s[blk][1][0], s[blk][1][1]), fmaxf(s[blk][1][2], s[blk][1][3]))));
    }
    mx = fmaxf(mx, __shfl_xor(mx, 16)); mx = fmaxf(mx, __shfl_xor(mx, 32));
    float sum = 0.f; bf16x8 pfr[8];
#pragma unroll
    for (int blk = 0; blk < 8; ++blk) { float e[8];
#pragma unroll
        for (int j = 0; j < 8; ++j) { e[j] = __builtin_amdgcn_exp2f(s[blk][j >> 2][j & 3] - mx); sum += e[j]; }
        u32x4 w; w.x = cvt_pk_bf16(e[0], e[1]); w.y = cvt_pk_bf16(e[2], e[3]); w.z = cvt_pk_bf16(e[4], e[5]); w.w = cvt_pk_bf16(e[6], e[7]); pfr[blk] = __builtin_bit_cast(bf16x8, w); }
    sum += __shfl_xor(sum, 16); sum += __shfl_xor(sum, 32);
    const float inv = 1.f / sum;
#pragma unroll
    for (int mt = 0; mt < 4; ++mt) { f32x4 o = {0.f, 0.f, 0.f, 0.f};
#pragma unroll
        for (int blk = 0; blk < 8; ++blk) o = mfma16(*(const LAS bf16x8*)(CV + vb + mt * 8448 + blk * 64), pfr[blk], o);
        u32x2 w; w.x = cvt_pk_bf16(o[0] * inv, o[1] * inv); w.y = cvt_pk_bf16(o[2] * inv, o[3] * inv); *(u32x2*)(orow + 16 * mt + 4 * g) = w; }
    if (PARTIAL && g == 0) { pm[0] = mx; pm[1] = sum; }
}
__device__ __forceinline__ void na_job(const Ctx& X, int job, int l, int TID, int LANE) {
    KargP ka = kargs(); unsigned char* const ws = ka->ws;
    const int bhd = job >> 2, qq = job & 3, b = bhd >> 3, hd = bhd & 7, n = LANE & 15, g = LANE >> 4;
    const bf16* PA = (const bf16*)(ws + WS_PA); const bf16* NVT = (const bf16*)(ws + WS_NVT); bf16* ACT = (bf16*)(ws + WS_ACT);
    bf16* PARTO = (bf16*)(ws + WS_PARTO) + (size_t)bhd * 4096 * 64; float* PARTM = (float*)(ws + WS_PARTM) + (size_t)bhd * 4096 * 2;
    const bf16* vtb = NVT + (size_t)(b * 8 + hd) * 64 * UT;
    LAS unsigned char* CK = X.lds; LAS unsigned char* CV = X.lds + 36864; LAS float* rpbL = (LAS float*)(X.lds + LDSCTL_OFF + 4096);
#pragma unroll
    for (int i = 0; i < 4; ++i) { const int nn = TID + NTHR * i, key = nn >> 3, ch = nn & 7; *(LAS u32x4*)(CK + key * 144 + ch * 16) = *(const u32x4*)(PA + ((size_t)b * UT + key) * 1536 + 1024 + hd * 64 + ch * 8); }
#pragma unroll
    for (int i = 0; i < 4; ++i) { const int nn = TID + NTHR * i, dv = nn >> 5, ch = nn & 31; *(LAS u32x4*)(CV + dv * 528 + ch * 16) = *(const u32x4*)(vtb + (size_t)dv * UT + ch * 8); }
    if (TID < 528) rpbL[TID] = (TID >= 16 && TID < 481) ? (ka->in[12] + (size_t)l * 8 * 465 + hd * 465)[TID - 16] : 0.f;
    __syncthreads();
#ifndef NA_SKIP_C
#pragma unroll 1
    for (int un = 0; un < 8; ++un) { const int r = 16 * qq + 2 * un + (X.wave >> 2), tq = r * 64 + 16 * (X.wave & 3) + n; const size_t row = (size_t)b * UT + CTXL + tq;
        na_ctx_tile<true>(CK, CV, PA + row * 1536 + 512 + hd * 64, PARTO + (size_t)tq * 64, PARTM + (size_t)tq * 2, n, g); }
    if (l == 0 && qq < 2) { const size_t row = (size_t)b * UT + 128 * qq + 16 * X.wave + n;
        na_ctx_tile<false>(CK, CV, PA + row * 1536 + 512 + hd * 64, ACT + row * 1024 + 512 + hd * 64, nullptr, n, g); }
#endif
    __syncthreads();
#ifndef NA_SKIP_W
    LAS unsigned char* WK = X.lds; LAS unsigned char* WV = X.lds + 73728;
#pragma unroll 1
    for (int un = 0; un < 8; ++un) {
        const int r0 = 16 * qq + 2 * un, rs_lo = min(max(r0 - 4, 0), 56), nrows = min(9, 64 - rs_lo);
        const size_t tok0 = (size_t)b * UT + CTXL + rs_lo * 64;
#pragma unroll
        for (int i = 0; i < 9; ++i) { const int nn = TID + NTHR * i, key = nn >> 3, ch = nn & 7;
            if (key < nrows * 64) *(LAS u32x4*)(WK + key * 128 + ((ch ^ (key & 7)) * 16)) = *(const u32x4*)(PA + (tok0 + key) * 1536 + 1024 + hd * 64 + ch * 8); }
#pragma unroll
        for (int i = 0; i < 9; ++i) { const int nn = TID + NTHR * i, dv = nn / 72, cc = nn - dv * 72;
            if (cc < nrows * 8) *(LAS u32x4*)(WV + dv * 1152 + (((cc & ~7) | ((cc & 7) ^ (dv & 7))) * 16)) = *(const u32x4*)(vtb + (size_t)dv * UT + CTXL + rs_lo * 64 + cc * 8); }
        __syncthreads();
        {
            const int r = r0 + (X.wave >> 2), c0 = 16 * (X.wave & 3), rs = min(max(r - 4, 0), 56), lr0 = rs - rs_lo, cs0 = min(max(c0 - 8, 0), 32);
            const int c = c0 + n, csq = min(max(c - 8, 0), 48), tq = r * 64 + c; const size_t row = (size_t)b * UT + CTXL + tq;
            u32x4 qf[2];
#pragma unroll
            for (int ks = 0; ks < 2; ++ks) qf[ks] = *(const u32x4*)(PA + row * 1536 + 512 + hd * 64 + 32 * ks + 8 * g);
            const float m_c = PARTM[(size_t)tq * 2], l_c = PARTM[(size_t)tq * 2 + 1];
            const unsigned kb0 = (unsigned)(lr0 * 64 + cs0 + 8 * (n >> 2) + (n & 3)) * 128u + 16u * (unsigned)(g ^ (n & 3)), kb1 = kb0 + 4u * 128u;
            const unsigned vb = (unsigned)n * 1152u + (unsigned)lr0 * 128u + 16u * (unsigned)(((cs0 >> 3) + g) ^ (n & 7));
            const int dk0 = cs0 + 8 * g - csq;
            const LAS float* rpl = rpbL + 16 + (rs - r + 7) * 31 + (cs0 + 8 * g - c + 15);
            f32x4 s[8][2]; float mx = m_c;
#pragma unroll
            for (int i = 0; i < 8; ++i) {
                f32x4 sa = {0.f, 0.f, 0.f, 0.f}, sb = {0.f, 0.f, 0.f, 0.f};
#pragma unroll
                for (int ks = 0; ks < 2; ++ks) { sa = mfma16(*(const LAS bf16x8*)(WK + kb0 + i * 8192 + 64 * ks), __builtin_bit_cast(bf16x8, qf[ks]), sa);
                    sb = mfma16(*(const LAS bf16x8*)(WK + kb1 + i * 8192 + 64 * (ks ^ 1)), __builtin_bit_cast(bf16x8, qf[ks]), sb); }
                const LAS float* bp = rpl + i * 31;
#pragma unroll
                for (int j = 0; j < 8; ++j) { const bool ok = (unsigned)(dk0 + j) < 16u; const float bias = bp[j]; const float sv = (j < 4 ? sa[j & 3] : sb[j & 3]);
                    const float x = ok ? (sv * 0.125f + bias) * 1.4426950408889634f : -1e30f; s[i][j >> 2][j & 3] = x; mx = fmaxf(mx, x); }
                asm volatile("" ::: "memory");
            }
            mx = fmaxf(mx, __shfl_xor(mx, 16)); mx = fmaxf(mx, __shfl_xor(mx, 32));
            float sum = 0.f; bf16x8 pfr[8];
#pragma unroll
            for (int i = 0; i < 8; ++i) { float e[8];
#pragma unroll
                for (int j = 0; j < 8; ++j) { e[j] = __builtin_amdgcn_exp2f(s[i][j >> 2][j & 3] - mx); sum += e[j]; }
                u32x4 w; w.x = cvt_pk_bf16(e[0], e[1]); w.y = cvt_pk_bf16(e[2], e[3]); w.z = cvt_pk_bf16(e[4], e[5]); w.w = cvt_pk_bf16(e[6], e[7]); pfr[i] = __builtin_bit_cast(bf16x8, w); }
            sum += __shfl_xor(sum, 16); sum += __shfl_xor(sum, 32);
            const float wc = __builtin_amdgcn_exp2f(m_c - mx) * l_c, inv = 1.f / (wc + sum);
#pragma unroll
            for (int mt = 0; mt < 4; ++mt) { f32x4 o = {0.f, 0.f, 0.f, 0.f};
#pragma unroll
                for (int i = 0; i < 8; ++i) o = mfma16(*(const LAS bf16x8*)(WV + vb + mt * 18432 + i * 128), pfr[i], o);
                const u32x2 pc = *(const u32x2*)(PARTO + (size_t)tq * 64 + 16 * mt + 4 * g);
                const float p0 = __uint_as_float(pc.x << 16), p1 = __uint_as_float(pc.x & 0xffff0000u), p2 = __uint_as_float(pc.y << 16), p3 = __uint_as_float(pc.y & 0xffff0000u);
                u32x2 w; w.x = cvt_pk_bf16((o[0] + wc * p0) * inv, (o[1] + wc * p1) * inv); w.y = cvt_pk_bf16((o[2] + wc * p2) * inv, (o[3] + wc * p3) * inv);
                *(u32x2*)(ACT + row * 1024 + 512 + hd * 64 + 16 * mt + 4 * g) = w; }
        }
        __syncthreads();
    }
#endif
}
__device__ __forceinline__ void phase_mix(const Ctx& X, int l, int flags) {
    int tid_ = X.wave * 64 + lane_id(); asm volatile("" : "+v"(tid_)); const int TID = tid_, LANE = tid_ & 63;
    LAS float* ga = (LAS float*)(X.lds + LDSCTL_OFF + 1024);
#ifdef MIXONLY
    flags &= MIXONLY;
#endif
    if (flags & 1) {
        const int nun = (l == 0) ? 32 * NCHUNK : 32 * 32;
#pragma unroll 1
        for (int v = blockIdx.x; v < nun; v += X.G) {
            int bh, c; if (l == 0) { bh = v / NCHUNK; c = v - bh * NCHUNK; } else { bh = v >> 5; c = 2 + (v & 31); }
            mlstm_unit(X, ga, bh >> 2, bh & 3, c, l, TID, LANE);
        }
    }
    if (flags & 2) { for (int job = blockIdx.x; job < 256; job += X.G) na_job(X, job, l, TID, LANE); }
}

#ifndef CPH
#define CPH 0xFFFFFFFFu
#endif
#define CEN(bit) ((CPH >> (bit)) & 1u)
#define IN(k) (lo <= (k) && (k) < hi)
#define SEAM(k) do { if (IN(k) && IN((k) + 1)) xcd_barrier(bar, LEADER); } while (0)
#ifndef REPMASK
#define REPMASK 0u
#endif
#define REP(bit) for (int rep_ = 0; rep_ < ((((REPMASK) >> (bit)) & 1u) ? 2 : 1); ++rep_)
#define REPBAR if (rep_) xcd_barrier(bar, LEADER)
template <int l>
__device__ __forceinline__ void layer_body(const Ctx& X, const XcdBarrier& bar, const int lo, const int hi, const int mixflags) {
#define LEADER (X.wave == 0 && lane_id() == 0)

        const int pb = 1 + 10 * l; const bool last = (l == 1);
        if (CEN(1) && IN(pb + K_NORM1)) REP(1) { REPBAR;
            KargP ka = kargs(); unsigned char* const ws = ka->ws; float* MOD = (float*)(ws + WS_MOD); float* CTXB = (float*)(ws + WS_CTX);
            if (l == 0) rows_phase<false, false, false>(X, ka->in[0], ka->in[2], nullptr, nullptr, ka->in[6], MOD, 0, 1, nullptr, false, 0);
            else rows_phase<true, false, false>(X, ka->out, CTXB, ka->out, CTXB, ka->in[6] + 1024, MOD + (size_t)9 * 6144, 0, 1, MOD, false, 0);
        } SEAM(pb + K_NORM1);
        if (CEN(2) && IN(pb + K_GEMM_IN)) REP(2) { REPBAR;
            KargP ka = kargs(); unsigned char* const ws = ka->ws;
            SchedDense S; S.init(136, 15, X.G, (int)blockIdx.x); S.A = (const char*)(ws + WS_ACT); S.B = (const char*)(ws + WS_WIN) + (size_t)l * 3840 * 1024 * 2; S.tstep = (size_t)256 * 1024 * 2;
            EpiInP E{(bf16*)(ws + WS_QKRAW), (bf16*)(ws + WS_PA), (bf16*)(ws + WS_MVT), (bf16*)(ws + WS_NVT), (float*)(ws + WS_GATES), ka->in[10] + l * 16};
            pg8::gemm_phase<EpiInP, SchedDense>(X.lds, 1024, S, E, X.wave);
        } SEAM(pb + K_GEMM_IN);
        if (CEN(3) && IN(pb + K_PREP)) REP(3) { REPBAR; phase_prep(X, l); } SEAM(pb + K_PREP);
        if (CEN(4) && IN(pb + K_SCAN)) REP(4) { REPBAR; phase_scan(X); } SEAM(pb + K_SCAN);
        if (CEN(5) && IN(pb + K_MIX)) REP(5) { REPBAR; phase_mix(X, l, mixflags); } SEAM(pb + K_MIX);
        if (CEN(6) && IN(pb + K_GEMM_OUT)) REP(6) { REPBAR;
            KargP ka = kargs(); unsigned char* const ws = ka->ws; float* CTXB = (float*)(ws + WS_CTX);
            EpiOutP E{l == 0 ? ka->in[0] : ka->out, l == 0 ? ka->in[2] : CTXB, ka->out, CTXB, (const float*)(ws + WS_MOD) + (size_t)l * 9 * 6144};
            SchedLatent S; S.init(last ? 128 : 136, 4, X.G, (int)blockIdx.x); S.lat = last ? 1 : 0; S.A = (const char*)(ws + WS_ACT); S.B = (const char*)(ws + WS_WOUT) + (size_t)l * 1024 * 1024 * 2; S.tstep = (size_t)256 * 1024 * 2;
            pg8::gemm_phase<EpiOutP, SchedLatent>(X.lds, 1024, S, E, X.wave);
        } SEAM(pb + K_GEMM_OUT);
        if (CEN(7) && IN(pb + K_NORM2)) REP(7) { REPBAR;
            { KargP ka = kargs(); unsigned char* const ws = ka->ws;
              rows_phase<false, true, false>(X, ka->out, (float*)(ws + WS_CTX), nullptr, nullptr, ka->in[14] + l * 1024, (const float*)(ws + WS_MOD) + (size_t)l * 9 * 6144, 3, 4, nullptr, last, l); }
            __syncthreads();
            convert_experts(X, l);
        } SEAM(pb + K_NORM2);
        if (CEN(8) && IN(pb + K_SLOTS)) REP(8) { REPBAR; phase_slots(X, l, last); } SEAM(pb + K_SLOTS);
        if (CEN(9) && IN(pb + K_MOE1)) REP(9) { REPBAR;
            KargP ka = kargs(); unsigned char* const ws = ka->ws;
            const int nt = (int)ld_u32((unsigned*)ws + CW_NT + 32 * l);
            SchedMoe S; S.init(nt, 4, X.G, (int)blockIdx.x); S.A = (const char*)(ws + WS_AG); S.B = (const char*)(ws + WS_EW13); S.tstep = (size_t)256 * 1024 * 2; S.TILE_E = (const int*)(ws + WS_ROUTE + RT_TILE_E) + 512 * l;
            EpiMoe1 E{(bf16*)(ws + WS_ACTM)};
            pg8::gemm_phase<EpiMoe1, SchedMoe>(X.lds, 1024, S, E, X.wave);
        } SEAM(pb + K_MOE1);
        if (CEN(10) && IN(pb + K_MOE2)) REP(10) { REPBAR;
            KargP ka = kargs(); unsigned char* const ws = ka->ws;
            const int nt = (int)ld_u32((unsigned*)ws + CW_NT + 32 * l);
            SchedMoe S; S.init(nt, 4, X.G, (int)blockIdx.x); S.A = (const char*)(ws + WS_ACTM); S.B = (const char*)(ws + WS_EW2); S.tstep = (size_t)256 * 512 * 2; S.TILE_E = (const int*)(ws + WS_ROUTE + RT_TILE_E) + 512 * l;
            EpiMoe2 E{(bf16*)(ws + WS_Y)};
            pg8::gemm_phase<EpiMoe2, SchedMoe>(X.lds, 512, S, E, X.wave);
        } SEAM(pb + K_MOE2);
    }
__global__ void __launch_bounds__(NTHR, 2) mk_fwd(Args args) {
    extern __shared__ __attribute__((aligned(16))) unsigned char lds_raw[];
    Ctx X;
    X.lds = (LAS unsigned char*)lds_raw; X.wave = __builtin_amdgcn_readfirstlane(threadIdx.x >> 6); X.G = gridDim.x;
    X.gw = blockIdx.x * NWAVES + X.wave; X.ngw = X.G * NWAVES;
    volatile LAS unsigned* MISC = (volatile LAS unsigned*)(X.lds + MISC_OFF);
    for (int u = X.wave * 64 + lane_id(); u < (LDS_BYTES - LDSCTL_OFF) / 4; u += NTHR) ((LAS unsigned*)(X.lds + LDSCTL_OFF))[u] = 0u;
    __syncthreads();
    const int lo = args.ph_lo, hi = args.ph_hi;
    XcdBarrier bar; bar.bar = (unsigned*)(args.ws + WS_CTL) + CW_BAR + args.bar_region * XCD_BAR_WORDS; bar.x = 0; bar.st = nullptr;
    if (hi - lo > 1) bar = xcd_barrier_post((unsigned*)(args.ws + WS_CTL) + CW_BAR + args.bar_region * XCD_BAR_WORDS, MISC + 8, LEADER);

    if (CEN(0) && IN(PH_PRO)) { phase_prologue(X); } SEAM(PH_PRO);

    layer_body<0>(X, bar, lo, hi, args.mixflags);
    layer_body<1>(X, bar, lo, hi, args.mixflags);
    if (CEN(11) && IN(PH_FINAL)) { KargP ka = kargs(); unsigned char* const ws = ka->ws;
        rows_phase<true, false, true>(X, ka->out, nullptr, ka->out, nullptr, ka->in[20], nullptr, 0, 0, (const float*)(ws + WS_MOD) + (size_t)9 * 6144, true, 1); }
#undef IN
#undef SEAM
}
constexpr unsigned PM_PRO = 1u << 0, PM_NORM1 = 1u << 1, PM_GEMM_IN = 1u << 2, PM_PREP = 1u << 3, PM_SCAN = 1u << 4, PM_MIX = 1u << 5, PM_GEMM_OUT = 1u << 6, PM_NORM2 = 1u << 7,
                   PM_SLOTS = 1u << 8, PM_MOE1 = 1u << 9, PM_MOE2 = 1u << 10, PM_FINAL = 1u << 11;
#ifndef PMASK
#define PMASK (PM_PRO | PM_NORM1 | PM_GEMM_IN | PM_PREP | PM_SCAN | PM_MIX | PM_GEMM_OUT | PM_NORM2 | PM_SLOTS | PM_MOE1 | PM_MOE2 | PM_FINAL)
#endif
#ifndef MIXFLAGS
#define MIXFLAGS 3
#endif
static bool persist_phase(int ph) { if (ph == PH_PRO) return (PMASK & PM_PRO) != 0; if (ph == PH_FINAL) return (PMASK & PM_FINAL) != 0; return (PMASK & (2u << ((ph - 1) % 10))) != 0; }

extern "C" void kernel_launch(void* const* d_in, const int* in_sizes, int n_in, void* d_out, int out_size, void* d_ws, size_t ws_size, hipStream_t stream) {
    const float* x = (const float*)d_in[0]; const float* c = (const float*)d_in[1]; const float* ctx = (const float*)d_in[2]; const float* c_ctx = (const float*)d_in[3];
    const float* ada_w = (const float*)d_in[4]; const float* ada_b = (const float*)d_in[5]; const float* norm1_w = (const float*)d_in[6]; const float* w_in = (const float*)d_in[7];
    const float* conv_w = (const float*)d_in[8]; const float* conv_b = (const float*)d_in[9]; const float* gate_b = (const float*)d_in[10]; const float* mnorm_w = (const float*)d_in[11];
    const float* rpb = (const float*)d_in[12]; const float* w_out = (const float*)d_in[13]; const float* norm2_w = (const float*)d_in[14]; const float* router_w = (const float*)d_in[15];
    const float* router_b = (const float*)d_in[16]; const float* exp_w1 = (const float*)d_in[17]; const float* exp_w3 = (const float*)d_in[18]; const float* exp_w2 = (const float*)d_in[19];
    const float* final_w = (const float*)d_in[20];
    if (ws_size < WS_END) { fprintf(stderr, "kernel_launch: workspace too small (%zu < %zu)\n", ws_size, (size_t)WS_END); return; }
    unsigned char* ws = (unsigned char*)d_ws; float* out = (float*)d_out;
    unsigned* CTL = (unsigned*)(ws + WS_CTL); float* MOD = (float*)(ws + WS_MOD); float* CTXB = (float*)(ws + WS_CTX);
    float* GATES = (float*)(ws + WS_GATES); bf16* ACT = (bf16*)(ws + WS_ACT); bf16* PA = (bf16*)(ws + WS_PA); bf16* QKRAW = (bf16*)(ws + WS_QKRAW); bf16* CST = (bf16*)(ws + WS_CST);
    bf16* MVT = (bf16*)(ws + WS_MVT); bf16* NVT = (bf16*)(ws + WS_NVT); bf16* QP = (bf16*)(ws + WS_QP); bf16* KP = (bf16*)(ws + WS_KP); bf16* KPT = (bf16*)(ws + WS_KPT);
    float* NST = (float*)(ws + WS_NST); float* MST = (float*)(ws + WS_MST); float* HSUM = (float*)(ws + WS_HSUM); bf16* ACTM = (bf16*)(ws + WS_ACTM); bf16* Y = (bf16*)(ws + WS_Y);
    int* TOK_E = (int*)(ws + WS_ROUTE + RT_TOK_E); float* TOK_W = (float*)(ws + WS_ROUTE + RT_TOK_W); int* TOK_SLOT = (int*)(ws + WS_ROUTE + RT_TOK_SLOT);
    int* SLOT_TOK = (int*)(ws + WS_ROUTE + RT_SLOT_TOK); float* SLOT_W = (float*)(ws + WS_ROUTE + RT_SLOT_W); int* TILE_E0 = (int*)(ws + WS_ROUTE + RT_TILE_E);
    static int grid = 0;
    if (grid == 0) {
        int dev = 0, cus = 0; (void)hipGetDevice(&dev); (void)hipDeviceGetAttribute(&cus, hipDeviceAttributeMultiprocessorCount, dev);
        (void)hipFuncSetAttribute((const void*)nv_mout, hipFuncAttributeMaxDynamicSharedMemorySize, 70 * 1024);
        (void)hipFuncSetAttribute((const void*)mk_fwd, hipFuncAttributeMaxDynamicSharedMemorySize, LDS_BYTES);
        int per_cu = 0; (void)hipOccupancyMaxActiveBlocksPerMultiprocessor(&per_cu, (const void*)mk_fwd, NTHR, LDS_BYTES); (void)hipGetLastError();
        grid = (cus == 256 && per_cu >= 1) ? 256 : -1;
        if (grid < 0) fprintf(stderr, "kernel_launch: persistent kernel needs 256 CUs and one resident block per CU (cus %d, per_cu %d); using the naive path\n", cus, per_cu);
    }
    (void)hipMemsetAsync(ws + WS_CTL, 0, 1 * MiB, stream);
    Args a{};
    for (int i = 0; i < 21; ++i) a.in[i] = (const float*)d_in[i];
    a.out = out; a.ws = ws;
    int region = 0;
#if defined(PROBE_PHASE)
    if (grid > 0) {
        a.mixflags = MIXFLAGS;
        a.ph_lo = 0; a.ph_hi = PROBE_PHASE + 1; a.bar_region = region++; hipLaunchKernelGGL(mk_fwd, dim3(grid), dim3(NTHR), LDS_BYTES, stream, a);
        for (int r = 1; r < PROBE_REPS; ++r) { a.ph_lo = PROBE_PHASE; a.ph_hi = PROBE_PHASE + 1; a.bar_region = region++; hipLaunchKernelGGL(mk_fwd, dim3(grid), dim3(NTHR), LDS_BYTES, stream, a); }
        a.ph_lo = PROBE_PHASE + 1; a.ph_hi = NPHASE; a.bar_region = region++; hipLaunchKernelGGL(mk_fwd, dim3(grid), dim3(NTHR), LDS_BYTES, stream, a);
        return;
    }
#endif
    for (int ph = 0; ph < NPHASE;) {
        if (grid > 0 && persist_phase(ph)) {
            int ph2 = ph; while (ph2 < NPHASE && persist_phase(ph2)) ++ph2;
            a.ph_lo = ph; a.ph_hi = ph2; a.bar_region = region++; a.mixflags = MIXFLAGS;
            for (int q = ph; q < ph2; ++q) if (q >= 1 && q < PH_FINAL && (q - 1) % 10 == K_MIX && MIXFLAGS != 3) { ph2 = q + 1; break; }
            a.ph_hi = ph2;
            hipLaunchKernelGGL(mk_fwd, dim3(grid), dim3(NTHR), LDS_BYTES, stream, a);
            if (ph2 >= 2 && ph2 - 1 < PH_FINAL && (ph2 - 2) % 10 == K_MIX && MIXFLAGS != 3) {
                const int l = (ph2 - 2) / 10; const bool last = (l == 1);
                if (!(MIXFLAGS & 1)) { nv_mout<<<dim3(NCHUNK, 32), 256, (128 * 129 + 1024) * 4, stream>>>(QP, KP, MVT, GATES, CST, NST, MST, HSUM, last ? 1 : 0);
                    nv_mnorm<<<MROWS, 256, 0, stream>>>(HSUM, PA, mnorm_w + l * 512, ACT, last ? 1 : 0); }
                if (!(MIXFLAGS & 2)) { nv_na<<<dim3(SEQ, 8, 8), 128, 0, stream>>>(PA, NVT, rpb + (size_t)l * 8 * 15 * 31, ACT, 0);
                    if (!last) nv_na<<<dim3(CTXL, 8, 8), 128, 0, stream>>>(PA, NVT, rpb + (size_t)l * 8 * 15 * 31, ACT, 1); }
            }
            ph = ph2; continue;
        }
        if (ph == PH_PRO) { nv_mod<<<dim3(24, 9, 2), 256, 0, stream>>>(c, c_ctx, ada_w, ada_b, MOD); ++ph; continue; }
        if (ph == PH_FINAL) {
            nv_combine<<<MROWS, 256, 0, stream>>>(out, CTXB, MOD + (size_t)9 * 6144, TOK_SLOT, TOK_W, Y, 1);
            nv_final<<<NB * SEQ, 256, 0, stream>>>(out, final_w); ++ph; continue; }
        const int l = (ph - 1) / 10, k = (ph - 1) % 10; const bool last = (l == 1); const int lo = 32 * l;
        const float* MODl = MOD + (size_t)l * 9 * 6144;
        const float* sl = l == 0 ? x : out; const float* scx = l == 0 ? ctx : CTXB;
        int* TILE_E = TILE_E0 + 512 * l;
        switch (k) {
        case K_NORM1:
            if (l == 1) nv_combine<<<MROWS, 256, 0, stream>>>(out, CTXB, MOD, TOK_SLOT, TOK_W, Y, 0);
            nv_norm<<<MROWS, 256, 0, stream>>>(sl, scx, norm1_w + l * 1024, MODl, 0, 1, ACT, 0, nullptr, nullptr, nullptr, nullptr, nullptr, 0); break;
        case K_GEMM_IN: { EpiIn ei{QKRAW, PA, MVT, NVT, GATES, gate_b + l * 16}; EpiOut eo{};
            nv_gemm<0><<<dim3((N_IN + 63) / 64, MROWS / 64), 256, 0, stream>>>(ACT, w_in + (size_t)l * 1024 * N_IN, N_IN, N_IN, 1024, ei, eo); } break;
        case K_PREP: nv_prep<<<MROWS * 1024 / 256, 256, 0, stream>>>(QKRAW, conv_w + l * 3072, conv_b + l * 1024, QP, KP, KPT); break;
        case K_SCAN: nv_scan<<<dim3(64, 64), 256, 0, stream>>>(KP, MVT, GATES, CST, NST, MST); break;
        case K_MIX:
            nv_mout<<<dim3(NCHUNK, 32), 256, (128 * 129 + 1024) * 4, stream>>>(QP, KP, MVT, GATES, CST, NST, MST, HSUM, last ? 1 : 0);
            nv_mnorm<<<MROWS, 256, 0, stream>>>(HSUM, PA, mnorm_w + l * 512, ACT, last ? 1 : 0);
            nv_na<<<dim3(SEQ, 8, 8), 128, 0, stream>>>(PA, NVT, rpb + (size_t)l * 8 * 15 * 31, ACT, 0);
            if (!last) nv_na<<<dim3(CTXL, 8, 8), 128, 0, stream>>>(PA, NVT, rpb + (size_t)l * 8 * 15 * 31, ACT, 1);
            break;
        case K_GEMM_OUT: { EpiOut eo2{sl, scx, out, CTXB, MODl, last ? 1 : 0, 0}; EpiIn ei2{};
            nv_gemm<1><<<dim3(16, MROWS / 64), 256, 0, stream>>>(ACT, w_out + (size_t)l * 1024 * 1024, 1024, 1024, 1024, ei2, eo2); } break;
        case K_NORM2: nv_norm<<<MROWS, 256, 0, stream>>>(out, CTXB, norm2_w + l * 1024, MODl, 3, 4, ACT, 1, router_w, router_b, TOK_E, TOK_W, CTL + CW_CNT + lo, last ? 1 : 0); break;
        case K_SLOTS:
            nv_slots_off<<<1, 256, 0, stream>>>(CTL, SLOT_TOK, SLOT_W, TILE_E, lo);
            nv_slots_assign<<<MROWS / 256, 256, 0, stream>>>(CTL, TOK_E, TOK_W, TOK_SLOT, SLOT_TOK, SLOT_W, last ? 1 : 0, lo); break;
        case K_MOE1: nv_moe1<<<MAXSLOTS, 256, 0, stream>>>(CTL, ACT, SLOT_TOK, SLOT_W, TILE_E, exp_w1 + (size_t)l * 16 * 1024 * 512, exp_w3 + (size_t)l * 16 * 1024 * 512, ACTM, lo); break;
        case K_MOE2: nv_moe2<<<MAXSLOTS, 256, 0, stream>>>(CTL, ACTM, SLOT_W, TILE_E, exp_w2 + (size_t)l * 16 * 512 * 1024, Y, lo); break;
        }
        ++ph;
    }
}
```

```cpp
#include <hip/hip_runtime.h>
#include <cstdio>
#include <cstdint>

typedef unsigned short bf16;
__device__ __forceinline__ float bf2f(bf16 b) { return __uint_as_float(((unsigned)b) << 16); }
__device__ __forceinline__ bf16 f2bf(float f) { unsigned u = __float_as_uint(f); u += 0x7fffu + ((u >> 16) & 1u); return (bf16)(u >> 16); }

constexpr int DM = 1024, NB = 8, SEQ = 4096, CTXL = 256, UT = SEQ + CTXL  ;
constexpr int UTP = 4416;
constexpr int MROWS = NB * UT;
constexpr int NCHUNK = UT / 128;
constexpr int N_IN = 3600;
constexpr float EPS = 1e-6f;
constexpr int MAXSLOTS = 73728;

constexpr size_t MiB = 1u << 20;
constexpr size_t WS_CTL = 0;
constexpr size_t WS_MOD = 1 * MiB;
constexpr size_t WS_CTX = 2 * MiB;
constexpr size_t WS_WIN = 10 * MiB;
constexpr size_t WS_WOUT = 25 * MiB;
constexpr size_t WS_GATES = 29 * MiB;
constexpr size_t WS_ROUTE = 32 * MiB;
constexpr size_t WS_ACT = 34 * MiB;
constexpr size_t WS_PA = 102 * MiB;
constexpr size_t WS_QKRAW = 204 * MiB;
constexpr size_t WS_CST = 204 * MiB;
constexpr size_t WS_MVT = 272 * MiB;
constexpr size_t WS_NVT = 307 * MiB;
constexpr size_t WS_QP = 342 * MiB;
constexpr size_t WS_KP = 376 * MiB;
constexpr size_t WS_KPT = 410 * MiB;
constexpr size_t WS_NST = 445 * MiB;
constexpr size_t WS_MST = 446 * MiB + 512 * 1024;
constexpr size_t WS_HSUM = 444 * MiB;
constexpr size_t WS_DUMMY = 449 * MiB;
constexpr size_t WS_ACTM = 150 * MiB;
constexpr size_t WS_Y = 222 * MiB;
constexpr size_t WS_END = 512 * MiB;
constexpr size_t RT_TOK_E = 0, RT_TOK_W = 300 * 1024, RT_TOK_SLOT = 600 * 1024, RT_SLOT_TOK = 900 * 1024, RT_SLOT_W = 1200 * 1024, RT_TILE_E = 1500 * 1024;
constexpr int CW_CNT = 1024, CW_CUR = 1088, CW_OFF = 1152  , CW_NT = 1216;

__device__ __forceinline__ float silu_f(float v) { return v / (1.f + expf(-v)); }
__device__ __forceinline__ float sigmoid_f(float v) { return 1.f / (1.f + expf(-v)); }
__device__ __forceinline__ float logsig_f(float x) { return fminf(x, 0.f) - log1pf(expf(-fabsf(x))); }

__global__ void nv_mod(const float* c, const float* c_ctx, const float* ada_w, const float* ada_b, float* MOD) {
    const int j = blockIdx.x * 256 + threadIdx.x, r = blockIdx.y, l = blockIdx.z;
    __shared__ float s[1024];
    const float* src = r < 8 ? c + r * 1024 : c_ctx;
    for (int k = threadIdx.x; k < 1024; k += 256) s[k] = silu_f(src[k]);
    __syncthreads();
    const float* w = ada_w + (size_t)l * 1024 * 6144;
    float acc = 0.f;
    for (int k = 0; k < 1024; ++k) acc += s[k] * w[(size_t)k * 6144 + j];
    MOD[((size_t)l * 9 + r) * 6144 + j] = acc + ada_b[l * 6144 + j];
}

__device__ __forceinline__ float block_sum256(float v, float* red) {
    for (int o = 32; o >= 1; o >>= 1) v += __shfl_xor(v, o);
    __syncthreads();
    if ((threadIdx.x & 63) == 0) red[threadIdx.x >> 6] = v;
    __syncthreads();
    return red[0] + red[1] + red[2] + red[3];
}

__global__ void nv_norm(const float* xl, const float* xc, const float* nw, const float* MODl, int sh, int sc, bf16* ACT, int do_router,
                        const float* router_w, const float* router_b, int* TOK_E, float* TOK_W, unsigned* CNT, int skip_ctx) {
    const int row = blockIdx.x, b = row / UT, u = row % UT, tid = threadIdx.x;
    const bool ctx = u < CTXL;
    if (ctx && skip_ctx) return;
    __shared__ float red[4];
    __shared__ float lg[4][16];
    const float* xr = ctx ? xc + ((size_t)b * CTXL + u) * DM : xl + ((size_t)b * SEQ + (u - CTXL)) * DM;
    float v[4]; float ss = 0.f;
    for (int i = 0; i < 4; ++i) { v[i] = xr[tid + 256 * i]; ss += v[i] * v[i]; }
    ss = block_sum256(ss, red);
    const float rstd = rsqrtf(ss * (1.f / DM) + EPS);
    const float* md = MODl + (size_t)(ctx ? 8 : b) * 6144;
    float h[4];
    for (int i = 0; i < 4; ++i) { const int col = tid + 256 * i; h[i] = v[i] * rstd * nw[col] * (1.f + md[sc * 1024 + col]) + md[sh * 1024 + col]; ACT[(size_t)row * DM + col] = f2bf(h[i]); }
    if (!do_router) return;
    float pl[16];
    for (int e = 0; e < 16; ++e) { float a = 0.f; for (int i = 0; i < 4; ++i) a += h[i] * router_w[(tid + 256 * i) * 16 + e]; pl[e] = a; }
    for (int e = 0; e < 16; ++e) { float a = pl[e]; for (int o = 32; o >= 1; o >>= 1) a += __shfl_xor(a, o); if ((tid & 63) == 0) lg[tid >> 6][e] = a; }
    __syncthreads();
    if (tid == 0) {
        float p[16], sel[16], mx = -1e30f, sum = 0.f;
        for (int e = 0; e < 16; ++e) { p[e] = lg[0][e] + lg[1][e] + lg[2][e] + lg[3][e]; mx = fmaxf(mx, p[e]); }
        for (int e = 0; e < 16; ++e) { p[e] = expf(p[e] - mx); sum += p[e]; }
        for (int e = 0; e < 16; ++e) { p[e] /= sum; sel[e] = p[e] + router_b[e]; }
        int best = 0; float bgs = -1e30f;
        for (int g = 0; g < 4; ++g) {
            float m1 = -1e30f, m2 = -1e30f;
            for (int k = 0; k < 4; ++k) { const float s = sel[4 * g + k]; if (s > m1) { m2 = m1; m1 = s; } else if (s > m2) m2 = s; }
            if (m1 + m2 > bgs) { bgs = m1 + m2; best = g; }
        }
        int i0 = 4 * best; for (int k = 1; k < 4; ++k) if (sel[4 * best + k] > sel[i0]) i0 = 4 * best + k;
        int i1 = -1; for (int k = 0; k < 4; ++k) { const int e = 4 * best + k; if (e == i0) continue; if (i1 < 0 || sel[e] > sel[i1]) i1 = e; }
        const float w0 = p[i0], w1 = p[i1], ws = w0 + w1;
        TOK_E[row * 2] = i0; TOK_E[row * 2 + 1] = i1; TOK_W[row * 2] = w0 / ws; TOK_W[row * 2 + 1] = w1 / ws;
        atomicAdd(&CNT[i0], 1u); atomicAdd(&CNT[i1], 1u);
    }
}

struct EpiIn { bf16* QKRAW; bf16* PA; bf16* MVT; bf16* NVT; float* GATES; const float* gate_b; };
struct EpiOut { const float* sl; const float* sc; float* dl; float* dc; const float* MODl; int skip_ctx; int pad; };

template <int MODE> __global__ void nv_gemm(const bf16* A, const float* W, int ldw, int N, int K, EpiIn ei, EpiOut eo) {
    __shared__ float As[16][65], Bs[16][64];
    const int tid = threadIdx.x, tx = tid & 15, ty = tid >> 4, row0 = blockIdx.y * 64, col0 = blockIdx.x * 64;
    float acc[4][4];
    for (int i = 0; i < 4; ++i) for (int j = 0; j < 4; ++j) acc[i][j] = 0.f;
    for (int kt = 0; kt < K; kt += 16) {
        for (int i = 0; i < 4; ++i) { const int idx = tid + 256 * i, m = idx >> 4, k = idx & 15; As[k][m] = bf2f(A[(size_t)(row0 + m) * K + kt + k]); }
        for (int i = 0; i < 4; ++i) { const int idx = tid + 256 * i, k = idx >> 6, n = idx & 63; Bs[k][n] = (col0 + n < N) ? W[(size_t)(kt + k) * ldw + col0 + n] : 0.f; }
        __syncthreads();
        for (int k = 0; k < 16; ++k) {
            float a[4], bb[4];
            for (int i = 0; i < 4; ++i) a[i] = As[k][ty * 4 + i];
            for (int j = 0; j < 4; ++j) bb[j] = Bs[k][tx * 4 + j];
            for (int i = 0; i < 4; ++i) for (int j = 0; j < 4; ++j) acc[i][j] += a[i] * bb[j];
        }
        __syncthreads();
    }
    for (int i = 0; i < 4; ++i) for (int j = 0; j < 4; ++j) {
        const int row = row0 + ty * 4 + i, n = col0 + tx * 4 + j; if (n >= N) continue;
        const float v = acc[i][j]; const int b = row / UT, u = row % UT;
        if (MODE == 0) {
            if (n < 512) ei.QKRAW[(size_t)row * 1024 + n] = f2bf(v);
            else if (n < 1024) ei.PA[(size_t)row * 1536 + (n - 512)] = f2bf(v);
            else if (n < 1536) ei.PA[(size_t)row * 1536 + 512 + (n - 1024)] = f2bf(v);
            else if (n < 2048) ei.QKRAW[(size_t)row * 1024 + 512 + (n - 1536)] = f2bf(v);
            else if (n < 2560) { const int c = n - 2048; ei.MVT[((size_t)(b * 4 + c / 128) * 128 + c % 128) * UTP + u] = f2bf(v); }
            else if (n < 2576) ei.GATES[(size_t)row * 16 + (n - 2560)] = v + ei.gate_b[n - 2560];
            else if (n < 3088) ei.PA[(size_t)row * 1536 + 1024 + (n - 2576)] = f2bf(v);
            else { const int c = n - 3088; ei.NVT[((size_t)(b * 8 + c / 64) * 64 + c % 64) * UTP + u] = f2bf(v); }
        } else {
            const bool ctx = u < CTXL; if (ctx && eo.skip_ctx) continue;
            const size_t off = ctx ? ((size_t)b * CTXL + u) * DM + n : ((size_t)b * SEQ + (u - CTXL)) * DM + n;
            const float md = eo.MODl[(size_t)(ctx ? 8 : b) * 6144 + 2 * 1024 + n];
            if (ctx) eo.dc[off] = eo.sc[off] + md * v; else eo.dl[off] = eo.sl[off] + md * v;
        }
    }
}

__device__ __forceinline__ float conv_silu(const bf16* QKRAW, int row, int u, int col, const float* cw, const float* cb) {
    const int lo = u < CTXL ? 0 : CTXL, hi = u < CTXL ? CTXL - 1 : UT - 1;
    float y = cb[col] + cw[1024 + col] * bf2f(QKRAW[(size_t)row * 1024 + col]);
    if (u > lo) y += cw[col] * bf2f(QKRAW[(size_t)(row - 1) * 1024 + col]);
    if (u < hi) y += cw[2048 + col] * bf2f(QKRAW[(size_t)(row + 1) * 1024 + col]);
    return silu_f(y);
}
__global__ void nv_prep(const bf16* QKRAW, const float* cw, const float* cb, bf16* QP, bf16* KP, bf16* KPT) {
    const size_t gid = (size_t)blockIdx.x * 256 + threadIdx.x;
    const int row = (int)(gid >> 10), col = (int)(gid & 1023), b = row / UT, u = row % UT;
    const int c = col & 511, head = c >> 7, d = c & 127;
    float val = conv_silu(QKRAW, row, u, col, cw, cb);
    if (u >= CTXL) {
        const int t = u - CTXL, blk = d >> 6, dd = d & 63, i = dd & 31;
        const float pos = (float)(blk == 0 ? (t >> 6) : (t & 63));
        const float inv = powf(10000.f, -(float)(2 * i) / 64.f);
        const float ang = pos * inv, cs = cosf(ang), sn = sinf(ang);
        const float pv = conv_silu(QKRAW, row, u, dd < 32 ? col + 32 : col - 32, cw, cb);
        val = dd < 32 ? val * cs - pv * sn : pv * sn + val * cs;
    }
    if (col < 512) QP[(size_t)row * 512 + c] = f2bf(val);
    else { val *= 0.08838834764831845f; KP[(size_t)row * 512 + c] = f2bf(val); KPT[((size_t)(b * 4 + head) * 128 + d) * UTP + u] = f2bf(val); }
}

__device__ __forceinline__ int u_of(int dir, int j, int s) {
    if (dir == 0) return 128 * j + s;
    return j < 2 ? 255 - (128 * j + s) : UT - 1 - 128 * (j - 2) - s;
}
__global__ void nv_scan(const bf16* KP, const bf16* MVT, const float* GATES, bf16* CST, float* NST, float* MST) {
    const int chain = blockIdx.x, b = chain >> 3, h = (chain >> 1) & 3, dir = chain & 1, tid = threadIdx.x;
    const int dk = tid & 127, dv = blockIdx.y * 2 + (tid >> 7);
    __shared__ float wt[128], lf[128], ig[128], scal[2];
    __shared__ int us[128];
    float C = 0.f, n = 0.f;
    if (tid == 0) scal[1] = 0.f;
    __syncthreads();
    for (int j = 0; j < NCHUNK; ++j) {
        CST[((size_t)(chain * NCHUNK + j) * 128 + dv) * 128 + dk] = f2bf(C);
        if (blockIdx.y == 0 && tid < 128) NST[(size_t)(chain * NCHUNK + j) * 128 + dk] = n;
        if (blockIdx.y == 0 && tid == 0) MST[chain * NCHUNK + j] = scal[1];
        if (tid < 128) { const int u = u_of(dir, j, tid); us[tid] = u; const size_t row = (size_t)b * UT + u;
            lf[tid] = logsig_f(GATES[row * 16 + (2 * dir + 1) * 4 + h]); ig[tid] = GATES[row * 16 + (2 * dir) * 4 + h]; }
        __syncthreads();
        if (tid == 0) {
            float run = 0.f; for (int s = 0; s < 128; ++s) { run += lf[s]; lf[s] = run; }
            const float bend = run; float gmax = -1e30f;
            for (int s = 0; s < 128; ++s) { const float g = bend - lf[s] + ig[s]; ig[s] = g; gmax = fmaxf(gmax, g); }
            const float m = scal[1], mn = fmaxf(bend + m, gmax);
            scal[0] = expf(bend + m - mn); scal[1] = mn;
            for (int s = 0; s < 128; ++s) wt[s] = expf(ig[s] - mn);
        }
        __syncthreads();
        const float wo = scal[0]; float accC = 0.f, accn = 0.f;
        for (int s = 0; s < 128; ++s) { const int u = us[s]; const float kk = wt[s] * bf2f(KP[((size_t)b * UT + u) * 512 + h * 128 + dk]);
            accC += kk * bf2f(MVT[((size_t)(b * 4 + h) * 128 + dv) * UTP + u]); accn += kk; }
        C = wo * C + accC; n = wo * n + accn;
        __syncthreads();
    }
}

__global__ void nv_mout(const bf16* QP, const bf16* KP, const bf16* MVT, const float* GATES, const bf16* CST, const float* NST, const float* MST, float* HSUM, int last) {
    const int c = blockIdx.x, bh = blockIdx.y, b = bh >> 2, h = bh & 3, tid = threadIdx.x;
    if (last && c < 2) return;
    extern __shared__ float sm[];
    float* S = sm; float* bb = S + 128 * 129; float* ig = bb + 128; float* den = ig + 128; float* wint = den + 128;
    const int p = tid & 127, half = tid >> 7;
    for (int dir = 0; dir < 2; ++dir) {
        const int j = dir == 0 ? c : (c < 2 ? 1 - c : 35 - c), chain = (b * 4 + h) * 2 + dir;
        if (tid < 128) { const int tau = tid, pp = dir ? 127 - tau : tau; const size_t row = (size_t)b * UT + 128 * c + tau;
            bb[pp] = logsig_f(GATES[row * 16 + (2 * dir + 1) * 4 + h]); ig[pp] = GATES[row * 16 + (2 * dir) * 4 + h]; }
        __syncthreads();
        if (tid == 0) { float run = 0.f; for (int s = 0; s < 128; ++s) { run += bb[s]; bb[s] = run; } }
        __syncthreads();
        const float m = MST[chain * NCHUNK + j];
        const size_t rowp = (size_t)b * UT + 128 * c + (dir ? 127 - p : p);
        const bf16* qrow = QP + rowp * 512 + h * 128;
        for (int p2 = 64 * half; p2 < 64 * half + 64; ++p2) {
            if (p2 > p) continue;
            const bf16* krow = KP + ((size_t)b * UT + 128 * c + (dir ? 127 - p2 : p2)) * 512 + h * 128;
            float dot = 0.f; for (int d = 0; d < 128; ++d) dot += bf2f(qrow[d]) * bf2f(krow[d]);
            S[p * 129 + p2] = dot;
        }
        __syncthreads();
        if (tid < 128) {
            const float inter = bb[p] + m; float mx = inter;
            for (int p2 = 0; p2 <= p; ++p2) mx = fmaxf(mx, bb[p] - bb[p2] + ig[p2]);
            float sum = 0.f;
            for (int p2 = 0; p2 <= p; ++p2) { const float dd = expf(bb[p] - bb[p2] + ig[p2] - mx); const float sv = S[p * 129 + p2] * dd; S[p * 129 + p2] = sv; sum += sv; }
            const float wi = expf(inter - mx);
            float qn = 0.f; const float* nn = NST + (size_t)(chain * NCHUNK + j) * 128;
            for (int d = 0; d < 128; ++d) qn += bf2f(qrow[d]) * nn[d];
            qn = sum + wi * qn;
            den[p] = fmaxf(fabsf(qn), expf(-mx)); wint[p] = wi;
        }
        __syncthreads();
        for (int dv = 64 * half; dv < 64 * half + 64; ++dv) {
            const bf16* vt = MVT + ((size_t)(b * 4 + h) * 128 + dv) * UTP + 128 * c;
            float acc = 0.f;
            for (int p2 = 0; p2 <= p; ++p2) acc += S[p * 129 + p2] * bf2f(vt[dir ? 127 - p2 : p2]);
            const bf16* cc = CST + ((size_t)(chain * NCHUNK + j) * 128 + dv) * 128;
            float qc = 0.f; for (int d = 0; d < 128; ++d) qc += bf2f(qrow[d]) * bf2f(cc[d]);
            const float hv = (acc + wint[p] * qc) / den[p];
            float* o = HSUM + rowp * 512 + h * 128 + dv;
            if (dir == 0) *o = hv; else *o += hv;
        }
        __syncthreads();
    }
}

__global__ void nv_mnorm(const float* HSUM, const bf16* PA, const float* mnw, bf16* ACT, int skip_ctx) {
    const int row = blockIdx.x, u = row % UT, h = threadIdx.x >> 6, lane = threadIdx.x & 63;
    if (u < CTXL && skip_ctx) return;
    const float a = HSUM[(size_t)row * 512 + h * 128 + lane], bq = HSUM[(size_t)row * 512 + h * 128 + 64 + lane];
    float ss = a * a + bq * bq; for (int o = 32; o >= 1; o >>= 1) ss += __shfl_xor(ss, o);
    const float rstd = rsqrtf(ss * (1.f / 128.f) + EPS);
    for (int k = 0; k < 2; ++k) { const int col = h * 128 + 64 * k + lane; const float v = (k ? bq : a) * rstd * mnw[col] * sigmoid_f(bf2f(PA[(size_t)row * 1536 + col]));
        ACT[(size_t)row * 1024 + col] = f2bf(v); }
}

__global__ void nv_na(const bf16* PA, const bf16* NVT, const float* rpb, bf16* ACT, int ctxq) {
    const int tq = blockIdx.x, hd = blockIdx.y, b = blockIdx.z, tid = threadIdx.x;
    __shared__ float q[64], sc[384], red[4], o2[2][64];
    __shared__ int uk[384];
    const size_t rowq = (size_t)b * UT + (ctxq ? tq : CTXL + tq);
    if (tid < 64) q[tid] = bf2f(PA[rowq * 1536 + 512 + hd * 64 + tid]) * 0.125f;
    __syncthreads();
    const int nkeys = ctxq ? 256 : 384;
    for (int key = tid; key < nkeys; key += 128) {
        int uu; float bias = 0.f;
        if (!ctxq && key < 128) { const int i = key >> 4, j = key & 15, r = tq >> 6, c = tq & 63;
            const int rs = min(max(r - 4, 0), 56), cs = min(max(c - 8, 0), 48);
            uu = CTXL + (rs + i) * 64 + cs + j; bias = rpb[(hd * 15 + (rs + i - r + 7)) * 31 + (cs + j - c + 15)]; }
        else uu = ctxq ? key : key - 128;
        const bf16* kr = PA + ((size_t)b * UT + uu) * 1536 + 1024 + hd * 64;
        float dot = 0.f; for (int d = 0; d < 64; ++d) dot += q[d] * bf2f(kr[d]);
        sc[key] = dot + bias; uk[key] = uu;
    }
    __syncthreads();
    float mx = -1e30f; for (int key = tid; key < nkeys; key += 128) mx = fmaxf(mx, sc[key]);
    for (int o = 32; o >= 1; o >>= 1) mx = fmaxf(mx, __shfl_xor(mx, o));
    if ((tid & 63) == 0) red[tid >> 6] = mx;
    __syncthreads();
    mx = fmaxf(red[0], red[1]);
    float sum = 0.f; for (int key = tid; key < nkeys; key += 128) { const float e = expf(sc[key] - mx); sc[key] = e; sum += e; }
    for (int o = 32; o >= 1; o >>= 1) sum += __shfl_xor(sum, o);
    __syncthreads();
    if ((tid & 63) == 0) red[2 + (tid >> 6)] = sum;
    __syncthreads();
    sum = red[2] + red[3];
    const int dv = tid & 63, part = tid >> 6; const bf16* vt = NVT + ((size_t)(b * 8 + hd) * 64 + dv) * UTP;
    float acc = 0.f; for (int key = part * (nkeys / 2); key < (part + 1) * (nkeys / 2); ++key) acc += sc[key] * bf2f(vt[uk[key]]);
    o2[part][dv] = acc;
    __syncthreads();
    if (tid < 64) ACT[rowq * 1024 + 512 + hd * 64 + tid] = f2bf((o2[0][tid] + o2[1][tid]) / sum);
}

__global__ void nv_slots_off(unsigned* CTL, int* SLOT_TOK, float* SLOT_W, int* TILE_E, int lo) {
    __shared__ unsigned off[17];
    if (threadIdx.x == 0) { unsigned o = 0; for (int e = 0; e < 16; ++e) { off[e] = o; CTL[CW_OFF + lo + e] = o; o += (CTL[CW_CNT + lo + e] + 255u) & ~255u; CTL[CW_CUR + lo + e] = 0u; } off[16] = o; CTL[CW_OFF + lo + 16] = o; CTL[CW_NT + lo] = o >> 8; }
    __syncthreads();
    for (int e = 0; e < 16; ++e) {
        const unsigned cnt = CTL[CW_CNT + lo + e];
        for (unsigned i = off[e] + cnt + threadIdx.x; i < off[e + 1]; i += blockDim.x) { SLOT_TOK[i] = 0; SLOT_W[i] = 0.f; }
        for (unsigned t = (off[e] >> 8) + threadIdx.x; t < (off[e + 1] >> 8); t += blockDim.x) TILE_E[t] = e;
    }
}
__global__ void nv_slots_assign(unsigned* CTL, const int* TOK_E, const float* TOK_W, int* TOK_SLOT, int* SLOT_TOK, float* SLOT_W, int skip_ctx, int lo) {
    const int row = blockIdx.x * 256 + threadIdx.x; if (row >= MROWS) return;
    if ((row % UT) < CTXL && skip_ctx) return;
    for (int k = 0; k < 2; ++k) { const int e = TOK_E[row * 2 + k]; const unsigned pos = atomicAdd(&CTL[CW_CUR + lo + e], 1u); const int slot = (int)(CTL[CW_OFF + lo + e] + pos);
        SLOT_TOK[slot] = row; SLOT_W[slot] = TOK_W[row * 2 + k]; TOK_SLOT[row * 2 + k] = slot; }
}
__global__ void nv_moe1(const unsigned* CTL, const bf16* ACT, const int* SLOT_TOK, const float* SLOT_W, const int* TILE_E, const float* w1, const float* w3, bf16* ACTM, int lo) {
    const int slot = blockIdx.x, tid = threadIdx.x; if ((unsigned)slot >= CTL[CW_OFF + lo + 16]) return;
    const float w = SLOT_W[slot]; if (w == 0.f) return;
    const int e = TILE_E[slot >> 8], tok = SLOT_TOK[slot];
    __shared__ float t[1024];
    for (int k = tid; k < 1024; k += 256) t[k] = bf2f(ACT[(size_t)tok * 1024 + k]);
    __syncthreads();
    const float* a1 = w1 + (size_t)e * 1024 * 512; const float* a3 = w3 + (size_t)e * 1024 * 512;
    for (int cc = 0; cc < 2; ++cc) { const int col = tid + 256 * cc; float g1 = 0.f, g3 = 0.f;
        for (int k = 0; k < 1024; ++k) { g1 += t[k] * a1[(size_t)k * 512 + col]; g3 += t[k] * a3[(size_t)k * 512 + col]; }
        ACTM[(size_t)slot * 512 + col] = f2bf(silu_f(g1) * g3); }
}
__global__ void nv_moe2(const unsigned* CTL, const bf16* ACTM, const float* SLOT_W, const int* TILE_E, const float* w2, bf16* Y, int lo) {
    const int slot = blockIdx.x, tid = threadIdx.x; if ((unsigned)slot >= CTL[CW_OFF + lo + 16]) return;
    if (SLOT_W[slot] == 0.f) return;
    const int e = TILE_E[slot >> 8];
    __shared__ float a[512];
    for (int k = tid; k < 512; k += 256) a[k] = bf2f(ACTM[(size_t)slot * 512 + k]);
    __syncthreads();
    const float* ww = w2 + (size_t)e * 512 * 1024;
    for (int cc = 0; cc < 4; ++cc) { const int col = tid + 256 * cc; float acc = 0.f; for (int k = 0; k < 512; ++k) acc += a[k] * ww[(size_t)k * 1024 + col]; Y[(size_t)slot * 1024 + col] = f2bf(acc); }
}
__global__ void nv_combine(float* xl, float* xc, const float* MODl, const int* TOK_SLOT, const float* TOK_W, const bf16* Y, int skip_ctx) {
    const int row = blockIdx.x, b = row / UT, u = row % UT, tid = threadIdx.x; const bool ctx = u < CTXL;
    if (ctx && skip_ctx) return;
    float* xr = ctx ? xc + ((size_t)b * CTXL + u) * DM : xl + ((size_t)b * SEQ + (u - CTXL)) * DM;
    const int s0 = TOK_SLOT[row * 2], s1 = TOK_SLOT[row * 2 + 1]; const float w0 = TOK_W[row * 2], w1 = TOK_W[row * 2 + 1]; const float* md = MODl + (size_t)(ctx ? 8 : b) * 6144 + 5 * 1024;
    for (int i = 0; i < 4; ++i) { const int col = tid + 256 * i; xr[col] += md[col] * (w0 * bf2f(Y[(size_t)s0 * 1024 + col]) + w1 * bf2f(Y[(size_t)s1 * 1024 + col])); }
}
__global__ void nv_final(float* xl, const float* fw) {
    const int row = blockIdx.x, tid = threadIdx.x; __shared__ float red[4];
    float* xr = xl + (size_t)row * DM; float v[4]; float ss = 0.f;
    for (int i = 0; i < 4; ++i) { v[i] = xr[tid + 256 * i]; ss += v[i] * v[i]; }
    ss = block_sum256(ss, red); const float rstd = rsqrtf(ss * (1.f / DM) + EPS);
    for (int i = 0; i < 4; ++i) xr[tid + 256 * i] = v[i] * rstd * fw[tid + 256 * i];
}

constexpr size_t WS_X16 = WS_ACT;
#define LAS __attribute__((address_space(3)))
#define GAS __attribute__((address_space(1)))
constexpr int NWAVES = 8, NTHR = 512;
constexpr int RING_BYTES = 131072, SCR_BYTES = 147456, LDSCTL_OFF = SCR_BYTES, MISC_OFF = LDSCTL_OFF + 320, LDS_BYTES = 163840;
constexpr size_t WS_EW13_L1 = 462 * MiB, WS_EW2_L1 = 494 * MiB;
constexpr int CW_CONV = 16;
constexpr size_t WS_EW13 = 102 * MiB;
constexpr size_t WS_EW2 = 134 * MiB;
constexpr size_t WS_AG = 366 * MiB;
constexpr size_t WS_PARTO = WS_KPT;
constexpr size_t WS_PARTM = 447 * MiB;
constexpr size_t WS_GA = 458 * MiB;
constexpr int CW_BAR = 4096;
constexpr int N_BAR_REGIONS = 24;
constexpr int PH_PRO = 0, PH_FINAL = 21, NPHASE = 22;
constexpr int K_NORM1 = 0, K_GEMM_IN = 1, K_PREP = 2, K_SCAN = 3, K_MIX = 4, K_GEMM_OUT = 5, K_NORM2 = 6, K_SLOTS = 7, K_MOE1 = 8, K_MOE2 = 9;

typedef float f32x4 __attribute__((ext_vector_type(4)));
typedef float f32x2 __attribute__((ext_vector_type(2)));
typedef unsigned u32x4 __attribute__((ext_vector_type(4)));
typedef unsigned u32x2 __attribute__((ext_vector_type(2)));
typedef short bf16x8 __attribute__((ext_vector_type(8)));
#define LDS_WAIT() asm volatile("s_waitcnt lgkmcnt(0)" ::: "memory")
#define VM_WAIT() asm volatile("s_waitcnt vmcnt(0)" ::: "memory")
__device__ __forceinline__ unsigned cvt_pk_bf16(float lo, float hi) { unsigned r; asm volatile("v_cvt_pk_bf16_f32 %0, %1, %2" : "=v"(r) : "v"(lo), "v"(hi)); return r; }
__device__ __forceinline__ unsigned ld_u32(const unsigned* p) { return __hip_atomic_load(p, __ATOMIC_RELAXED, __HIP_MEMORY_SCOPE_AGENT); }
__device__ __forceinline__ int ld_i32(const int* p) { return __hip_atomic_load(p, __ATOMIC_RELAXED, __HIP_MEMORY_SCOPE_AGENT); }
__device__ __forceinline__ float ld_f32(const float* p) { return __uint_as_float(__hip_atomic_load((const unsigned*)p, __ATOMIC_RELAXED, __HIP_MEMORY_SCOPE_AGENT)); }
__device__ __forceinline__ int lane_id() { int l; asm volatile("v_mbcnt_lo_u32_b32 %0, -1, 0\n\tv_mbcnt_hi_u32_b32 %0, -1, %0" : "=v"(l)); return l; }
template <int CTRL> __device__ __forceinline__ float dpp_f(float v) { return __int_as_float(__builtin_amdgcn_update_dpp(0, __float_as_int(v), CTRL, 0xF, 0xF, true)); }
__device__ __forceinline__ float red16_add(float v) { const auto r = __builtin_amdgcn_permlane16_swap(__float_as_uint(v), __float_as_uint(v), false, false); return __uint_as_float(r[0]) + __uint_as_float(r[1]); }
__device__ __forceinline__ float red32_add(float v) { const auto r = __builtin_amdgcn_permlane32_swap(__float_as_uint(v), __float_as_uint(v), false, false); return __uint_as_float(r[0]) + __uint_as_float(r[1]); }
__device__ __forceinline__ float red16_max(float v) { const auto r = __builtin_amdgcn_permlane16_swap(__float_as_uint(v), __float_as_uint(v), false, false); return fmaxf(__uint_as_float(r[0]), __uint_as_float(r[1])); }
__device__ __forceinline__ float red32_max(float v) { const auto r = __builtin_amdgcn_permlane32_swap(__float_as_uint(v), __float_as_uint(v), false, false); return fmaxf(__uint_as_float(r[0]), __uint_as_float(r[1])); }
__device__ __forceinline__ float red_hi_add(float v) { return red32_add(red16_add(v)); }
__device__ __forceinline__ float red_hi_max(float v) { return red32_max(red16_max(v)); }
__device__ __forceinline__ float wave_sum(float v) {
    v += dpp_f<0xB1>(v);
    v += dpp_f<0x4E>(v);
    v += dpp_f<0x141>(v);
    v += dpp_f<0x140>(v);
    return red_hi_add(v);
}
__device__ __forceinline__ float fast_silu(float v) { return v * __builtin_amdgcn_rcpf(1.f + __expf(-v)); }

#define XB_TMO      128
#define XB_XCNT(j)  (256  + 64 * (j))
#define XB_XSUB(j)  (1280 + 64 * (j))
#define XB_XGEN(j)  (2304 + 64 * (j))
#define XB_TOP      3328
#define XB_TOPGEN   3392
#define XCD_BAR_WORDS 3456
#define XB_SPIN_CAP (1u << 18)
__device__ __forceinline__ unsigned xb_ld(unsigned* p)              { return __hip_atomic_load(p, __ATOMIC_RELAXED, __HIP_MEMORY_SCOPE_AGENT); }
__device__ __forceinline__ unsigned xb_add(unsigned* p, unsigned v) { return __hip_atomic_fetch_add(p, v, __ATOMIC_RELAXED, __HIP_MEMORY_SCOPE_AGENT); }
__device__ __forceinline__ unsigned xb_xcc_id() { return (unsigned)__builtin_amdgcn_s_getreg((3 << 11) | 20) & 0xFu; }
#define XB_SPIN(cond, bar) do { unsigned _sp = 0; while (cond) { __builtin_amdgcn_s_sleep(1); \
    if ((++_sp & 255u) == 0u) { if (xb_ld(&(bar)[XB_TMO])) break; if (_sp > XB_SPIN_CAP) { atomicAdd(&(bar)[XB_TMO], 1u); break; } } } } while (0)
struct XcdBarrier { unsigned* bar; unsigned x; volatile LAS unsigned* st; };
__device__ __forceinline__ XcdBarrier xcd_barrier_post(unsigned* bar, volatile LAS unsigned* st, bool leader) {
    XcdBarrier b; b.bar = bar; b.x = xb_xcc_id(); b.st = st;
    if (leader) (void)xb_add(&bar[XB_XCNT(b.x)], 1u);
    return b;
}
__device__ __forceinline__ void xcd_barrier_complete(unsigned* bar, unsigned x, unsigned& nloc, unsigned& nx) {
    const unsigned G = gridDim.x * gridDim.y * gridDim.z;
    unsigned sum, cnt, mine, sp = 0u;
    for (;;) {
        sum = 0u; cnt = 0u;
#pragma unroll
        for (unsigned j = 0; j < 16; ++j) { const unsigned c = xb_ld(&bar[XB_XCNT(j)]); sum += c; cnt += (c > 0u) ? 1u : 0u; }
        mine = xb_ld(&bar[XB_XCNT(x)]);
        if (sum == G) break;
        __builtin_amdgcn_s_sleep(1);
        if ((++sp & 255u) == 0u) { if (xb_ld(&bar[XB_TMO])) break; if (sp > XB_SPIN_CAP) { atomicAdd(&bar[XB_TMO], 1u); break; } }
    }
    nloc = mine > 0u ? mine : 1u; nx = cnt > 0u ? cnt : 1u;
}
__device__ __forceinline__ void xcd_barrier(const XcdBarrier& b, bool leader) {
    asm volatile("s_waitcnt vmcnt(0)" ::: "memory");
    __syncthreads();
    if (leader) {
        unsigned* bar = b.bar;
        __builtin_amdgcn_s_waitcnt(0);
        unsigned nloc = b.st[0], nx = b.st[1];
        if (nloc == 0u) { xcd_barrier_complete(bar, b.x, nloc, nx); b.st[0] = nloc; b.st[1] = nx; }
        const unsigned old = xb_add(&bar[XB_XSUB(b.x)], 1u);
        const unsigned gen = old / nloc;
        if (old + 1u == (gen + 1u) * nloc) {
            __builtin_amdgcn_fence(__ATOMIC_RELEASE, "agent");
            asm volatile("s_waitcnt vmcnt(0)" ::: "memory");
            const unsigned og = xb_add(&bar[XB_TOP], 1u);
            const unsigned tg = og / nx;
            if (og + 1u == (tg + 1u) * nx) xb_add(&bar[XB_TOPGEN], 1u);
            else XB_SPIN(xb_ld(&bar[XB_TOPGEN]) == tg, bar);
            __builtin_amdgcn_fence(__ATOMIC_ACQUIRE, "agent");
            xb_add(&bar[XB_XGEN(b.x)], 1u);
            asm volatile("s_waitcnt vmcnt(0)" ::: "memory");
        } else {
            XB_SPIN(xb_ld(&bar[XB_XGEN(b.x)]) == gen, bar);
            __builtin_amdgcn_fence(__ATOMIC_ACQUIRE, "agent");
            asm volatile("s_waitcnt vmcnt(0)" ::: "memory");
        }
    }
    __syncthreads();
}

namespace pg8 {
constexpr int BM = 256, BK = 64, HALF = 128, HTB = HALF * BK * 2, STAGE_BYTES = 8 * HTB, NXCD = 8, WGM = 8;
__host__ __device__ __forceinline__ int lds_byte(int r, int c) { const int st = (r >> 4) * 2 + (c >> 5), rr = r & 15, cc = c & 31, ob = rr * 64 + cc * 2; return st * 1024 + (ob ^ (((ob >> 9) & 1) << 5)); }
__host__ __device__ __forceinline__ void stage_rc(int b, int& R, int& C) { const int st = b / 1024, sb = b % 1024, swz = sb ^ (((sb >> 9) & 1) << 5); R = (st >> 1) * 16 + swz / 64; C = (st & 1) * 32 + (swz % 64) / 2; }
__host__ __device__ __forceinline__ int perm32(int rho) { const int n = rho >> 4, i = rho & 15; return 8 * (i >> 2) + 4 * n + (i & 3); }
struct Unit { int pm, pn; const char* A; const char* B; };
struct GridOrder {
    int nM, nN, nwg, G, c;
    __device__ void init(int nM_, int nN_, int G_, int c_) { nM = nM_; nN = nN_; nwg = nM * nN; G = G_; c = c_; }
    __device__ bool map(int i, int& pm, int& pn) const {
        const long L = (long)i * G + c; if (L >= nwg) return false;
        int wgid = (int)L; { const int q = nwg / NXCD, r = nwg % NXCD, xcd = wgid % NXCD, off = wgid / NXCD; wgid = (xcd < r ? xcd * (q + 1) : r * (q + 1) + (xcd - r) * q) + off; }
        const int nig = WGM * nN, gid = wgid / nig, fm = gid * WGM, gsz = (nM - fm) < WGM ? (nM - fm) : WGM;
        pm = fm + ((wgid % nig) % gsz); pn = (wgid % nig) / gsz; return true;
    }
};
template <class Epi, class Sched, bool ALIGN_EPI = true, bool SP2 = true, bool GATHER = false>
__device__ __forceinline__ void gemm_phase(LAS unsigned char* lds, const int K, const Sched& S, const Epi& E, const int wave_) {
    int tid_ = wave_ * 64 + lane_id(); asm volatile("" : "+v"(tid_));
    const int tid = tid_, wid = __builtin_amdgcn_readfirstlane(tid >> 6), lane = tid & 63, wr = wid >> 2, wc = wid & 3, fr = lane & 15, fq = lane >> 4;
    const int nt = K / BK;
    static_assert(!GATHER || SP2, "row gather is implemented for the SP2 loop");
    unsigned voffA[2], voffB[2]; int Rr[2]; unsigned Cb[2];
#pragma unroll
    for (int i = 0; i < 2; ++i) { int R, C; stage_rc(tid * 16 + i * 8192, R, C); const int Rb = Epi::PERM ? ((R & ~31) + perm32(R & 31)) : R;
        voffA[i] = (unsigned)(R * K + C) * 2u; voffB[i] = (unsigned)(Rb * K + C) * 2u; Rr[i] = R; Cb[i] = (unsigned)C * 2u; }
    const size_t kstep = (size_t)(BK * 2);
    const size_t hstep = (size_t)HALF * K * 2;
    unsigned gA[2][2], gN[2][2];
    const unsigned ldsw = (unsigned)wid * 1024u;
    const int aoff = lds_byte(wr * 64 + fr, fq * 8), boff = lds_byte(wc * 32 + fr, fq * 8);
#define PG8_SA(b, h) (((b) * 2 + (h)) * HTB)
#define PG8_SB(b, h) ((4 + (b) * 2 + (h)) * HTB)
#define PG8_STAGE(bufoff, gbase, voff) do { _Pragma("unroll") for (int _i = 0; _i < 2; ++_i) \
        __builtin_amdgcn_global_load_lds((const unsigned*)((const char*)(gbase) + (voff)[_i]), (LAS unsigned*)(lds + (bufoff) + ldsw + _i * 8192), 16, 0, 0); } while (0)
#define PG8_LDA(dst, b, h) do { _Pragma("unroll") for (int m = 0; m < 4; ++m) _Pragma("unroll") for (int k = 0; k < 2; ++k) dst[m][k] = *(const LAS bf16x8*)(lds + PG8_SA(b, h) + aoff + m * 2048 + k * 1024); } while (0)
#define PG8_LDB(dst, b, h) do { _Pragma("unroll") for (int n = 0; n < 2; ++n) _Pragma("unroll") for (int k = 0; k < 2; ++k) dst[n][k] = *(const LAS bf16x8*)(lds + PG8_SB(b, h) + boff + n * 2048 + k * 1024); } while (0)
#define PG8_MMA(ai, bj, At, Bt) do { __builtin_amdgcn_s_setprio(1); _Pragma("unroll") for (int m = 0; m < 4; ++m) _Pragma("unroll") for (int n = 0; n < 2; ++n) _Pragma("unroll") for (int k = 0; k < 2; ++k) \
        acc[ai][bj][m][n] = __builtin_amdgcn_mfma_f32_16x16x32_bf16(Bt[n][k], At[m][k], acc[ai][bj][m][n], 0, 0, 0); __builtin_amdgcn_s_setprio(0); } while (0)
#define PG8_WAIT_V(n) asm volatile("s_waitcnt vmcnt(" #n ")" ::: "memory")
#define PG8_WAIT_L(n) asm volatile("s_waitcnt lgkmcnt(" #n ")" ::: "memory")
#define PG8_BAR __builtin_amdgcn_s_barrier()
#define PG8_SCHED __builtin_amdgcn_sched_barrier(0)
    Unit cur, nxt; int ui = 0;
    if (!S.next(0, cur)) return;
    f32x4 acc[2][2][4][2];
#pragma unroll
    for (int a = 0; a < 2; ++a)
#pragma unroll
        for (int b = 0; b < 2; ++b)
#pragma unroll
            for (int m = 0; m < 4; ++m)
#pragma unroll
                for (int n = 0; n < 2; ++n) acc[a][b][m][n] = (f32x4){0.f, 0.f, 0.f, 0.f};
    bf16x8 At[4][2], B0[2][2], B1[2][2];
    const char* cA = cur.A; const char* cB = cur.B;
#pragma unroll
    for (int h = 0; h < 2; ++h)
#pragma unroll
        for (int i = 0; i < 2; ++i) { if constexpr (GATHER) gA[h][i] = (unsigned)S.arow(cur, h * HALF + Rr[i]) * (unsigned)(K * 2) + Cb[i]; else gA[h][i] = voffA[i] + (unsigned)(h * hstep); gN[h][i] = gA[h][i]; }
    if constexpr (SP2) {
        PG8_STAGE(PG8_SB(0, 0), cB, voffB); PG8_STAGE(PG8_SB(0, 1), cB + hstep, voffB); PG8_STAGE(PG8_SA(0, 0), cA, gA[0]); PG8_STAGE(PG8_SA(0, 1), cA, gA[1]);
        if (wr == 1) PG8_BAR;
        PG8_WAIT_V(2); PG8_BAR;
        PG8_STAGE(PG8_SB(1, 0), cB + kstep, voffB); PG8_STAGE(PG8_SA(1, 0), cA + kstep, gA[0]); PG8_STAGE(PG8_SB(1, 1), cB + hstep + kstep, voffB);
        PG8_WAIT_V(6); PG8_BAR;
    } else {
        PG8_STAGE(PG8_SB(0, 0), cB, voffB); PG8_STAGE(PG8_SA(0, 0), cA, voffA); PG8_STAGE(PG8_SB(0, 1), cB + hstep, voffB); PG8_STAGE(PG8_SA(0, 1), cA + hstep, voffA);
        if (wr == 1) PG8_BAR;
        PG8_WAIT_V(4); PG8_BAR;
        PG8_STAGE(PG8_SB(1, 0), cB + kstep, voffB); PG8_STAGE(PG8_SA(1, 0), cA + kstep, voffA); PG8_STAGE(PG8_SB(1, 1), cB + hstep + kstep, voffB);
        PG8_WAIT_V(6); PG8_BAR;
    }
    for (;;) {
        const bool has_next = S.next(ui + 1, nxt);
        const char* nA = has_next ? nxt.A : cA; const char* nB = has_next ? nxt.B : cB;
        if constexpr (GATHER) { if (has_next) {
#pragma unroll
            for (int h = 0; h < 2; ++h)
#pragma unroll
                for (int i = 0; i < 2; ++i) gN[h][i] = (unsigned)S.arow(nxt, h * HALF + Rr[i]) * (unsigned)(K * 2) + Cb[i]; } }
        for (int t = 0; t < nt; t += 2) {
            const bool last = (t == nt - 2);
            const char* a1 = cA + (size_t)(t + 1) * kstep;
            const char* a2 = last ? nA : cA + (size_t)(t + 2) * kstep; const char* b2 = last ? nB : cB + (size_t)(t + 2) * kstep;
            const char* a3 = a2 + kstep; const char* b3 = b2 + kstep;
            if constexpr (SP2) {
            unsigned g2[2][2];
#pragma unroll
            for (int h = 0; h < 2; ++h)
#pragma unroll
                for (int i = 0; i < 2; ++i) g2[h][i] = last ? gN[h][i] : gA[h][i];
            PG8_LDB(B0, 0, 0); PG8_LDB(B1, 0, 1); PG8_SCHED; PG8_LDA(At, 0, 0); PG8_STAGE(PG8_SA(1, 1), a1, gA[1]);
            PG8_WAIT_V(8); PG8_WAIT_L(0); PG8_BAR; PG8_MMA(0, 0, At, B0); PG8_MMA(0, 1, At, B1); PG8_BAR; PG8_SCHED;
            PG8_LDA(At, 0, 1); PG8_STAGE(PG8_SB(0, 0), b2, voffB); PG8_STAGE(PG8_SB(0, 1), b2 + hstep, voffB); PG8_STAGE(PG8_SA(0, 0), a2, g2[0]);
            PG8_WAIT_V(8); PG8_WAIT_L(0); PG8_BAR; PG8_MMA(1, 0, At, B0); PG8_MMA(1, 1, At, B1); PG8_BAR; PG8_SCHED;
            PG8_LDB(B0, 1, 0); PG8_LDB(B1, 1, 1); PG8_SCHED; PG8_LDA(At, 1, 0); PG8_STAGE(PG8_SA(0, 1), a2, g2[1]);
            PG8_WAIT_V(8); PG8_WAIT_L(0); PG8_BAR; PG8_MMA(0, 0, At, B0); PG8_MMA(0, 1, At, B1); PG8_BAR; PG8_SCHED;
            PG8_LDA(At, 1, 1); PG8_STAGE(PG8_SB(1, 0), b3, voffB); PG8_STAGE(PG8_SB(1, 1), b3 + hstep, voffB); PG8_STAGE(PG8_SA(1, 0), a3, g2[0]);
            PG8_WAIT_V(8); PG8_WAIT_L(0); PG8_BAR; PG8_MMA(1, 0, At, B0); PG8_MMA(1, 1, At, B1); PG8_BAR; PG8_SCHED;
            } else {
            PG8_LDB(B0, 0, 0); PG8_SCHED; PG8_LDA(At, 0, 0); PG8_STAGE(PG8_SA(1, 1), a1 + hstep, voffA);
            PG8_WAIT_L(8); PG8_BAR; PG8_WAIT_L(0); PG8_MMA(0, 0, At, B0); PG8_BAR; PG8_SCHED;
            PG8_LDB(B1, 0, 1); PG8_STAGE(PG8_SB(0, 0), b2, voffB);
            PG8_BAR; PG8_WAIT_L(0); PG8_MMA(0, 1, At, B1); PG8_BAR;
            PG8_LDA(At, 0, 1); PG8_STAGE(PG8_SA(0, 0), a2, voffA);
            PG8_BAR; PG8_WAIT_L(0); PG8_MMA(1, 0, At, B0); PG8_BAR; PG8_SCHED;
            PG8_STAGE(PG8_SB(0, 1), b2 + hstep, voffB);
            PG8_WAIT_V(6); PG8_BAR; PG8_MMA(1, 1, At, B1); PG8_BAR;
            PG8_LDB(B0, 1, 0); PG8_SCHED; PG8_LDA(At, 1, 0); PG8_STAGE(PG8_SA(0, 1), a2 + hstep, voffA);
            PG8_WAIT_L(8); PG8_BAR; PG8_WAIT_L(0); PG8_MMA(0, 0, At, B0); PG8_BAR; PG8_SCHED;
            PG8_LDB(B1, 1, 1); PG8_STAGE(PG8_SB(1, 0), b3, voffB);
            PG8_BAR; PG8_WAIT_L(0); PG8_MMA(0, 1, At, B1); PG8_BAR;
            PG8_LDA(At, 1, 1); PG8_STAGE(PG8_SA(1, 0), a3, voffA);
            PG8_BAR; PG8_WAIT_L(0); PG8_MMA(1, 0, At, B0); PG8_BAR; PG8_SCHED;
            PG8_STAGE(PG8_SB(1, 1), b3 + hstep, voffB);
            PG8_WAIT_V(6); PG8_BAR; PG8_MMA(1, 1, At, B1); PG8_BAR;
            }
        }
        if constexpr (ALIGN_EPI) { if (wr == 0) PG8_BAR; }
        E(acc, cur, wr, wc, fr, fq);
        if (!has_next) break;
#pragma unroll
        for (int a = 0; a < 2; ++a)
#pragma unroll
            for (int b = 0; b < 2; ++b)
#pragma unroll
                for (int m = 0; m < 4; ++m)
#pragma unroll
                    for (int n = 0; n < 2; ++n) acc[a][b][m][n] = (f32x4){0.f, 0.f, 0.f, 0.f};
        cur = nxt; cA = nA; cB = nB; ++ui;
#pragma unroll
        for (int h = 0; h < 2; ++h)
#pragma unroll
            for (int i = 0; i < 2; ++i) gA[h][i] = gN[h][i];
        if constexpr (ALIGN_EPI) { if (wr == 1) PG8_BAR; }
    }
    PG8_WAIT_V(0);
    if constexpr (!ALIGN_EPI) { if (wr == 0) PG8_BAR; }
    PG8_BAR;
#undef PG8_SA
#undef PG8_SB
#undef PG8_STAGE
#undef PG8_LDA
#undef PG8_LDB
#undef PG8_MMA
#undef PG8_WAIT_V
#undef PG8_WAIT_L
#undef PG8_BAR
#undef PG8_SCHED
}
}

struct SchedDense : pg8::GridOrder {
    const char* A; const char* B; size_t tstep;
    __device__ bool next(int i, pg8::Unit& u) const { int pm, pn; if (!map(i, pm, pn)) return false; u.pm = pm; u.pn = pn; u.A = A + (size_t)pm * tstep; u.B = B + (size_t)pn * tstep; return true; }
};
struct SchedIn : pg8::GridOrder {
    const char* A; const char* B; size_t tstep;
    __device__ bool next(int i, pg8::Unit& u) const { int pm, pn; if (!map(i, pm, pn)) return false; u.pm = pm; u.pn = pn;
        const char* a = A + (size_t)pm * tstep; const char* b = B + (size_t)pn * tstep; const bool sw = (pn >= 10 && pn < 14); u.A = sw ? b : a; u.B = sw ? a : b; return true; }
};
struct SchedLatent : pg8::GridOrder {
    const char* A; const char* B; size_t tstep; int lat;
    __device__ bool next(int i, pg8::Unit& u) const { int pm, pn; if (!map(i, pm, pn)) return false; if (lat) pm = pm + (pm >> 4) + 1; u.pm = pm; u.pn = pn; u.A = A + (size_t)pm * tstep; u.B = B + (size_t)pn * tstep; return true; }
};
struct SchedMoe : pg8::GridOrder {
    const char* A; const char* B; size_t tstep; const int* TILE_E;
    __device__ bool next(int i, pg8::Unit& u) const { int pm, pn; if (!map(i, pm, pn)) return false; const int e = __builtin_amdgcn_readfirstlane(ld_i32(TILE_E + pm)); u.pm = pm; u.pn = pn;
        u.A = A + (size_t)pm * tstep; u.B = B + ((size_t)e * 4 + pn) * tstep; return true; }
};

struct SchedMoeG : pg8::GridOrder {
    const char* A; const char* B; size_t tstepB; const int* TILE_E; const int* SLOT_TOK;
    __device__ bool next(int i, pg8::Unit& u) const { int pm, pn; if (!map(i, pm, pn)) return false; const int e = __builtin_amdgcn_readfirstlane(ld_i32(TILE_E + pm)); u.pm = pm; u.pn = pn;
        u.A = A; u.B = B + ((size_t)e * 4 + pn) * tstepB; return true; }
    __device__ __forceinline__ int arow(const pg8::Unit& u, int r) const { return SLOT_TOK[u.pm * 256 + r]; }
};
struct EpiInP {
    static constexpr bool PERM = true;
    bf16* QKRAW; bf16* PA; bf16* MVT; bf16* NVT; float* GATES; const float* gate_b; int dbg;
    __device__ __forceinline__ void operator()(const f32x4 (&acc)[2][2][4][2], const pg8::Unit& u, int wr, int wc, int fr, int fq) const {
        if (dbg & 1024) return;
        const int pn = u.pn;
        if (pn < 10) {
            bf16* base; int ldc, colt; if (pn < 4) { base = QKRAW; ldc = 1024; colt = pn * 256; } else { base = PA; ldc = 1536; colt = (pn - 4) * 256; }
            const int row0 = u.pm * 256 + wr * 64 + fr, col0 = colt + wc * 32 + 8 * fq;
#pragma unroll
            for (int ai = 0; ai < 2; ++ai)
#pragma unroll
                for (int m = 0; m < 4; ++m) { bf16* rowp = base + (size_t)(row0 + ai * 128 + m * 16) * ldc + col0;
#pragma unroll
                    for (int bj = 0; bj < 2; ++bj) { const f32x4 v0 = acc[ai][bj][m][0], v1 = acc[ai][bj][m][1];
                        u32x4 w; w.x = cvt_pk_bf16(v0[0], v0[1]); w.y = cvt_pk_bf16(v0[2], v0[3]); w.z = cvt_pk_bf16(v1[0], v1[1]); w.w = cvt_pk_bf16(v1[2], v1[3]);
                        *(u32x4*)(rowp + bj * 128) = w; } }
        } else if (pn < 14) {
            const int b = u.pm / 17, u0 = (u.pm % 17) * 256 + wc * 32 + 8 * fq;
#pragma unroll
            for (int ai = 0; ai < 2; ++ai)
#pragma unroll
                for (int m = 0; m < 4; ++m) { const int ch = ai * 128 + wr * 64 + m * 16 + fr;
                    bf16* dst = pn < 12 ? MVT + ((size_t)(b * 4 + (pn - 10) * 2 + (ch >> 7)) * 128 + (ch & 127)) * UTP : NVT + ((size_t)(b * 8 + (pn - 12) * 4 + (ch >> 6)) * 64 + (ch & 63)) * UTP;
#pragma unroll
                    for (int bj = 0; bj < 2; ++bj) { const f32x4 v0 = acc[ai][bj][m][0], v1 = acc[ai][bj][m][1];
                        u32x4 w; w.x = cvt_pk_bf16(v0[0], v0[1]); w.y = cvt_pk_bf16(v0[2], v0[3]); w.z = cvt_pk_bf16(v1[0], v1[1]); w.w = cvt_pk_bf16(v1[2], v1[3]);
                        *(u32x4*)(dst + u0 + bj * 128) = w; } }
        } else {
            if (wc == 0 && fq < 2) {
                const int row0 = u.pm * 256 + wr * 64 + fr;
#pragma unroll
                for (int n = 0; n < 2; ++n) { const f32x4 gb = *(const f32x4*)(gate_b + fq * 8 + n * 4);
#pragma unroll
                    for (int ai = 0; ai < 2; ++ai)
#pragma unroll
                        for (int m = 0; m < 4; ++m) *(f32x4*)(GATES + (size_t)(row0 + ai * 128 + m * 16) * 16 + fq * 8 + n * 4) = acc[ai][0][m][n] + gb; }
            }
        }
    }
};
struct EpiOutP {
    static constexpr bool PERM = true;
    bf16* YB;
    __device__ __forceinline__ void operator()(const f32x4 (&acc)[2][2][4][2], const pg8::Unit& u, int wr, int wc, int fr, int fq) const {
        const int row0 = u.pm * 256 + wr * 64 + fr, col0 = u.pn * 256 + wc * 32 + 8 * fq;
#pragma unroll
        for (int ai = 0; ai < 2; ++ai)
#pragma unroll
            for (int m = 0; m < 4; ++m) { bf16* rowp = YB + (size_t)(row0 + ai * 128 + m * 16) * 1024 + col0;
#pragma unroll
                for (int bj = 0; bj < 2; ++bj) { const f32x4 v0 = acc[ai][bj][m][0], v1 = acc[ai][bj][m][1];
                    u32x4 w; w.x = cvt_pk_bf16(v0[0], v0[1]); w.y = cvt_pk_bf16(v0[2], v0[3]); w.z = cvt_pk_bf16(v1[0], v1[1]); w.w = cvt_pk_bf16(v1[2], v1[3]);
                    *(u32x4*)(rowp + bj * 128) = w; } }
    }
};
struct EpiMoe1 {
    static constexpr bool PERM = true;
    bf16* ACTM;
    __device__ __forceinline__ void operator()(const f32x4 (&acc)[2][2][4][2], const pg8::Unit& u, int wr, int wc, int fr, int fq) const {
        const int row0 = u.pm * 256 + wr * 64 + fr;
#pragma unroll
        for (int ai = 0; ai < 2; ++ai)
#pragma unroll
            for (int m = 0; m < 4; ++m) { bf16* rowp = ACTM + (size_t)(row0 + ai * 128 + m * 16) * 512;
#pragma unroll
                for (int bj = 0; bj < 2; ++bj) { const int j0 = (u.pn * 256 + bj * 128 + wc * 32 + fq * 8) >> 1; const f32x4 g1 = acc[ai][bj][m][0], g3 = acc[ai][bj][m][1];
                    u32x2 w; w.x = cvt_pk_bf16(fast_silu(g1[0]) * g3[0], fast_silu(g1[1]) * g3[1]); w.y = cvt_pk_bf16(fast_silu(g1[2]) * g3[2], fast_silu(g1[3]) * g3[3]);
                    *(u32x2*)(rowp + j0) = w; } }
    }
};
struct EpiMoe2 {
    static constexpr bool PERM = true;
    bf16* Y;
    __device__ __forceinline__ void operator()(const f32x4 (&acc)[2][2][4][2], const pg8::Unit& u, int wr, int wc, int fr, int fq) const {
        const int row0 = u.pm * 256 + wr * 64 + fr, col0 = u.pn * 256 + wc * 32 + 8 * fq;
#pragma unroll
        for (int ai = 0; ai < 2; ++ai)
#pragma unroll
            for (int m = 0; m < 4; ++m) { bf16* rowp = Y + (size_t)(row0 + ai * 128 + m * 16) * 1024 + col0;
#pragma unroll
                for (int bj = 0; bj < 2; ++bj) { const f32x4 v0 = acc[ai][bj][m][0], v1 = acc[ai][bj][m][1];
                    u32x4 w; w.x = cvt_pk_bf16(v0[0], v0[1]); w.y = cvt_pk_bf16(v0[2], v0[3]); w.z = cvt_pk_bf16(v1[0], v1[1]); w.w = cvt_pk_bf16(v1[2], v1[3]);
                    *(u32x4*)(rowp + bj * 128) = w; } }
    }
};

struct Args { const float* in[21]; float* out; unsigned char* ws; int ph_lo, ph_hi, bar_region, mixflags; };
typedef const Args __attribute__((address_space(4)))* KargP;
__device__ __forceinline__ KargP kargs() { KargP p = (KargP)__builtin_amdgcn_kernarg_segment_ptr(); asm volatile("" : "+s"(p)); return p; }
struct Ctx { LAS unsigned char* lds; int wave, G, gw, ngw; };

struct ConvJob { const float* sp; float msk; size_t ld; bf16* dst; int K, n0, k0; };
__device__ __forceinline__ void conv_load(const ConvJob& J, f32x4 (&v)[8], int lane) {
    const int kq = lane >> 3;
#pragma unroll
    for (int it = 0; it < 8; ++it) v[it] = *(const f32x4*)(J.sp + (size_t)(J.k0 + 8 * it + kq) * J.ld);
}
__device__ __forceinline__ void conv_finish(const ConvJob& J, const f32x4 (&v)[8], LAS float* scr, int lane) {
    const int kq = lane >> 3, nq = lane & 7;
#pragma unroll
    for (int it = 0; it < 8; ++it) { LAS float* w = scr + (8 * it + kq) * 33 + 4 * nq; w[0] = v[it][0] * J.msk; w[1] = v[it][1] * J.msk; w[2] = v[it][2] * J.msk; w[3] = v[it][3] * J.msk; }
    LDS_WAIT(); asm volatile("" ::: "memory");
    const int c = lane & 7;
#pragma unroll
    for (int j = 0; j < 4; ++j) { const int n = (lane >> 3) + 8 * j; const LAS float* s = scr + (8 * c) * 33 + n;
        u32x4 o; o.x = cvt_pk_bf16(s[0 * 33], s[1 * 33]); o.y = cvt_pk_bf16(s[2 * 33], s[3 * 33]); o.z = cvt_pk_bf16(s[4 * 33], s[5 * 33]); o.w = cvt_pk_bf16(s[6 * 33], s[7 * 33]);
        *(u32x4*)(J.dst + (size_t)(J.n0 + n) * J.K + J.k0 + 8 * c) = o; }
    LDS_WAIT(); asm volatile("" ::: "memory");
}
__device__ __forceinline__ int win_src(int n) {
    if (n < 512) return n;
    if (n < 1024) return 1536 + (n - 512);
    if (n < 1536) return 512 + (n - 1024);
    if (n < 2048) return 1024 + (n - 1536);
    if (n < 2560) return 2576 + (n - 2048);
    if (n < 3072) return 2048 + (n - 2560);
    if (n < 3584) return 3088 + (n - 3072);
    if (n < 3600) return 2560 + (n - 3584);
    return -1;
}
__device__ __forceinline__ void phase_prologue(const Ctx& X) {
    KargP ka = kargs(); unsigned char* const ws = ka->ws; (void)ka; (void)ws;
    int tid_ = X.wave * 64 + lane_id(); asm volatile("" : "+v"(tid_)); const int TID = tid_, LANE = tid_ & 63;
    LAS float* s = (LAS float*)X.lds;
    LAS float* red = s + 9 * 1024;
    for (int i = TID; i < 9 * 1024; i += NTHR) { const int r = i >> 10, k = i & 1023; const float v = r < 8 ? ka->in[1][r * 1024 + k] : ka->in[3][k]; s[i] = v / (1.f + __expf(-v)); }
    __syncthreads();
    const int gc0 = blockIdx.x * 48, l = gc0 / 6144, j0 = gc0 % 6144;
    if (blockIdx.x < 256) {
        const int kg = TID / 12, c4 = TID % 12;
        if (kg < 42) {
            f32x4 a[9];
#pragma unroll
            for (int r = 0; r < 9; ++r) a[r] = (f32x4){0.f, 0.f, 0.f, 0.f};
            const float* w = ka->in[4] + (size_t)l * 1024 * 6144 + j0 + 4 * c4;
#pragma unroll 1
            for (int i0 = 0; i0 < 25; i0 += 5) { f32x4 wv[5];
#pragma unroll
                for (int u = 0; u < 5; ++u) { const int k = min(kg + 42 * (i0 + u), 1023); wv[u] = *(const f32x4*)(w + (size_t)k * 6144); }
#pragma unroll
                for (int u = 0; u < 5; ++u) { const int k = kg + 42 * (i0 + u), kc = min(k, 1023); const float mk = k < 1024 ? 1.f : 0.f;
#pragma unroll
                    for (int r = 0; r < 9; ++r) a[r] += (s[r * 1024 + kc] * mk) * wv[u]; } }
#pragma unroll
            for (int r = 0; r < 9; ++r) *(LAS f32x4*)(red + (kg * 9 + r) * 48 + 4 * c4) = a[r];
        }
        __syncthreads();
        if (TID < 432) { const int r = TID / 48, col = TID % 48; float a = 0.f;
#pragma unroll 6
            for (int q = 0; q < 42; ++q) a += red[(q * 9 + r) * 48 + col];
            ((float*)(ws + WS_MOD))[((size_t)l * 9 + r) * 6144 + j0 + col] = a + ka->in[5][l * 6144 + j0 + col]; }
    }
}
__device__ __forceinline__ void phase_wconv(const Ctx& X) {
    KargP ka = kargs(); unsigned char* const ws = ka->ws; (void)ka; (void)ws;
    int tid_ = X.wave * 64 + lane_id(); asm volatile("" : "+v"(tid_)); const int LANE = tid_ & 63;
    LAS float* scr = (LAS float*)(X.lds + X.wave * 16384);
    constexpr int I_IN = 120 * 16, I_OUT = 32 * 16, NIT = 2 * (I_IN + I_OUT);
    auto job_of = [&](int it) { ConvJob J; int r = it; const int ly = r / (I_IN + I_OUT); r -= ly * (I_IN + I_OUT);
        if (r < I_IN) { const int nb = r / 16, kb = r % 16, n = nb * 32 + 4 * (LANE & 7), sc = win_src(n);
            J.sp = ka->in[7] + (size_t)ly * 1024 * N_IN + (sc < 0 ? 0 : sc); J.msk = sc < 0 ? 0.f : 1.f; J.ld = N_IN; J.dst = (bf16*)(ws + WS_WIN) + (size_t)ly * 3840 * 1024; J.K = 1024; J.n0 = nb * 32; J.k0 = kb * 64; }
        else { r -= I_IN; const int nb = r / 16, kb = r % 16;
            J.sp = ka->in[13] + (size_t)ly * 1024 * 1024 + nb * 32 + 4 * (LANE & 7); J.msk = 1.f; J.ld = 1024; J.dst = (bf16*)(ws + WS_WOUT) + (size_t)ly * 1024 * 1024; J.K = 1024; J.n0 = nb * 32; J.k0 = kb * 64; }
        return J; };
    { f32x4 va[8], vb[8]; int it = X.gw; ConvJob Ja = job_of(min(it, NIT - 1)); conv_load(Ja, va, LANE);
      for (; it < NIT; it += 2 * X.ngw) {
          ConvJob Jb = job_of(min(it + X.ngw, NIT - 1)); conv_load(Jb, vb, LANE);
          conv_finish(Ja, va, scr, LANE);
          Ja = job_of(min(it + 2 * X.ngw, NIT - 1)); conv_load(Ja, va, LANE);
          if (it + X.ngw < NIT) conv_finish(Jb, vb, scr, LANE); } }
}
__device__ __forceinline__ void convert_experts(const Ctx& X, int ly, int first, int end, int wid, int stride) {
    KargP ka = kargs(); unsigned char* const ws = ka->ws; (void)ka; (void)ws;
    int tid_ = X.wave * 64 + lane_id(); asm volatile("" : "+v"(tid_)); const int LANE = tid_ & 63;
    LAS float* scr = (LAS float*)(X.lds + X.wave * 16384);
    constexpr int I13 = 16 * 32 * 16, I2 = 16 * 32 * 8, NIT = I13 + I2;
    if (end > NIT) end = NIT;
    bf16* const e13 = (bf16*)(ws + (ly ? WS_EW13_L1 : WS_EW13)); bf16* const e2 = (bf16*)(ws + (ly ? WS_EW2_L1 : WS_EW2));
    auto job_of = [&](int it) { ConvJob J;
        if (it < I13) { const int e = it / 512, r = it % 512, nb = r / 16, kb = r % 16, n = nb * 32 + 4 * (LANE & 7), g = n >> 3, i = n & 7;
            J.sp = (i < 4 ? ka->in[17] : ka->in[18]) + ((size_t)ly * 16 + e) * 1024 * 512 + 4 * g; J.msk = 1.f; J.ld = 512; J.dst = e13 + (size_t)e * 1024 * 1024; J.K = 1024; J.n0 = nb * 32; J.k0 = kb * 64; }
        else { const int r0 = it - I13, e = r0 / 256, r = r0 % 256, nb = r / 8, kb = r % 8;
            J.sp = ka->in[19] + ((size_t)ly * 16 + e) * 512 * 1024 + nb * 32 + 4 * (LANE & 7); J.msk = 1.f; J.ld = 1024; J.dst = e2 + (size_t)e * 1024 * 512; J.K = 512; J.n0 = nb * 32; J.k0 = kb * 64; }
        return J; };
    int it = first + wid; const int lastit = end - 1;
    if (it < end) { f32x4 va[8], vb[8]; ConvJob Ja = job_of(min(it, lastit)); conv_load(Ja, va, LANE);
        for (; it < end; it += 2 * stride) {
            const ConvJob Jb = job_of(min(it + stride, lastit)); conv_load(Jb, vb, LANE);
            conv_finish(Ja, va, scr, LANE);
            Ja = job_of(min(it + 2 * stride, lastit)); conv_load(Ja, va, LANE);
            if (it + stride < end) conv_finish(Jb, vb, scr, LANE); } }
}
constexpr int CONV_TAIL_OUT = 224 * 8 * 6;

template <bool COMBINE, bool ROUTER, bool FINAL, bool ADDY = false, bool SRC16 = false>
__device__ __forceinline__ void rows_phase(const Ctx& X, const float* xl_src, const float* xc_src, float* out_dst, const float* nw, const float* MODn, int sh, int sc,
                                           const float* MODc  , bool latent_only, int lyr, const int dbg = 0) {
    KargP ka = kargs(); unsigned char* const ws = ka->ws; (void)ka; (void)ws;
    int tid_ = X.wave * 64 + lane_id(); asm volatile("" : "+v"(tid_)); const int TID = tid_, LANE = tid_ & 63;
    bf16* ACT = (bf16*)ka->out; const bf16* Y = (const bf16*)(ws + WS_Y); bf16* X16 = (bf16*)(ws + WS_X16);
    const int* TOK_SLOT = (const int*)(ws + WS_ROUTE + RT_TOK_SLOT); const float* TOK_Wc = (const float*)(ws + WS_ROUTE + RT_TOK_W);
    int* TOK_E = (int*)(ws + WS_ROUTE + RT_TOK_E); float* TOK_W = (float*)(ws + WS_ROUTE + RT_TOK_W);
    LAS float* rwL = (LAS float*)X.lds;
    LAS unsigned* hist = (LAS unsigned*)(X.lds + 65536);
    LAS float* rbL = (LAS float*)(X.lds + 65536 + 64);
    if (ROUTER) {
        { f32x4 t[8];
#pragma unroll
          for (int u = 0; u < 8; ++u) t[u] = *(const f32x4*)(ka->in[15] + (size_t)(TID + NTHR * u) * 4);
#pragma unroll
          for (int u = 0; u < 8; ++u) { const int i4 = TID + NTHR * u, cidx = i4 >> 2, q = i4 & 3, ji = (cidx >> 8) * 4 + (cidx & 3), ln = (cidx & 255) >> 2;
              *(LAS f32x4*)(rwL + ((ji * 4 + q) * 64 + ln) * 4) = t[u]; } }
        if (TID < 16) { hist[TID] = 0u; rbL[TID] = ka->in[16][TID]; }
        __syncthreads();
    }
    const int nrow = latent_only ? 16 : 17;
    const bf16* YB = (const bf16*)(ws + WS_Y);
    int key = -1; f32x4 wv[4], shv[4], m5[4];
#define RP_DESC(ii, ROW, B, U) do { const int i_ = min((ii), nrow - 1); if (latent_only) { const int lr = X.gw * 16 + i_; B = lr >> 12; U = CTXL + (lr & 4095); ROW = B * UT + U; } \
        else { ROW = X.gw * 17 + i_; B = ROW / UT; U = ROW - B * UT; } } while (0)
#define RP_XPTR(B, U) (((U) < CTXL ? xc_src : xl_src) + ((U) < CTXL ? ((size_t)(B) * CTXL + (U)) * DM : ((size_t)(B) * SEQ + ((U) - CTXL)) * DM))
    f32x4 vn[4]; u32x2 xn16[4]; u32x2 yan[4], ybn[4]; int sl0 = 0, sl1 = 0; float sw0 = 0.f, sw1 = 0.f;
    int nl0 = 0, nl1 = 0; float nw0 = 0.f, nw1 = 0.f;
    { int row, b, u; RP_DESC(0, row, b, u);
      if (COMBINE) { sl0 = __builtin_amdgcn_readfirstlane(ld_i32(TOK_SLOT + row * 2)); sl1 = __builtin_amdgcn_readfirstlane(ld_i32(TOK_SLOT + row * 2 + 1)); sw0 = ld_f32(TOK_Wc + row * 2); sw1 = ld_f32(TOK_Wc + row * 2 + 1); }
      const float* xs = RP_XPTR(b, u);
#pragma unroll
      for (int j = 0; j < 4; ++j) { if (SRC16) xn16[j] = *(const u32x2*)(X16 + (size_t)row * DM + 4 * LANE + 256 * j); else vn[j] = *(const f32x4*)(xs + 4 * LANE + 256 * j);
          if (ADDY) yan[j] = *(const u32x2*)(YB + (size_t)row * DM + 4 * LANE + 256 * j);
          if (COMBINE) { yan[j] = *(const u32x2*)(Y + (size_t)sl0 * 1024 + 4 * LANE + 256 * j); ybn[j] = *(const u32x2*)(Y + (size_t)sl1 * 1024 + 4 * LANE + 256 * j); } }
      if (COMBINE) { int r1, b1, u1; RP_DESC(1, r1, b1, u1); nl0 = ld_i32(TOK_SLOT + r1 * 2); nl1 = ld_i32(TOK_SLOT + r1 * 2 + 1); nw0 = ld_f32(TOK_Wc + r1 * 2); nw1 = ld_f32(TOK_Wc + r1 * 2 + 1); } }
    int split = nrow;
    { int r0, b0, u0; RP_DESC(0, r0, b0, u0); const int k0 = u0 < CTXL ? 8 : b0;
      for (int i = 1; i < nrow; ++i) { int r1, b1, u1; RP_DESC(i, r1, b1, u1); const int k1 = u1 < CTXL ? 8 : b1; if (k1 != k0 && split == nrow) split = i; } }
#pragma unroll 1
    for (int seg = 0; seg < 2; ++seg) {
    const int ilo = seg ? split : 0, ihi = seg ? nrow : split;
    if (ilo < ihi) {
        int rk, bk, uk; RP_DESC(ilo, rk, bk, uk); const int k2 = uk < CTXL ? 8 : bk; key = k2;
#pragma unroll
        for (int j = 0; j < 4; ++j) { const int col = 4 * LANE + 256 * j;
            if (FINAL) wv[j] = *(const f32x4*)(nw + col);
            else { const f32x4 w = *(const f32x4*)(nw + col), s1 = *(const f32x4*)(MODn + (size_t)k2 * 6144 + sc * 1024 + col); wv[j] = w * (1.f + s1); shv[j] = *(const f32x4*)(MODn + (size_t)k2 * 6144 + sh * 1024 + col); }
            if (COMBINE) m5[j] = *(const f32x4*)(MODc + (size_t)k2 * 6144 + 5 * 1024 + col);
            if (ADDY) m5[j] = *(const f32x4*)(MODn + (size_t)k2 * 6144 + 2 * 1024 + col); }
#pragma unroll
        for (int j = 0; j < 4; ++j) { asm volatile("" : "+v"(wv[j])); if (SRC16) asm volatile("" : "+v"(xn16[j])); else asm volatile("" : "+v"(vn[j])); if (!FINAL) asm volatile("" : "+v"(shv[j])); if (COMBINE || ADDY) asm volatile("" : "+v"(m5[j]), "+v"(yan[j])); if (COMBINE) asm volatile("" : "+v"(ybn[j])); }
    }
#pragma unroll 1
    for (int i = ilo; i < ihi; ++i) {
        int row, b, u; RP_DESC(i, row, b, u);
        const bool ctx = u < CTXL;
        const size_t xoff = ctx ? ((size_t)b * CTXL + u) * DM : ((size_t)b * SEQ + (u - CTXL)) * DM;
        f32x4 v[4]; u32x2 ya_[4], yb_[4]; const float w0 = sw0, w1 = sw1;
#pragma unroll
        for (int j = 0; j < 4; ++j) { ya_[j] = yan[j]; yb_[j] = ybn[j];
            if (SRC16) { const u32x2 a = xn16[j]; v[j][0] = __uint_as_float(a.x << 16); v[j][1] = __uint_as_float(a.x & 0xffff0000u); v[j][2] = __uint_as_float(a.y << 16); v[j][3] = __uint_as_float(a.y & 0xffff0000u); }
            else v[j] = vn[j]; }
        { int r1, b1, u1; RP_DESC(i + 1, r1, b1, u1);
          if (COMBINE) { sl0 = __builtin_amdgcn_readfirstlane(nl0); sl1 = __builtin_amdgcn_readfirstlane(nl1); sw0 = nw0; sw1 = nw1; }
          const float* xs = RP_XPTR(b1, u1);
#pragma unroll
          for (int j = 0; j < 4; ++j) { if (SRC16) xn16[j] = *(const u32x2*)(X16 + (size_t)r1 * DM + 4 * LANE + 256 * j); else vn[j] = *(const f32x4*)(xs + 4 * LANE + 256 * j);
              if (ADDY) yan[j] = *(const u32x2*)(YB + (size_t)r1 * DM + 4 * LANE + 256 * j);
              if (COMBINE) { yan[j] = *(const u32x2*)(Y + (size_t)sl0 * 1024 + 4 * LANE + 256 * j); ybn[j] = *(const u32x2*)(Y + (size_t)sl1 * 1024 + 4 * LANE + 256 * j); } }
          if (COMBINE) { int r2, b2, u2; RP_DESC(i + 2, r2, b2, u2); nl0 = ld_i32(TOK_SLOT + r2 * 2); nl1 = ld_i32(TOK_SLOT + r2 * 2 + 1); nw0 = ld_f32(TOK_Wc + r2 * 2); nw1 = ld_f32(TOK_Wc + r2 * 2 + 1); } }
        if (ADDY) {
#pragma unroll
            for (int j = 0; j < 4; ++j) { const u32x2 a = ya_[j];
                f32x4 ya; ya[0] = __uint_as_float(a.x << 16); ya[1] = __uint_as_float(a.x & 0xffff0000u); ya[2] = __uint_as_float(a.y << 16); ya[3] = __uint_as_float(a.y & 0xffff0000u);
                v[j] = v[j] + m5[j] * ya; }
            if (!(dbg & 2048)) {
#pragma unroll
            for (int j = 0; j < 4; ++j) { u32x2 o; o.x = cvt_pk_bf16(v[j][0], v[j][1]); o.y = cvt_pk_bf16(v[j][2], v[j][3]); *(u32x2*)(X16 + (size_t)row * DM + 4 * LANE + 256 * j) = o; } }
        }
        if (COMBINE) {
#pragma unroll
            for (int j = 0; j < 4; ++j) { const u32x2 a = ya_[j], bq = yb_[j];
                f32x4 ya, yb; ya[0] = __uint_as_float(a.x << 16); ya[1] = __uint_as_float(a.x & 0xffff0000u); ya[2] = __uint_as_float(a.y << 16); ya[3] = __uint_as_float(a.y & 0xffff0000u);
                yb[0] = __uint_as_float(bq.x << 16); yb[1] = __uint_as_float(bq.x & 0xffff0000u); yb[2] = __uint_as_float(bq.y << 16); yb[3] = __uint_as_float(bq.y & 0xffff0000u);
                v[j] = v[j] + m5[j] * (w0 * ya + w1 * yb); }
            if (!FINAL && !(dbg & 2048)) {
#pragma unroll
                for (int j = 0; j < 4; ++j) { u32x2 o; o.x = cvt_pk_bf16(v[j][0], v[j][1]); o.y = cvt_pk_bf16(v[j][2], v[j][3]); *(u32x2*)(X16 + (size_t)row * DM + 4 * LANE + 256 * j) = o; } }
        }
        float ss = 0.f;
#pragma unroll
        for (int j = 0; j < 4; ++j) ss += (v[j][0] * v[j][0] + v[j][1] * v[j][1]) + (v[j][2] * v[j][2] + v[j][3] * v[j][3]);
        const float rstd = rsqrtf(wave_sum(ss) * (1.f / DM) + EPS);
        if (FINAL) { float* xd = out_dst + xoff;
#pragma unroll
            for (int j = 0; j < 4; ++j) *(f32x4*)(xd + 4 * LANE + 256 * j) = v[j] * rstd * wv[j];
            continue; }
        f32x4 h[4];
#pragma unroll
        for (int j = 0; j < 4; ++j) { h[j] = v[j] * rstd * wv[j] + shv[j]; u32x2 o; o.x = cvt_pk_bf16(h[j][0], h[j][1]); o.y = cvt_pk_bf16(h[j][2], h[j][3]); *(u32x2*)(ACT + (size_t)row * DM + 4 * LANE + 256 * j) = o; }
        if (ROUTER && !(dbg & 512)) {
            float p[16];
            { f32x2 pa[8];
#pragma unroll
              for (int e = 0; e < 8; ++e) pa[e] = (f32x2){0.f, 0.f};
#pragma unroll
              for (int j = 0; j < 4; ++j)
#pragma unroll
                for (int ii = 0; ii < 4; ++ii) { const f32x2 hh = (f32x2){h[j][ii], h[j][ii]};
#pragma unroll
                    for (int q = 0; q < 4; ++q) { const f32x4 w = *(const LAS f32x4*)(rwL + (((j * 4 + ii) * 4 + q) * 64 + LANE) * 4);
                        pa[2 * q] = __builtin_elementwise_fma(hh, (f32x2){w[0], w[1]}, pa[2 * q]); pa[2 * q + 1] = __builtin_elementwise_fma(hh, (f32x2){w[2], w[3]}, pa[2 * q + 1]); } }
#pragma unroll
              for (int e = 0; e < 8; ++e) { p[2 * e] = pa[e][0]; p[2 * e + 1] = pa[e][1]; } }
            float q8[8], q4[4], q2[2], q1;
#pragma unroll
            for (int t = 0; t < 8; ++t) { const auto r = __builtin_amdgcn_permlane32_swap(__float_as_uint(p[t]), __float_as_uint(p[t + 8]), false, false); q8[t] = __uint_as_float(r[0]) + __uint_as_float(r[1]); }
#pragma unroll
            for (int t = 0; t < 4; ++t) { const auto r = __builtin_amdgcn_permlane16_swap(__float_as_uint(q8[t]), __float_as_uint(q8[t + 4]), false, false); q4[t] = __uint_as_float(r[0]) + __uint_as_float(r[1]); }
            { const bool hi = (LANE & 8) != 0;
#pragma unroll
              for (int t = 0; t < 2; ++t) { const float a = dpp_f<0x128>(q4[t]), c = dpp_f<0x128>(q4[t + 2]); q2[t] = hi ? q4[t + 2] + c : q4[t] + a; } }
            { const bool hi = (LANE & 4) != 0; const float a0 = dpp_f<0x104>(q2[0]), a1 = dpp_f<0x114>(q2[1]); q1 = hi ? q2[1] + a1 : q2[0] + a0; }
            q1 += dpp_f<0xB1>(q1); q1 += dpp_f<0x4E>(q1);
            float mx = q1;
            mx = fmaxf(mx, dpp_f<0x124>(mx)); mx = fmaxf(mx, dpp_f<0x128>(mx)); mx = red_hi_max(mx);
            const float pe = __expf(q1 - mx); float sum = pe;
            sum += dpp_f<0x124>(sum); sum += dpp_f<0x128>(sum); sum = red_hi_add(sum);
            const float prob = pe * (1.f / sum), sv = prob + rbL[LANE >> 2];
            const bool b2_ = (LANE & 4) != 0; const float s2 = dpp_f<0x128>(sv);
            float s1m = dpp_f<0x114>(sv), s1p = dpp_f<0x104>(sv), s3m = dpp_f<0x114>(s2), s3p = dpp_f<0x104>(s2); asm volatile("" : "+v"(s1m), "+v"(s1p), "+v"(s3m), "+v"(s3p));
            const float s1 = b2_ ? s1m : s1p, s3 = b2_ ? s3m : s3p;
            const int kk = (LANE >> 2) & 3;
            const int rank = ((s1 > sv) || (s1 == sv && (kk ^ 1) < kk) ? 1 : 0) + ((s2 > sv) || (s2 == sv && (kk ^ 2) < kk) ? 1 : 0) + ((s3 > sv) || (s3 == sv && (kk ^ 3) < kk) ? 1 : 0);
            const float hi01 = fmaxf(sv, s1), lo01 = fminf(sv, s1), hi23 = fmaxf(s2, s3), lo23 = fminf(s2, s3);
            const float gs = fmaxf(hi01, hi23) + fmaxf(fminf(hi01, hi23), fmaxf(lo01, lo23));
            const float gmax = red_hi_max(gs);
            const int best = (__ffsll((unsigned long long)__ballot(gs == gmax)) - 1) >> 4;
            const bool inb = (LANE >> 4) == best;
            const int l0 = __ffsll((unsigned long long)__ballot(inb && rank == 0)) - 1, l1 = __ffsll((unsigned long long)__ballot(inb && rank == 1)) - 1;
            const float p0 = __uint_as_float(__builtin_amdgcn_readlane(__float_as_uint(prob), l0)), p1 = __uint_as_float(__builtin_amdgcn_readlane(__float_as_uint(prob), l1));
            const int i0 = (l0 >> 2) & 3, i1 = (l1 >> 2) & 3;
            if (LANE == 0) { const int e0 = 4 * best + i0, e1 = 4 * best + i1; const float wsum = p0 + p1;
                TOK_E[row * 2] = e0; TOK_E[row * 2 + 1] = e1; TOK_W[row * 2] = p0 / wsum; TOK_W[row * 2 + 1] = p1 / wsum;
                __hip_atomic_fetch_add(hist + e0, 1u, __ATOMIC_RELAXED, __HIP_MEMORY_SCOPE_WORKGROUP); __hip_atomic_fetch_add(hist + e1, 1u, __ATOMIC_RELAXED, __HIP_MEMORY_SCOPE_WORKGROUP); }
        }
    }
    }
    if (ROUTER) {
        __syncthreads();
        if (TID < 16 && !(dbg & 128)) __hip_atomic_fetch_add(((unsigned*)ws) + CW_CNT + 32 * lyr + TID, hist[TID], __ATOMIC_RELAXED, __HIP_MEMORY_SCOPE_AGENT);
    }
}

__device__ __forceinline__ void phase_slots(const Ctx& X, int lyr, bool latent_only) {
    KargP ka = kargs(); unsigned char* const ws = ka->ws; (void)ka; (void)ws;
    int tid_ = X.wave * 64 + lane_id(); asm volatile("" : "+v"(tid_)); const int TID = tid_, LANE = tid_ & 63;
    LAS unsigned* off = (LAS unsigned*)X.lds;
    LAS unsigned* lcnt = off + 32;
    LAS unsigned* lbase = off + 64;
    const int* TOK_E = (const int*)(ws + WS_ROUTE + RT_TOK_E); const float* TOK_W = (const float*)(ws + WS_ROUTE + RT_TOK_W);
    int* TOK_SLOT = (int*)(ws + WS_ROUTE + RT_TOK_SLOT); int* SLOT_TOK = (int*)(ws + WS_ROUTE + RT_SLOT_TOK); float* SLOT_W = (float*)(ws + WS_ROUTE + RT_SLOT_W); int* TILE_E = (int*)(ws + WS_ROUTE + RT_TILE_E) + 512 * lyr;
    const bf16* ACT = (const bf16*)ka->out; bf16* AG = (bf16*)(ws + WS_AG);
    unsigned* CNT = ((unsigned*)ws) + CW_CNT + 32 * lyr; unsigned* CUR = ((unsigned*)ws) + CW_CUR + 32 * lyr;
    if (TID == 0) { unsigned o = 0; for (int e = 0; e < 16; ++e) { off[e] = o; o += (ld_u32(CNT + e) + 255u) & ~255u; } off[16] = o; }
    if (TID < 16) lcnt[TID] = 0u;
    __syncthreads();
    if (blockIdx.x == 0) {
        if (TID == 0) { for (int e = 0; e <= 16; ++e) ((unsigned*)ws)[CW_OFF + 32 * lyr + e] = off[e]; ((unsigned*)ws)[CW_NT + 32 * lyr] = off[16] >> 8; }
        for (int e = 0; e < 16; ++e) { const unsigned cnt = ld_u32(CNT + e);
            for (unsigned i = off[e] + cnt + TID; i < off[e + 1]; i += NTHR) { SLOT_TOK[i] = 0; SLOT_W[i] = 0.f; }
            for (unsigned t = (off[e] >> 8) + TID; t < (off[e + 1] >> 8); t += NTHR) TILE_E[t] = e; }
    }
    const int nrow = latent_only ? 16 : 17;
    int row = -1, e0 = 0, e1 = 0; unsigned lp0 = 0, lp1 = 0;
    if (LANE < nrow) {
        if (latent_only) { const int lr = X.gw * 16 + LANE; row = (lr >> 12) * UT + CTXL + (lr & 4095); } else row = X.gw * 17 + LANE;
        e0 = TOK_E[row * 2]; e1 = TOK_E[row * 2 + 1];
        lp0 = __hip_atomic_fetch_add(lcnt + e0, 1u, __ATOMIC_RELAXED, __HIP_MEMORY_SCOPE_WORKGROUP); lp1 = __hip_atomic_fetch_add(lcnt + e1, 1u, __ATOMIC_RELAXED, __HIP_MEMORY_SCOPE_WORKGROUP);
    }
    __syncthreads();
    if (TID < 16) lbase[TID] = off[TID] + __hip_atomic_fetch_add(CUR + TID, lcnt[TID], __ATOMIC_RELAXED, __HIP_MEMORY_SCOPE_AGENT);
    __syncthreads();
    int s0 = 0, s1 = 0;
    if (LANE < nrow) { s0 = (int)(lbase[e0] + lp0); s1 = (int)(lbase[e1] + lp1); TOK_SLOT[row * 2] = s0; TOK_SLOT[row * 2 + 1] = s1;
        SLOT_TOK[s0] = row; SLOT_TOK[s1] = row; SLOT_W[s0] = TOK_W[row * 2]; SLOT_W[s1] = TOK_W[row * 2 + 1]; }
}

__device__ __forceinline__ void unpack8(const u32x4 v, float (&f)[8]) {
    f[0] = __uint_as_float(v.x << 16); f[1] = __uint_as_float(v.x & 0xffff0000u); f[2] = __uint_as_float(v.y << 16); f[3] = __uint_as_float(v.y & 0xffff0000u);
    f[4] = __uint_as_float(v.z << 16); f[5] = __uint_as_float(v.z & 0xffff0000u); f[6] = __uint_as_float(v.w << 16); f[7] = __uint_as_float(v.w & 0xffff0000u);
}
__device__ __forceinline__ void phase_prep(const Ctx& X, int l) {
    KargP ka = kargs(); unsigned char* const ws = ka->ws; (void)ka; (void)ws;
    int tid_ = X.wave * 64 + lane_id(); asm volatile("" : "+v"(tid_)); const int TID = tid_, LANE = tid_ & 63;
    LAS float* tcos = (LAS float*)X.lds; LAS float* tsin = tcos + 2048;
    for (int i = TID; i < 2048; i += NTHR) { const int pos = i >> 5, ii = i & 31; const float inv = exp2f(-(float)(2 * ii) * (13.287712379549449f / 64.f)); const float ang = (float)pos * inv; tcos[i] = cosf(ang); tsin[i] = sinf(ang); }
    __syncthreads();
    const bf16* QKRAW = (const bf16*)(ws + WS_QKRAW); bf16* QP = (bf16*)(ws + WS_QP); bf16* KP = (bf16*)(ws + WS_KP); bf16* KPT = (bf16*)(ws + WS_KPT);
    const float* cw = ka->in[8] + l * 3072; const float* cb = ka->in[9] + l * 1024;
    const int t8 = LANE & 7, cg = LANE >> 3, i0 = 8 * (cg & 3); const bool low = cg < 4;
#pragma unroll 1
    for (int it = X.gw; it < 2 * 8 * (MROWS / 64); it += X.ngw) {
        const int hf = it & 1, cbk = (it >> 1) & 7, tb = it >> 4, b = tb / (UT / 64), ub = (tb - b * (UT / 64)) * 64, u0 = ub + 8 * t8;
        const int col0 = hf * 512 + cbk * 64 + 8 * cg, blk = cbk & 1, hd = cbk >> 1;
        const int seglo = ub < CTXL ? 0 : CTXL, seghi = ub < CTXL ? CTXL : UT;
        const size_t rowb = (size_t)b * UT + u0;
        float w0[8], w1[8], w2[8], bb[8];
#pragma unroll
        for (int j = 0; j < 8; ++j) { w0[j] = cw[col0 + j]; w1[j] = cw[1024 + col0 + j]; w2[j] = cw[2048 + col0 + j]; bb[j] = cb[col0 + j]; }
        u32x4 raw[10];
#pragma unroll
        for (int i = 0; i < 10; ++i) { const int u = u0 - 1 + i; const bool ok = (u >= seglo) && (u < seghi); const size_t rr = ok ? rowb - 1 + i : rowb;
            const u32x4 v = *(const u32x4*)(QKRAW + rr * 1024 + col0); raw[i] = ok ? v : (u32x4){0u, 0u, 0u, 0u}; }
        float xp[8], xc[8], xr[8];
        unpack8(raw[0], xp); unpack8(raw[1], xc);
        u32x4 o[8];
#pragma unroll
        for (int i = 0; i < 8; ++i) {
            unpack8(raw[i + 2], xr);
            float s[8];
#pragma unroll
            for (int j = 0; j < 8; ++j) { const float y = bb[j] + w0[j] * xp[j] + w1[j] * xc[j] + w2[j] * xr[j]; s[j] = y * __builtin_amdgcn_rcpf(1.f + __expf(-y)); }
            if (ub >= CTXL) {
                const int t = u0 + i - CTXL, pos = blk ? (t & 63) : (t >> 6);
                const f32x4 c0 = *(const LAS f32x4*)(tcos + pos * 32 + i0), c1 = *(const LAS f32x4*)(tcos + pos * 32 + i0 + 4), s0 = *(const LAS f32x4*)(tsin + pos * 32 + i0), s1 = *(const LAS f32x4*)(tsin + pos * 32 + i0 + 4);
#pragma unroll
                for (int j = 0; j < 8; ++j) { const auto r_ = __builtin_amdgcn_permlane32_swap(__float_as_uint(s[j]), __float_as_uint(s[j]), false, false); const float pv = __uint_as_float(low ? r_[1] : r_[0]);     const float cs = j < 4 ? c0[j & 3] : c1[j & 3], sn = j < 4 ? s0[j & 3] : s1[j & 3]; s[j] = s[j] * cs + (low ? -pv : pv) * sn; }
            }
            if (hf == 1) {
#pragma unroll
                for (int j = 0; j < 8; ++j) s[j] *= 0.08838834764831845f; }
            o[i].x = cvt_pk_bf16(s[0], s[1]); o[i].y = cvt_pk_bf16(s[2], s[3]); o[i].z = cvt_pk_bf16(s[4], s[5]); o[i].w = cvt_pk_bf16(s[6], s[7]);
            if (hf == 0) *(u32x4*)(QP + (rowb + i) * 512 + cbk * 64 + 8 * cg) = o[i]; else *(u32x4*)(KP + (rowb + i) * 512 + cbk * 64 + 8 * cg) = o[i];
#pragma unroll
            for (int j = 0; j < 8; ++j) { xp[j] = xc[j]; xc[j] = xr[j]; }
        }
        if (hf == 1) {
            bf16* kt = KPT + ((size_t)(b * 4 + hd) * 128 + blk * 64 + 8 * cg) * UTP + u0;
#pragma unroll
            for (int j = 0; j < 8; ++j) { u32x4 tv;
#pragma unroll
                for (int q = 0; q < 4; ++q) { const unsigned a = j < 2 ? o[2 * q].x : j < 4 ? o[2 * q].y : j < 6 ? o[2 * q].z : o[2 * q].w, c = j < 2 ? o[2 * q + 1].x : j < 4 ? o[2 * q + 1].y : j < 6 ? o[2 * q + 1].z : o[2 * q + 1].w;
                    const unsigned w = (j & 1) ? ((a >> 16) | (c & 0xffff0000u)) : ((a & 0xffffu) | (c << 16)); if (q == 0) tv.x = w; else if (q == 1) tv.y = w; else if (q == 2) tv.z = w; else tv.w = w; }
                *(u32x4*)(kt + (size_t)j * UTP) = tv; }
        }
    }
}

__device__ __forceinline__ f32x4 mfma16(bf16x8 a, bf16x8 b, f32x4 c) { return __builtin_amdgcn_mfma_f32_16x16x32_bf16(a, b, c, 0, 0, 0); }
__device__ __forceinline__ float logsig_fast(float x) { return fminf(x, 0.f) - __logf(1.f + __expf(-fabsf(x))); }
__device__ __forceinline__ int chunk_of(int dir, int k) { return dir == 0 ? k : (k < 2 ? 1 - k : 35 - k); }
__device__ __forceinline__ void phase_scan(const Ctx& X, const int dbg) {
    KargP ka = kargs(); unsigned char* const ws = ka->ws; (void)ka; (void)ws;
    int tid_ = X.wave * 64 + lane_id(); asm volatile("" : "+v"(tid_)); const int TID = tid_, LANE = tid_ & 63;
    const int bid = blockIdx.x, chain = (bid & 7) + 8 * (bid >> 5), q4 = (bid >> 3) & 3, b = chain >> 3, h = (chain >> 1) & 3, dir = chain & 1;
    LAS float* gl = (LAS float*)X.lds;
    LAS float* bend = gl + NCHUNK * 128; LAS float* gmx = bend + 64; LAS float* wold = gmx + 64; LAS float* mst = wold + 64; LAS float* mnx = mst + 64;
    const float* GATES = (const float*)(ws + WS_GATES);
    for (int k = X.wave; k < NCHUNK; k += NWAVES) {
        const int c = chunk_of(dir, k), p0 = 2 * LANE, t0 = dir ? 127 - p0 : p0, t1 = dir ? 126 - p0 : p0 + 1;
        const size_t row0 = (size_t)b * UT + 128 * c;
        const float f0 = GATES[(row0 + t0) * 16 + (2 * dir + 1) * 4 + h], f1 = GATES[(row0 + t1) * 16 + (2 * dir + 1) * 4 + h];
        const float i0 = GATES[(row0 + t0) * 16 + (2 * dir) * 4 + h], i1 = GATES[(row0 + t1) * 16 + (2 * dir) * 4 + h];
        const float l0 = logsig_fast(f0), l1 = logsig_fast(f1);
        float v = l0 + l1;
#pragma unroll
        for (int o = 1; o < 64; o <<= 1) { const float t = __shfl_up(v, o); if (LANE >= o) v += t; }
        const float be = __shfl(v, 63), b1 = v, b0 = v - l1;
        const float g0 = be - b0 + i0, g1 = be - b1 + i1;
        float gm = fmaxf(g0, g1);
#pragma unroll
        for (int o = 1; o < 64; o <<= 1) gm = fmaxf(gm, __shfl_xor(gm, o));
        gl[k * 128 + t0] = g0; gl[k * 128 + t1] = g1;
        if (LANE == 0) { bend[k] = be; gmx[k] = gm; }
        if (q4 == 0) {
            const float a0 = i0 - b0, a1 = i1 - b1; float mx = fmaxf(a0, a1);
#pragma unroll
            for (int o = 1; o < 64; o <<= 1) { const float t = __shfl_up(mx, o); if (LANE >= o) mx = fmaxf(mx, t); }
            float mprev = __shfl_up(mx, 1); if (LANE == 0) mprev = -1e30f;
            float* gaw = (float*)(ws + WS_GA) + (size_t)(chain * NCHUNK + k) * 384;
            gaw[t0] = a0; gaw[t1] = a1; gaw[128 + t0] = fmaxf(mprev, a0); gaw[128 + t1] = mx; gaw[256 + t0] = b0; gaw[256 + t1] = b1;
        }
    }
    __syncthreads();
    if (TID == 0) { float m = 0.f; for (int k = 0; k < NCHUNK; ++k) { mst[k] = m; const float mn = fmaxf(bend[k] + m, gmx[k]); wold[k] = __expf(bend[k] + m - mn); mnx[k] = mn; m = mn; } }
    __syncthreads();
    for (int i = TID; i < NCHUNK * 128; i += NTHR) gl[i] = __expf(gl[i] - mnx[i >> 7]);
    if (q4 == 0 && TID < NCHUNK) ((float*)(ws + WS_MST))[chain * NCHUNK + TID] = mst[TID];
    __syncthreads();
    const bf16* KPT = (const bf16*)(ws + WS_KPT); const bf16* MVT = (const bf16*)(ws + WS_MVT); bf16* CST = (bf16*)(ws + WS_CST); float* NST = (float*)(ws + WS_NST);
    const int n = LANE & 15, g = LANE >> 4;
    constexpr int SLOT0 = 20480, SLOTB = 40960;
    const int sr = LANE >> 4, sp = LANE & 15;
    const bf16* ksrc[4];
#pragma unroll
    for (int i = 0; i < 4; ++i) { const int r = 16 * X.wave + 4 * i + sr; ksrc[i] = KPT + ((size_t)(b * 4 + h) * 128 + r) * UTP + 8 * (sp ^ (((r & 3) << 2) | ((r >> 2) & 3))); }
    const bf16* vsrc; { const int r = 4 * X.wave + sr; vsrc = MVT + ((size_t)(b * 4 + h) * 128 + 32 * q4 + r) * UTP + 8 * (sp ^ (((r & 3) << 2) | ((r >> 2) & 3))); }
    unsigned rb[4];
#pragma unroll
    for (int ks = 0; ks < 4; ++ks) rb[ks] = 256u * n + 64u * (unsigned)(ks ^ (n & 3)) + 16u * (unsigned)(g ^ ((n >> 2) & 3));
    f32x4 C0 = {0.f, 0.f, 0.f, 0.f}, C1 = {0.f, 0.f, 0.f, 0.f}, Cn = {0.f, 0.f, 0.f, 0.f};
    bf16x8 ones;
#pragma unroll
    for (int j = 0; j < 8; ++j) ones[j] = (short)0x3F80;
    bf16* const cst_dummy = (bf16*)(ws + WS_DUMMY);
#define SC_DMA(kk) do { const int u_ = 128 * chunk_of(dir, min((kk), NCHUNK - 1)); LAS unsigned char* sl_ = X.lds + SLOT0 + ((kk) % 3) * SLOTB; \
        _Pragma("unroll") for (int i = 0; i < 4; ++i) __builtin_amdgcn_global_load_lds((const unsigned*)(ksrc[i] + u_), (LAS unsigned*)(sl_ + (16 * X.wave + 4 * i) * 256), 16, 0, 0); \
        __builtin_amdgcn_global_load_lds((const unsigned*)(vsrc + u_), (LAS unsigned*)(sl_ + 32768 + 4 * X.wave * 256), 16, 0, 0); } while (0)
#define SC_ST(buf, half) (X.lds + ((buf) ? ((half) ? LDSCTL_OFF + 1024 + 8192 : SLOT0 + 3 * SLOTB) : LDSCTL_OFF + 1024 + 4096 * (half)))
#define SC_STEP(kk, WAITSTR) do { const int k = min((kk), NCHUNK - 1); const bool real = (kk) < NCHUNK; \
        asm volatile(WAITSTR ::: "memory"); __builtin_amdgcn_s_barrier(); asm volatile("" ::: "memory"); \
        SC_DMA((kk) + 2); asm volatile("" ::: "memory"); \
        { const int kp = (kk) - 1, kpc = min(max(kp, 0), NCHUNK - 1); const bool preal = kp >= 0 && kp < NCHUNK; \
          const u32x4 tv = *(const LAS u32x4*)(SC_ST(kp & 1, TID >> 8) + ((TID >> 4) & 15) * 256 + (TID & 15) * 16); \
          bf16* cd = (preal ? CST + (size_t)(chain * NCHUNK + kpc) * 16384 : cst_dummy + (size_t)blockIdx.x * 16384) + (size_t)(32 * q4 + (TID >> 4)) * 128 + (TID & 15) * 8; \
          *(u32x4*)cd = tv; \
          float* ns = real ? NST + (size_t)(chain * NCHUNK + k) * 128 : (float*)(cst_dummy + (size_t)256 * 16384) + (size_t)blockIdx.x * 128; ns[16 * X.wave + n] = Cn[0]; } \
        { LAS unsigned char* s0 = SC_ST((kk) & 1, 0) + (4 * g) * 256 + (16 * X.wave + n) * 2; LAS unsigned char* s1 = SC_ST((kk) & 1, 1) + (4 * g) * 256 + (16 * X.wave + n) * 2; \
          _Pragma("unroll") for (int r = 0; r < 4; ++r) { *(LAS bf16*)(s0 + r * 256) = f2bf(C0[r]); *(LAS bf16*)(s1 + r * 256) = f2bf(C1[r]); } } \
        const float wo = wold[k]; C0 = C0 * wo; C1 = C1 * wo; Cn = Cn * wo; \
        const LAS unsigned char* sl = X.lds + SLOT0 + ((kk) % 3) * SLOTB; \
        _Pragma("unroll") for (int ks = 0; ks < 4; ++ks) { \
            const f32x4 wa = *(const LAS f32x4*)(gl + k * 128 + 32 * ks + 8 * g), wb = *(const LAS f32x4*)(gl + k * 128 + 32 * ks + 8 * g + 4); \
            float kf[8]; unpack8(*(const LAS u32x4*)(sl + 4096 * X.wave + rb[ks]), kf); \
            u32x4 kw; kw.x = cvt_pk_bf16(kf[0] * wa[0], kf[1] * wa[1]); kw.y = cvt_pk_bf16(kf[2] * wa[2], kf[3] * wa[3]); kw.z = cvt_pk_bf16(kf[4] * wb[0], kf[5] * wb[1]); kw.w = cvt_pk_bf16(kf[6] * wb[2], kf[7] * wb[3]); \
            const bf16x8 bfr = __builtin_bit_cast(bf16x8, kw); \
            C0 = mfma16(*(const LAS bf16x8*)(sl + 32768 + rb[ks]), bfr, C0); C1 = mfma16(*(const LAS bf16x8*)(sl + 32768 + 4096 + rb[ks]), bfr, C1); Cn = mfma16(ones, bfr, Cn); } \
        asm volatile("s_waitcnt lgkmcnt(0)" ::: "memory"); } while (0)
    const int kend = (dbg & 64) ? 0 : 36;
    __syncthreads();
    SC_DMA(0); SC_DMA(1);
    if (kend) { SC_STEP(0, "s_waitcnt vmcnt(0)"); SC_STEP(1, "s_waitcnt vmcnt(7)"); SC_STEP(2, "s_waitcnt vmcnt(9)"); }
#pragma unroll 1
    for (int kb = 3; kb < kend; kb += 3) { SC_STEP(kb, "s_waitcnt vmcnt(9)"); SC_STEP(kb + 1, "s_waitcnt vmcnt(9)"); SC_STEP(kb + 2, "s_waitcnt vmcnt(9)"); }
    asm volatile("s_waitcnt vmcnt(0)" ::: "memory"); __syncthreads();
#undef SC_DMA
#undef SC_STEP
#undef SC_ST
}

__device__ __forceinline__ unsigned swz_b(unsigned row, unsigned ch) { return 256u * row + 16u * (ch ^ (((row & 3u) << 2) | ((row >> 2) & 3u))); }
__device__ __forceinline__ void stage_tile128(LAS unsigned char* dst, const char* src, size_t gpitch, int TID) {
#pragma unroll
    for (int i = 0; i < 4; ++i) { const int nn = TID + NTHR * i, row = nn >> 4, ch = nn & 15; const u32x4 v = *(const u32x4*)(src + (size_t)row * gpitch + ch * 16); *(LAS u32x4*)(dst + swz_b(row, ch)) = v; }
}
__device__ __forceinline__ void dma_tile128(LAS unsigned char* dst, const char* src, size_t gpitch, int wave, int LANE) {
    const int sr = LANE >> 4, sp = LANE & 15;
#pragma unroll
    for (int i = 0; i < 4; ++i) { const int rg = i * 8 + wave, r = 4 * rg + sr;
        __builtin_amdgcn_global_load_lds((const unsigned*)(src + (size_t)r * gpitch + 16 * (sp ^ (((r & 3) << 2) | ((r >> 2) & 3)))), (LAS unsigned*)(dst + rg * 1024), 16, 0, 0); }
}
struct MUnit { int b, h, c; };
__device__ __forceinline__ bool munit_of(int v, int l, MUnit& u) {
    const int nun = (l == 0) ? 32 * NCHUNK : 32 * 32; if (v >= nun) return false;
    int bh; if (l == 0) { bh = v / NCHUNK; u.c = v - bh * NCHUNK; } else { bh = v >> 5; u.c = 2 + (v & 31); }
    u.b = bh >> 2; u.h = bh & 3; return true;
}
__device__ __forceinline__ void mlstm_run(const Ctx& X, int l, int TID_, int LANE_) {
    KargP ka = kargs(); unsigned char* const ws = ka->ws;
    const bf16* QP = (const bf16*)(ws + WS_QP); const bf16* KP = (const bf16*)(ws + WS_KP); const bf16* MVT = (const bf16*)(ws + WS_MVT); const bf16* CST = (const bf16*)(ws + WS_CST);
    const float* NST = (const float*)(ws + WS_NST); const float* MST = (const float*)(ws + WS_MST); const float* GA = (const float*)(ws + WS_GA);
    const bf16* PA = (const bf16*)(ws + WS_PA); bf16* ACT = (bf16*)ka->out;
    LAS unsigned char* TK = X.lds; LAS unsigned char* TV = X.lds + 32768; LAS unsigned char* TCF = X.lds + 65536; LAS unsigned char* TCB = X.lds + 98304;
    LAS unsigned char* SIDE = X.lds + LDSCTL_OFF + 1024;
    MUnit cu, nu; int ui = 0;
    if (!munit_of(blockIdx.x, l, cu)) return;
#define MU_DMA_A(U, sbuf) do { const size_t row0_ = (size_t)(U).b * UT + 128 * (U).c; const int chF_ = ((U).b * 4 + (U).h) * 2, jf_ = (U).c, jb_ = (U).c < 2 ? 1 - (U).c : 35 - (U).c; \
        dma_tile128(TK, (const char*)(KP + row0_ * 512 + (U).h * 128), 1024, X.wave, LANE); \
        dma_tile128(TV, (const char*)(MVT + (size_t)((U).b * 4 + (U).h) * 128 * UTP + 128 * (U).c), (size_t)UTP * 2, X.wave, LANE); \
        if (X.wave < 3) { int l32 = LANE & 31, hi_ = LANE >> 5; asm volatile("" : "+v"(l32), "+v"(hi_));     \
            const int ch_ = chF_ + hi_, jj_ = hi_ ? jb_ : jf_; \
            const float* s_ = X.wave == 0 ? GA + (size_t)(ch_ * NCHUNK + jj_) * 384 + 4 * l32 : X.wave == 1 ? NST + (size_t)(ch_ * NCHUNK + jj_) * 128 + 4 * l32 : ka->in[11] + l * 512 + (U).h * 128 + 4 * l32; \
            __builtin_amdgcn_global_load_lds((const unsigned*)s_, (LAS unsigned*)(SIDE + (sbuf) * 4096 + X.wave * 1024), 16, 0, 0); } } while (0)
#define MU_LOAD_P1(U, QF, SC) do { const size_t rowt_ = (size_t)(U).b * UT + 128 * (U).c + t; const int chF_ = ((U).b * 4 + (U).h) * 2, jf_ = (U).c, jb_ = (U).c < 2 ? 1 - (U).c : 35 - (U).c; \
        _Pragma("unroll") for (int ks = 0; ks < 4; ++ks) QF[ks] = *(const u32x4*)(QP + rowt_ * 512 + (U).h * 128 + 32 * ks + 8 * g); \
        const float* gf_ = GA + (size_t)(chF_ * NCHUNK + jf_) * 384; const float* gb_ = GA + (size_t)((chF_ + 1) * NCHUNK + jb_) * 384; \
        SC[0] = gf_[128 + t]; SC[1] = gf_[256 + t]; SC[2] = gb_[128 + t]; SC[3] = gb_[256 + t]; SC[4] = MST[chF_ * NCHUNK + jf_]; SC[5] = MST[(chF_ + 1) * NCHUNK + jb_]; } while (0)
    int TID = TID_, LANE = LANE_; asm volatile("" : "+v"(TID), "+v"(LANE));
    int n = LANE & 15, g = LANE >> 4, t = 16 * (TID >> 6) + n; const int dblk = X.wave >> 1;
    u32x4 qf[4], qn_[4]; float sc[6], scn[6];
    MU_DMA_A(cu, 0); MU_LOAD_P1(cu, qf, sc);
    asm volatile("s_waitcnt vmcnt(0)" ::: "memory"); __syncthreads();
#pragma unroll 1
    for (;;) {
        const int sb = ui & 1;
        LAS float* side = (LAS float*)(SIDE + sb * 4096);
        LAS float* aF = side; LAS float* aB = side + 128; LAS float* nF = side + 256; LAS float* nB = side + 384; LAS float* mnw = side + 512;
        asm volatile("" : "+v"(n), "+v"(g), "+v"(t));
        const size_t rowt = (size_t)cu.b * UT + 128 * cu.c + t;
        const int chF = (cu.b * 4 + cu.h) * 2, jf = cu.c, jb = cu.c < 2 ? 1 - cu.c : 35 - cu.c;
        dma_tile128(TCF, (const char*)(CST + (size_t)(chF * NCHUNK + jf) * 16384), 256, X.wave, LANE);
        dma_tile128(TCB, (const char*)(CST + (size_t)((chF + 1) * NCHUNK + jb) * 16384), 256, X.wave, LANE);
        u32x2 mo[8];
#pragma unroll
        for (int mt = 0; mt < 8; ++mt) mo[mt] = *(const u32x2*)(PA + rowt * 1536 + cu.h * 128 + 16 * mt + 4 * g);
        unsigned rb[4], ka_[4], kb_[4];
#pragma unroll
        for (int ks = 0; ks < 4; ++ks) { const unsigned cx = 64u * (unsigned)(ks ^ (n & 3));
            rb[ks] = 256u * n + cx + 16u * (unsigned)(g ^ ((n >> 2) & 3));
            ka_[ks] = 256u * (8 * (n >> 2) + (n & 3)) + cx + 16u * (unsigned)(g ^ ((2 * (n >> 2)) & 3));
            kb_[ks] = 256u * (8 * (n >> 2) + (n & 3) + 4) + cx + 16u * (unsigned)(g ^ ((2 * (n >> 2) + 1) & 3)); }
        float qnf = 0.f, qnb = 0.f;
#pragma unroll
        for (int ks = 0; ks < 4; ++ks) { float q8[8]; unpack8(qf[ks], q8);
            const f32x4 a0 = *(const LAS f32x4*)(nF + 32 * ks + 8 * g), a1 = *(const LAS f32x4*)(nF + 32 * ks + 8 * g + 4), c0 = *(const LAS f32x4*)(nB + 32 * ks + 8 * g), c1 = *(const LAS f32x4*)(nB + 32 * ks + 8 * g + 4);
#pragma unroll
            for (int j = 0; j < 4; ++j) { qnf += q8[j] * a0[j] + q8[4 + j] * a1[j]; qnb += q8[j] * c0[j] + q8[4 + j] * c1[j]; } }
        qnf = red_hi_add(qnf); qnb = red_hi_add(qnb);
        const float mf = sc[4], mb = sc[5], MFt = fmaxf(mf, sc[0]), bFt = sc[1], MBt = fmaxf(mb, sc[2]), bBt = sc[3];
        float pp[4][8], pdb[8]; float sumF = 0.f, sumB = 0.f;
#pragma unroll
        for (int j = 0; j < 8; ++j) pdb[j] = 0.f;
        f32x4 sA[4], sB[4];
#pragma unroll
        for (int blk = 0; blk < 4; ++blk) { sA[blk] = (f32x4){0.f, 0.f, 0.f, 0.f}; sB[blk] = (f32x4){0.f, 0.f, 0.f, 0.f}; }
#pragma unroll
        for (int ks = 0; ks < 4; ++ks) {
            bf16x8 A0[4], A1[4];
#pragma unroll
            for (int blk = 0; blk < 4; ++blk) { A0[blk] = *(const LAS bf16x8*)(TK + ka_[ks] + blk * 8192); A1[blk] = *(const LAS bf16x8*)(TK + kb_[ks] + blk * 8192); }
#pragma unroll
            for (int blk = 0; blk < 4; ++blk) { sA[blk] = mfma16(A0[blk], __builtin_bit_cast(bf16x8, qf[ks]), sA[blk]); sB[blk] = mfma16(A1[blk], __builtin_bit_cast(bf16x8, qf[ks]), sB[blk]); }
        }
#pragma unroll
        for (int blk = 0; blk < 4; ++blk) {
            const f32x4 sa = sA[blk], sb2 = sB[blk];
            if (blk <= dblk) {
                const f32x4 af0 = *(const LAS f32x4*)(aF + 32 * blk + 8 * g), af1 = *(const LAS f32x4*)(aF + 32 * blk + 8 * g + 4);
#pragma unroll
                for (int j = 0; j < 8; ++j) { const int s = 32 * blk + 8 * g + j; const float sv = j < 4 ? sa[j & 3] : sb2[j & 3]; const float afs = j < 4 ? af0[j & 3] : af1[j & 3];
                    const float v = (s <= t) ? sv * __expf(afs - MFt) : 0.f; pp[blk][j] = v; sumF += v; }
            }
            if (blk >= dblk) {
                const f32x4 ab0 = *(const LAS f32x4*)(aB + 32 * blk + 8 * g), ab1 = *(const LAS f32x4*)(aB + 32 * blk + 8 * g + 4);
#pragma unroll
                for (int j = 0; j < 8; ++j) { const int s = 32 * blk + 8 * g + j; const float sv = j < 4 ? sa[j & 3] : sb2[j & 3]; const float abs_ = j < 4 ? ab0[j & 3] : ab1[j & 3];
                    const float v = (s >= t) ? sv * __expf(abs_ - MBt) : 0.f; if (blk == dblk) pdb[j] = v; else pp[blk][j] = v; sumB += v; }
            }
        }
        sumF = red_hi_add(sumF); sumB = red_hi_add(sumB);
        const float wiF = __expf(mf - MFt), wiB = __expf(mb - MBt);
        const float rF = 1.f / fmaxf(fabsf(sumF + wiF * qnf), __expf(-bFt - MFt)), rB = 1.f / fmaxf(fabsf(sumB + wiB * qnb), __expf(-bBt - MBt));
        bf16x8 pfr[4];
#pragma unroll
        for (int blk = 0; blk < 4; ++blk) { const float s1 = blk <= dblk ? rF : rB; const float sd = blk == dblk ? rB : 0.f; float q[8];
#pragma unroll
            for (int j = 0; j < 8; ++j) q[j] = pp[blk][j] * s1 + pdb[j] * sd;
            u32x4 w; w.x = cvt_pk_bf16(q[0], q[1]); w.y = cvt_pk_bf16(q[2], q[3]); w.z = cvt_pk_bf16(q[4], q[5]); w.w = cvt_pk_bf16(q[6], q[7]); pfr[blk] = __builtin_bit_cast(bf16x8, w); }
        const float cF = wiF * rF, cB = wiB * rB;
        f32x4 O[8];
#pragma unroll
        for (int mt = 0; mt < 8; ++mt) O[mt] = (f32x4){0.f, 0.f, 0.f, 0.f};
#pragma unroll
        for (int ks = 0; ks < 4; ++ks) { bf16x8 Af[8];
#pragma unroll
            for (int mt = 0; mt < 8; ++mt) Af[mt] = *(const LAS bf16x8*)(TV + rb[ks] + mt * 4096);
#pragma unroll
            for (int mt = 0; mt < 8; ++mt) O[mt] = mfma16(Af[mt], pfr[ks], O[mt]); }
        asm volatile("s_waitcnt vmcnt(0) lgkmcnt(0)" ::: "memory"); __syncthreads();
        const bool has_next = munit_of(blockIdx.x + X.G * (ui + 1), l, nu);
        if (has_next) { MU_DMA_A(nu, sb ^ 1); MU_LOAD_P1(nu, qn_, scn); }
        float ss = 0.f;
#pragma unroll
        for (int hh = 0; hh < 2; ++hh) { f32x4 aF_[4], aB_[4];
#pragma unroll
          for (int m4 = 0; m4 < 4; ++m4) { aF_[m4] = (f32x4){0.f, 0.f, 0.f, 0.f}; aB_[m4] = (f32x4){0.f, 0.f, 0.f, 0.f}; }
#pragma unroll
          for (int ks = 0; ks < 4; ++ks) { bf16x8 Cf[4], Cb[4];
#pragma unroll
            for (int m4 = 0; m4 < 4; ++m4) { Cf[m4] = *(const LAS bf16x8*)(TCF + rb[ks] + (4 * hh + m4) * 4096); Cb[m4] = *(const LAS bf16x8*)(TCB + rb[ks] + (4 * hh + m4) * 4096); }
#pragma unroll
            for (int m4 = 0; m4 < 4; ++m4) { aF_[m4] = mfma16(Cf[m4], __builtin_bit_cast(bf16x8, qf[ks]), aF_[m4]); aB_[m4] = mfma16(Cb[m4], __builtin_bit_cast(bf16x8, qf[ks]), aB_[m4]); } }
#pragma unroll
          for (int m4 = 0; m4 < 4; ++m4) { const int mt = 4 * hh + m4; O[mt] = O[mt] + cF * aF_[m4] + cB * aB_[m4];
            ss += (O[mt][0] * O[mt][0] + O[mt][1] * O[mt][1]) + (O[mt][2] * O[mt][2] + O[mt][3] * O[mt][3]); } }
        ss = red_hi_add(ss);
        const float rstd = rsqrtf(ss * (1.f / 128.f) + EPS);
#pragma unroll
        for (int mt = 0; mt < 8; ++mt) { const int dv0 = 16 * mt + 4 * g; const f32x4 w4 = *(const LAS f32x4*)(mnw + dv0);
            const float g0 = __uint_as_float(mo[mt].x << 16), g1 = __uint_as_float(mo[mt].x & 0xffff0000u), g2 = __uint_as_float(mo[mt].y << 16), g3 = __uint_as_float(mo[mt].y & 0xffff0000u);
            const float o0 = O[mt][0] * rstd * w4[0] * __builtin_amdgcn_rcpf(1.f + __expf(-g0)), o1 = O[mt][1] * rstd * w4[1] * __builtin_amdgcn_rcpf(1.f + __expf(-g1));
            const float o2 = O[mt][2] * rstd * w4[2] * __builtin_amdgcn_rcpf(1.f + __expf(-g2)), o3 = O[mt][3] * rstd * w4[3] * __builtin_amdgcn_rcpf(1.f + __expf(-g3));
            u32x2 w; w.x = cvt_pk_bf16(o0, o1); w.y = cvt_pk_bf16(o2, o3); *(u32x2*)(ACT + rowt * 1024 + cu.h * 128 + dv0) = w; }
        asm volatile("s_waitcnt vmcnt(0) lgkmcnt(0)" ::: "memory"); __syncthreads();
        if (!has_next) break;
        cu = nu; ++ui;
#pragma unroll
        for (int ks = 0; ks < 4; ++ks) qf[ks] = qn_[ks];
#pragma unroll
        for (int j = 0; j < 6; ++j) sc[j] = scn[j];
    }
#undef MU_DMA_A
#undef MU_LOAD_P1
}

constexpr float NA_C2 = 0.125f * 1.4426950408889634f;
template <bool PARTIAL>
__device__ __forceinline__ void na_ctx_tile(LAS unsigned char* CK, LAS unsigned char* CV, const u32x4 qf0, const u32x4 qf1  , bf16* orow  , float* pm, int n, int g) {
    u32x4 qf[2]; qf[0] = qf0; qf[1] = qf1;
    const unsigned ka0 = (unsigned)(8 * (n >> 2) + (n & 3)) * 144u + 16u * g, ka1 = ka0 + 4u * 144u, vb = (unsigned)n * 528u + 16u * g;
    f32x4 s[8][2]; float mx = -1e30f;
#pragma unroll
    for (int blk = 0; blk < 8; ++blk) { s[blk][0] = (f32x4){0.f, 0.f, 0.f, 0.f}; s[blk][1] = (f32x4){0.f, 0.f, 0.f, 0.f}; }
#pragma unroll
    for (int ks = 0; ks < 2; ++ks)
#pragma unroll
        for (int hb = 0; hb < 4; ++hb) { bf16x8 A0[2], A1[2];
#pragma unroll
            for (int b4 = 0; b4 < 2; ++b4) { A0[b4] = *(const LAS bf16x8*)(CK + ka0 + (2 * hb + b4) * 4608 + ks * 64); A1[b4] = *(const LAS bf16x8*)(CK + ka1 + (2 * hb + b4) * 4608 + ks * 64); }
#pragma unroll
            for (int b4 = 0; b4 < 2; ++b4) { s[2 * hb + b4][0] = mfma16(A0[b4], __builtin_bit_cast(bf16x8, qf[ks]), s[2 * hb + b4][0]); s[2 * hb + b4][1] = mfma16(A1[b4], __builtin_bit_cast(bf16x8, qf[ks]), s[2 * hb + b4][1]); } }
#pragma unroll
    for (int blk = 0; blk < 8; ++blk) {
        s[blk][0] = s[blk][0] * NA_C2; s[blk][1] = s[blk][1] * NA_C2;
        mx = fmaxf(mx, fmaxf(fmaxf(fmaxf(s[blk][0][0], s[blk][0][1]), fmaxf(s[blk][0][2], s[blk][0][3])), fmaxf(fmaxf(s[blk][1][0], s[blk][1][1]), fmaxf(s[blk][1][2], s[blk][1][3]))));
    }
    mx = red_hi_max(mx);
    float sum = 0.f; bf16x8 pfr[8];
#pragma unroll
    for (int blk = 0; blk < 8; ++blk) { float e[8];
#pragma unroll
        for (int j = 0; j < 8; ++j) { e[j] = __builtin_amdgcn_exp2f(s[blk][j >> 2][j & 3] - mx); sum += e[j]; }
        u32x4 w; w.x = cvt_pk_bf16(e[0], e[1]); w.y = cvt_pk_bf16(e[2], e[3]); w.z = cvt_pk_bf16(e[4], e[5]); w.w = cvt_pk_bf16(e[6], e[7]); pfr[blk] = __builtin_bit_cast(bf16x8, w); }
    sum = red_hi_add(sum);
    const float inv = 1.f / sum;
    f32x4 oo[4];
#pragma unroll
    for (int mt = 0; mt < 4; ++mt) oo[mt] = (f32x4){0.f, 0.f, 0.f, 0.f};
#pragma unroll
    for (int b2 = 0; b2 < 4; ++b2) { bf16x8 Vf[2][4];
#pragma unroll
        for (int q = 0; q < 2; ++q)
#pragma unroll
            for (int mt = 0; mt < 4; ++mt) Vf[q][mt] = *(const LAS bf16x8*)(CV + vb + mt * 8448 + (2 * b2 + q) * 64);
#pragma unroll
        for (int q = 0; q < 2; ++q)
#pragma unroll
            for (int mt = 0; mt < 4; ++mt) oo[mt] = mfma16(Vf[q][mt], pfr[2 * b2 + q], oo[mt]); }
#pragma unroll
    for (int mt = 0; mt < 4; ++mt) { const f32x4 o = oo[mt]; u32x2 w; w.x = cvt_pk_bf16(o[0] * inv, o[1] * inv); w.y = cvt_pk_bf16(o[2] * inv, o[3] * inv); *(u32x2*)(orow + 16 * mt + 4 * g) = w; }
    if (PARTIAL && g == 0) { pm[0] = mx; pm[1] = sum; }
}
__device__ __forceinline__ void na_job(const Ctx& X, int job, int l, int TID, int LANE) {
    KargP ka = kargs(); unsigned char* const ws = ka->ws;
    asm volatile("" : "+v"(TID), "+v"(LANE));
    const int bhd = job >> 2, qq = job & 3, b = bhd >> 3, hd = bhd & 7, n_ = LANE & 15, g_ = LANE >> 4;
    const bf16* PA = (const bf16*)(ws + WS_PA); const bf16* NVT = (const bf16*)(ws + WS_NVT); bf16* ACT = (bf16*)ka->out;
    bf16* PARTO = (bf16*)(ws + WS_PARTO) + (size_t)bhd * 4096 * 64; float* PARTM = (float*)(ws + WS_PARTM) + (size_t)bhd * 4096 * 2;
    const bf16* vtb = NVT + (size_t)(b * 8 + hd) * 64 * UTP;
    LAS unsigned char* CK = X.lds; LAS unsigned char* CV = X.lds + 36864; LAS float* rpbL = (LAS float*)(X.lds + LDSCTL_OFF + 4096);
#pragma unroll
    for (int i = 0; i < 4; ++i) { const int nn = TID + NTHR * i, key = nn >> 3, ch = nn & 7; *(LAS u32x4*)(CK + key * 144 + ch * 16) = *(const u32x4*)(PA + ((size_t)b * UT + key) * 1536 + 1024 + hd * 64 + ch * 8); }
#pragma unroll
    for (int i = 0; i < 4; ++i) { const int nn = TID + NTHR * i, dv = nn >> 5, ch = nn & 31; *(LAS u32x4*)(CV + dv * 528 + ch * 16) = *(const u32x4*)(vtb + (size_t)dv * UTP + ch * 8); }
    if (TID < 528) rpbL[TID] = (TID >= 16 && TID < 481) ? (ka->in[12] + (size_t)l * 8 * 465 + hd * 465)[TID - 16] : 0.f;
    __syncthreads();
#ifndef NA_SKIP_C
#define NA_QPTR(un_) (PA + ((size_t)b * UT + CTXL + (size_t)((16 * qq + 2 * (un_) + (X.wave >> 2)) * 64 + 16 * (X.wave & 3) + n_)) * 1536 + 512 + hd * 64 + 8 * g_)
    { u32x4 qc0 = *(const u32x4*)NA_QPTR(0), qc1 = *(const u32x4*)(NA_QPTR(0) + 32);
#pragma unroll 1
    for (int un = 0; un < 8; ++un) { int n = n_, g = g_; asm volatile("" : "+v"(n), "+v"(g)); const int r = 16 * qq + 2 * un + (X.wave >> 2), tq = r * 64 + 16 * (X.wave & 3) + n;
        const u32x4 q0 = qc0, q1 = qc1; const int un1 = min(un + 1, 7); qc0 = *(const u32x4*)NA_QPTR(un1); qc1 = *(const u32x4*)(NA_QPTR(un1) + 32);
        na_ctx_tile<true>(CK, CV, q0, q1, PARTO + (size_t)tq * 64, PARTM + (size_t)tq * 2, n, g); } }
    if (l == 0 && qq < 2) { const int n = n_, g = g_; const size_t row = (size_t)b * UT + 128 * qq + 16 * X.wave + n; const bf16* qrow = PA + row * 1536 + 512 + hd * 64 + 8 * g;
        na_ctx_tile<false>(CK, CV, *(const u32x4*)qrow, *(const u32x4*)(qrow + 32), ACT + row * 1024 + 512 + hd * 64, nullptr, n, g); }
#endif
    __syncthreads();
#ifndef NA_SKIP_W
    LAS unsigned char* WK = X.lds; LAS unsigned char* WV = X.lds + 73728;
    int have_hi = -1;
    u32x4 pk_[2], pv_[2];
    const int skey = TID >> 3, sch = TID & 7;
#define NA_ROW_LOAD(kr, KD, VD) do { const size_t tok_ = (size_t)b * UT + CTXL + (size_t)(kr) * 64; \
        KD = *(const u32x4*)(PA + (tok_ + skey) * 1536 + 1024 + hd * 64 + sch * 8); VD = *(const u32x4*)(vtb + (size_t)skey * UTP + CTXL + (kr) * 64 + sch * 8); } while (0)
#define NA_ROW_STORE(kr, KD, VD) do { const int sl_ = (kr) % 9; *(LAS u32x4*)(WK + (sl_ * 64 + skey) * 128 + ((sch ^ (skey & 7)) * 16)) = KD; \
        *(LAS u32x4*)(WV + skey * 1152 + (sl_ * 8 + (sch ^ (skey & 7))) * 16) = VD; } while (0)
    {
        const int r0 = 16 * qq, rs_lo = min(max(r0 - 4, 0), 56), nrows = min(9, 64 - rs_lo);
        for (int kr = rs_lo; kr < rs_lo + nrows; ++kr) { u32x4 kd, vd; NA_ROW_LOAD(kr, kd, vd); NA_ROW_STORE(kr, kd, vd); }
        have_hi = rs_lo + nrows - 1;
    }
    __syncthreads();
    u32x4 qn0, qn1; float mcn, lcn; u32x2 pcn[4];
#define NA_UNIT_LOAD(un_) do { const int tq_ = (16 * qq + 2 * (un_) + (X.wave >> 2)) * 64 + 16 * (X.wave & 3) + n_; \
        qn0 = *(const u32x4*)NA_QPTR(un_); qn1 = *(const u32x4*)(NA_QPTR(un_) + 32); mcn = PARTM[(size_t)tq_ * 2]; lcn = PARTM[(size_t)tq_ * 2 + 1]; \
        _Pragma("unroll") for (int mt_ = 0; mt_ < 4; ++mt_) pcn[mt_] = *(const u32x2*)(PARTO + (size_t)tq_ * 64 + 16 * mt_ + 4 * g_); } while (0)
    NA_UNIT_LOAD(0);
#pragma unroll 1
    for (int un = 0; un < 8; ++un) {
        const int r0 = 16 * qq + 2 * un;
        u32x4 qf[2]; qf[0] = qn0; qf[1] = qn1; const float m_c = mcn, l_c = lcn; u32x2 pc_[4];
#pragma unroll
        for (int mt = 0; mt < 4; ++mt) pc_[mt] = pcn[mt];
        NA_UNIT_LOAD(min(un + 1, 7));
        int nnew = 0, new0 = 0;
        if (un < 7) { const int r1 = r0 + 2, lo1 = min(max(r1 - 4, 0), 56), hi1 = lo1 + min(9, 64 - lo1) - 1; nnew = hi1 - have_hi; new0 = have_hi + 1; }
        if (nnew > 0) NA_ROW_LOAD(new0, pk_[0], pv_[0]);
        if (nnew > 1) NA_ROW_LOAD(new0 + 1, pk_[1], pv_[1]);
        {
            int n = n_, g = g_; asm volatile("" : "+v"(n), "+v"(g));
            const int r = r0 + (X.wave >> 2), c0 = 16 * (X.wave & 3), rs = min(max(r - 4, 0), 56), cs0 = min(max(c0 - 8, 0), 32);
            const int c = c0 + n, csq = min(max(c - 8, 0), 48), tq = r * 64 + c; const size_t row = (size_t)b * UT + CTXL + tq;
            const unsigned kb0 = (unsigned)(cs0 + 8 * (n >> 2) + (n & 3)) * 128u + 16u * (unsigned)(g ^ (n & 3)), kb1 = kb0 + 4u * 128u;
            const unsigned vb = (unsigned)n * 1152u + 16u * (unsigned)(((cs0 >> 3) + g) ^ (n & 7));
            const int dk0 = cs0 + 8 * g - csq;
            const LAS float* rpl = rpbL + 16 + (rs - r + 7) * 31 + (cs0 + 8 * g - c + 15);
            f32x4 s[8][2]; float mx = m_c;
            int slot[8];
#pragma unroll
            for (int i = 0; i < 8; ++i) slot[i] = (rs + i) % 9;
#pragma unroll
            for (int i = 0; i < 8; ++i) {
                f32x4 sa = {0.f, 0.f, 0.f, 0.f}, sb = {0.f, 0.f, 0.f, 0.f};
#pragma unroll
                for (int ks = 0; ks < 2; ++ks) { sa = mfma16(*(const LAS bf16x8*)(WK + kb0 + slot[i] * 8192 + 64 * ks), __builtin_bit_cast(bf16x8, qf[ks]), sa);
                    sb = mfma16(*(const LAS bf16x8*)(WK + kb1 + slot[i] * 8192 + 64 * (ks ^ 1)), __builtin_bit_cast(bf16x8, qf[ks]), sb); }
                const LAS float* bp = rpl + i * 31;
#pragma unroll
                for (int j = 0; j < 8; ++j) { const bool ok = (unsigned)(dk0 + j) < 16u; const float bias = bp[j]; const float sv = (j < 4 ? sa[j & 3] : sb[j & 3]);
                    const float x = ok ? (sv * 0.125f + bias) * 1.4426950408889634f : -1e30f; s[i][j >> 2][j & 3] = x; mx = fmaxf(mx, x); }
                asm volatile("" ::: "memory");
            }
            mx = red_hi_max(mx);
            float sum = 0.f; bf16x8 pfr[8];
#pragma unroll
            for (int i = 0; i < 8; ++i) { float e[8];
#pragma unroll
                for (int j = 0; j < 8; ++j) { e[j] = __builtin_amdgcn_exp2f(s[i][j >> 2][j & 3] - mx); sum += e[j]; }
                u32x4 w; w.x = cvt_pk_bf16(e[0], e[1]); w.y = cvt_pk_bf16(e[2], e[3]); w.z = cvt_pk_bf16(e[4], e[5]); w.w = cvt_pk_bf16(e[6], e[7]); pfr[i] = __builtin_bit_cast(bf16x8, w); }
            sum = red_hi_add(sum);
            const float wc = __builtin_amdgcn_exp2f(m_c - mx) * l_c, inv = 1.f / (wc + sum);
#pragma unroll
            for (int mt = 0; mt < 4; ++mt) { f32x4 o = {0.f, 0.f, 0.f, 0.f};
#pragma unroll
                for (int i = 0; i < 8; ++i) o = mfma16(*(const LAS bf16x8*)(WV + vb + mt * 18432 + slot[i] * 128), pfr[i], o);
                const u32x2 pc = pc_[mt];
                const float p0 = __uint_as_float(pc.x << 16), p1 = __uint_as_float(pc.x & 0xffff0000u), p2 = __uint_as_float(pc.y << 16), p3 = __uint_as_float(pc.y & 0xffff0000u);
                u32x2 w; w.x = cvt_pk_bf16((o[0] + wc * p0) * inv, (o[1] + wc * p1) * inv); w.y = cvt_pk_bf16((o[2] + wc * p2) * inv, (o[3] + wc * p3) * inv);
                *(u32x2*)(ACT + row * 1024 + 512 + hd * 64 + 16 * mt + 4 * g) = w; }
        }
        __syncthreads();
        if (nnew > 0) NA_ROW_STORE(new0, pk_[0], pv_[0]);
        if (nnew > 1) NA_ROW_STORE(new0 + 1, pk_[1], pv_[1]);
        if (nnew > 0) have_hi += nnew;
        __syncthreads();
    }
#undef NA_ROW_LOAD
#undef NA_ROW_STORE
#undef NA_UNIT_LOAD
#endif
}
__device__ __forceinline__ void phase_mix(const Ctx& X, int l, int flags) {
    int tid_ = X.wave * 64 + lane_id(); asm volatile("" : "+v"(tid_)); const int TID = tid_, LANE = tid_ & 63;
#ifdef MIXONLY
    flags &= MIXONLY;
#endif
    if (flags & 1) mlstm_run(X, l, TID, LANE);
    if (flags & 2) { for (int job = blockIdx.x; job < 256; job += X.G) na_job(X, job, l, TID, LANE); }
}

#ifndef CPH
#define CPH 0xFFFFFFFFu
#endif
#define CEN(bit) ((CPH >> (bit)) & 1u)
#define IN(k) (lo <= (k) && (k) < hi)
#define SEAM(k) do { if (IN(k) && IN((k) + 1)) xcd_barrier(bar, LEADER); } while (0)
#ifndef REPMASK
#define REPMASK 0u
#endif
#define REP(bit) for (int rep_ = 0; rep_ < ((((REPMASK) >> (bit)) & 1u) ? 2 : 1); ++rep_)
#define REPBAR if (rep_) xcd_barrier(bar, LEADER)
template <int l>
__device__ __forceinline__ void layer_body(const Ctx& X, const XcdBarrier& bar, const int lo, const int hi, const int mixflags) {
#define LEADER (X.wave == 0 && lane_id() == 0)

        const int pb = 1 + 10 * l; const bool last = (l == 1);
        if (CEN(1) && IN(pb + K_NORM1)) REP(1) { REPBAR;
            KargP ka = kargs(); unsigned char* const ws = ka->ws; float* MOD = (float*)(ws + WS_MOD);
            if (l == 0) { rows_phase<false, false, false>(X, ka->in[0], ka->in[2], nullptr, ka->in[6], MOD, 0, 1, nullptr, false, 0); __syncthreads(); phase_wconv(X); }
            else rows_phase<true, false, false, false, true>(X, nullptr, nullptr, nullptr, ka->in[6] + 1024, MOD + (size_t)9 * 6144, 0, 1, MOD, false, 0, mixflags);
        } SEAM(pb + K_NORM1);
        if (CEN(2) && IN(pb + K_GEMM_IN)) REP(2) { REPBAR;
            KargP ka = kargs(); unsigned char* const ws = ka->ws;
            SchedIn S; S.init(136, 15, X.G, (int)blockIdx.x); S.A = (const char*)ka->out; S.B = (const char*)(ws + WS_WIN) + (size_t)l * 3840 * 1024 * 2; S.tstep = (size_t)256 * 1024 * 2;
            EpiInP E{(bf16*)(ws + WS_QKRAW), (bf16*)(ws + WS_PA), (bf16*)(ws + WS_MVT), (bf16*)(ws + WS_NVT), (float*)(ws + WS_GATES), ka->in[10] + l * 16, mixflags};
            pg8::gemm_phase<EpiInP, SchedIn>(X.lds, 1024, S, E, X.wave);
        } SEAM(pb + K_GEMM_IN);
        if (CEN(3) && IN(pb + K_PREP)) REP(3) { REPBAR; phase_prep(X, l); } SEAM(pb + K_PREP);
        if (CEN(4) && IN(pb + K_SCAN)) REP(4) { REPBAR; phase_scan(X, mixflags); } SEAM(pb + K_SCAN);
        if (CEN(5) && IN(pb + K_MIX)) REP(5) { REPBAR; phase_mix(X, l, mixflags); } SEAM(pb + K_MIX);
        if (CEN(6) && IN(pb + K_GEMM_OUT)) REP(6) { REPBAR;
            KargP ka = kargs(); unsigned char* const ws = ka->ws;
            EpiOutP E{(bf16*)(ws + WS_Y)};
            SchedLatent S; S.init(last ? 128 : 136, 4, X.G, (int)blockIdx.x); S.lat = last ? 1 : 0; S.A = (const char*)ka->out; S.B = (const char*)(ws + WS_WOUT) + (size_t)l * 1024 * 1024 * 2; S.tstep = (size_t)256 * 1024 * 2;
            pg8::gemm_phase<EpiOutP, SchedLatent>(X.lds, 1024, S, E, X.wave);
            if (l == 0 && (int)blockIdx.x >= 32) convert_experts(X, 0, 0, CONV_TAIL_OUT, ((int)blockIdx.x - 32) * NWAVES + X.wave, 224 * NWAVES);
        } SEAM(pb + K_GEMM_OUT);
        if (CEN(7) && IN(pb + K_NORM2)) REP(7) { REPBAR;
            { KargP ka = kargs(); unsigned char* const ws = ka->ws;
              rows_phase<false, true, false, true, l != 0>(X, ka->in[0], ka->in[2], nullptr,
                                                   ka->in[14] + l * 1024, (const float*)(ws + WS_MOD) + (size_t)l * 9 * 6144, 3, 4, nullptr, last, l, mixflags); }
            __syncthreads();
            if (!(mixflags & 256)) {
                int first = CONV_TAIL_OUT;
                if (l == 1) { KargP ka = kargs(); const int nt0 = (int)ld_u32((unsigned*)ka->ws + CW_NT), rem = (nt0 * 4) % X.G, nf = rem ? X.G - rem : 0; first = nf * NWAVES * 6; }
                convert_experts(X, l, first, 1 << 30, X.gw, X.ngw); }
        } SEAM(pb + K_NORM2);
        if (CEN(8) && IN(pb + K_SLOTS)) REP(8) { REPBAR; phase_slots(X, l, last); } SEAM(pb + K_SLOTS);
        if (CEN(9) && IN(pb + K_MOE1)) REP(9) { REPBAR;
            KargP ka = kargs(); unsigned char* const ws = ka->ws;
            const int nt = (int)ld_u32((unsigned*)ws + CW_NT + 32 * l);
            SchedMoeG S; S.init(nt, 4, X.G, (int)blockIdx.x); S.A = (const char*)ka->out; S.B = (const char*)(ws + (l ? WS_EW13_L1 : WS_EW13)); S.tstepB = (size_t)256 * 1024 * 2;
            S.TILE_E = (const int*)(ws + WS_ROUTE + RT_TILE_E) + 512 * l; S.SLOT_TOK = (const int*)(ws + WS_ROUTE + RT_SLOT_TOK);
            EpiMoe1 E{(bf16*)(ws + WS_ACTM)};
            pg8::gemm_phase<EpiMoe1, SchedMoeG, true, true, true>(X.lds, 1024, S, E, X.wave);
            { const int rem = (nt * 4) % X.G, nf = X.G - rem; if (l == 0 && rem != 0 && (int)blockIdx.x >= rem) convert_experts(X, 1, 0, nf * NWAVES * 4, ((int)blockIdx.x - rem) * NWAVES + X.wave, nf * NWAVES); }
        } SEAM(pb + K_MOE1);
        if (CEN(10) && IN(pb + K_MOE2)) REP(10) { REPBAR;
            KargP ka = kargs(); unsigned char* const ws = ka->ws;
            const int nt = (int)ld_u32((unsigned*)ws + CW_NT + 32 * l);
            SchedMoe S; S.init(nt, 4, X.G, (int)blockIdx.x); S.A = (const char*)(ws + WS_ACTM); S.B = (const char*)(ws + (l ? WS_EW2_L1 : WS_EW2)); S.tstep = (size_t)256 * 512 * 2; S.TILE_E = (const int*)(ws + WS_ROUTE + RT_TILE_E) + 512 * l;
            EpiMoe2 E{(bf16*)(ws + WS_Y)};
            pg8::gemm_phase<EpiMoe2, SchedMoe>(X.lds, 512, S, E, X.wave);
            { const int rem = (nt * 4) % X.G, nf = X.G - rem; if (l == 0 && rem != 0 && (int)blockIdx.x >= rem) convert_experts(X, 1, nf * NWAVES * 4, nf * NWAVES * 6, ((int)blockIdx.x - rem) * NWAVES + X.wave, nf * NWAVES); }
        } SEAM(pb + K_MOE2);
    }
__global__ void __launch_bounds__(NTHR, 2) mk_fwd(Args args) {
    extern __shared__ __attribute__((aligned(16))) unsigned char lds_raw[];
    Ctx X;
    X.lds = (LAS unsigned char*)lds_raw; X.wave = __builtin_amdgcn_readfirstlane(threadIdx.x >> 6); X.G = gridDim.x;
    X.gw = blockIdx.x * NWAVES + X.wave; X.ngw = X.G * NWAVES;
    volatile LAS unsigned* MISC = (volatile LAS unsigned*)(X.lds + MISC_OFF);
    for (int u = X.wave * 64 + lane_id(); u < (LDS_BYTES - LDSCTL_OFF) / 4; u += NTHR) ((LAS unsigned*)(X.lds + LDSCTL_OFF))[u] = 0u;
    __syncthreads();
    const int lo = args.ph_lo, hi = args.ph_hi;
    XcdBarrier bar; bar.bar = (unsigned*)(args.ws + WS_CTL) + CW_BAR + args.bar_region * XCD_BAR_WORDS; bar.x = 0; bar.st = nullptr;
    if (hi - lo > 1) bar = xcd_barrier_post((unsigned*)(args.ws + WS_CTL) + CW_BAR + args.bar_region * XCD_BAR_WORDS, MISC + 8, LEADER);

    if (CEN(0) && IN(PH_PRO)) { phase_prologue(X); } SEAM(PH_PRO);

    layer_body<0>(X, bar, lo, hi, args.mixflags);
    layer_body<1>(X, bar, lo, hi, args.mixflags);
    if (CEN(11) && IN(PH_FINAL)) { KargP ka = kargs(); unsigned char* const ws = ka->ws;
        rows_phase<true, false, true, false, true>(X, nullptr, nullptr, ka->out, ka->in[20], nullptr, 0, 0, (const float*)(ws + WS_MOD) + (size_t)9 * 6144, true, 1); }
#undef IN
#undef SEAM
}
constexpr unsigned PM_PRO = 1u << 0, PM_NORM1 = 1u << 1, PM_GEMM_IN = 1u << 2, PM_PREP = 1u << 3, PM_SCAN = 1u << 4, PM_MIX = 1u << 5, PM_GEMM_OUT = 1u << 6, PM_NORM2 = 1u << 7,
                   PM_SLOTS = 1u << 8, PM_MOE1 = 1u << 9, PM_MOE2 = 1u << 10, PM_FINAL = 1u << 11;
#ifndef PMASK
#define PMASK (PM_PRO | PM_NORM1 | PM_GEMM_IN | PM_PREP | PM_SCAN | PM_MIX | PM_GEMM_OUT | PM_NORM2 | PM_SLOTS | PM_MOE1 | PM_MOE2 | PM_FINAL)
#endif
#ifndef MIXFLAGS
#define MIXFLAGS 3
#endif
static bool persist_phase(int ph) { if (ph == PH_PRO) return (PMASK & PM_PRO) != 0; if (ph == PH_FINAL) return (PMASK & PM_FINAL) != 0; return (PMASK & (2u << ((ph - 1) % 10))) != 0; }

extern "C" void kernel_launch(void* const* d_in, const int* in_sizes, int n_in, void* d_out, int out_size, void* d_ws, size_t ws_size, hipStream_t stream) {
    const float* x = (const float*)d_in[0]; const float* c = (const float*)d_in[1]; const float* ctx = (const float*)d_in[2]; const float* c_ctx = (const float*)d_in[3];
    const float* ada_w = (const float*)d_in[4]; const float* ada_b = (const float*)d_in[5]; const float* norm1_w = (const float*)d_in[6]; const float* w_in = (const float*)d_in[7];
    const float* conv_w = (const float*)d_in[8]; const float* conv_b = (const float*)d_in[9]; const float* gate_b = (const float*)d_in[10]; const float* mnorm_w = (const float*)d_in[11];
    const float* rpb = (const float*)d_in[12]; const float* w_out = (const float*)d_in[13]; const float* norm2_w = (const float*)d_in[14]; const float* router_w = (const float*)d_in[15];
    const float* router_b = (const float*)d_in[16]; const float* exp_w1 = (const float*)d_in[17]; const float* exp_w3 = (const float*)d_in[18]; const float* exp_w2 = (const float*)d_in[19];
    const float* final_w = (const float*)d_in[20];
    if (ws_size < WS_END) { fprintf(stderr, "kernel_launch: workspace too small (%zu < %zu)\n", ws_size, (size_t)WS_END); return; }
    unsigned char* ws = (unsigned char*)d_ws; float* out = (float*)d_out;
    unsigned* CTL = (unsigned*)(ws + WS_CTL); float* MOD = (float*)(ws + WS_MOD); float* CTXB = (float*)(ws + WS_CTX);
    float* GATES = (float*)(ws + WS_GATES); bf16* ACT = (bf16*)(ws + WS_ACT); bf16* PA = (bf16*)(ws + WS_PA); bf16* QKRAW = (bf16*)(ws + WS_QKRAW); bf16* CST = (bf16*)(ws + WS_CST);
    bf16* MVT = (bf16*)(ws + WS_MVT); bf16* NVT = (bf16*)(ws + WS_NVT); bf16* QP = (bf16*)(ws + WS_QP); bf16* KP = (bf16*)(ws + WS_KP); bf16* KPT = (bf16*)(ws + WS_KPT);
    float* NST = (float*)(ws + WS_NST); float* MST = (float*)(ws + WS_MST); float* HSUM = (float*)(ws + WS_HSUM); bf16* ACTM = (bf16*)(ws + WS_ACTM); bf16* Y = (bf16*)(ws + WS_Y);
    int* TOK_E = (int*)(ws + WS_ROUTE + RT_TOK_E); float* TOK_W = (float*)(ws + WS_ROUTE + RT_TOK_W); int* TOK_SLOT = (int*)(ws + WS_ROUTE + RT_TOK_SLOT);
    int* SLOT_TOK = (int*)(ws + WS_ROUTE + RT_SLOT_TOK); float* SLOT_W = (float*)(ws + WS_ROUTE + RT_SLOT_W); int* TILE_E0 = (int*)(ws + WS_ROUTE + RT_TILE_E);
    static int grid = 0;
    if (grid == 0) {
        int dev = 0, cus = 0; (void)hipGetDevice(&dev); (void)hipDeviceGetAttribute(&cus, hipDeviceAttributeMultiprocessorCount, dev);
        (void)hipFuncSetAttribute((const void*)nv_mout, hipFuncAttributeMaxDynamicSharedMemorySize, 70 * 1024);
        (void)hipFuncSetAttribute((const void*)mk_fwd, hipFuncAttributeMaxDynamicSharedMemorySize, LDS_BYTES);
        int per_cu = 0; (void)hipOccupancyMaxActiveBlocksPerMultiprocessor(&per_cu, (const void*)mk_fwd, NTHR, LDS_BYTES); (void)hipGetLastError();
        grid = (cus == 256 && per_cu >= 1) ? 256 : -1;
        if (grid < 0) fprintf(stderr, "kernel_launch: persistent kernel needs 256 CUs and one resident block per CU (cus %d, per_cu %d); using the naive path\n", cus, per_cu);
    }
    (void)hipMemsetAsync(ws + WS_CTL, 0, 1 * MiB, stream);
    Args a{};
    for (int i = 0; i < 21; ++i) a.in[i] = (const float*)d_in[i];
    a.out = out; a.ws = ws;
    int region = 0;
#if defined(PROBE_PHASE)
    if (grid > 0) {
        a.mixflags = MIXFLAGS;
        if (PROBE_PHASE > 0) { a.ph_lo = 0; a.ph_hi = PROBE_PHASE; a.bar_region = region++; hipLaunchKernelGGL(mk_fwd, dim3(grid), dim3(NTHR), LDS_BYTES, stream, a); }
        #ifdef PROBE_MIXFLAGS
        a.mixflags = PROBE_MIXFLAGS;
#endif
        for (int r = 1; r < PROBE_REPS; ++r) { a.ph_lo = PROBE_PHASE; a.ph_hi = PROBE_PHASE + 1; a.bar_region = region++; hipLaunchKernelGGL(mk_fwd, dim3(grid), dim3(NTHR), LDS_BYTES, stream, a); }
        a.mixflags = MIXFLAGS;
        a.ph_lo = PROBE_PHASE; a.ph_hi = NPHASE; a.bar_region = region++; hipLaunchKernelGGL(mk_fwd, dim3(grid), dim3(NTHR), LDS_BYTES, stream, a);
        return;
    }
#endif
    for (int ph = 0; ph < NPHASE;) {
        if (grid > 0 && persist_phase(ph)) {
            int ph2 = ph; while (ph2 < NPHASE && persist_phase(ph2)) ++ph2;
            a.ph_lo = ph; a.ph_hi = ph2; a.bar_region = region++; a.mixflags = MIXFLAGS;
            for (int q = ph; q < ph2; ++q) if (q >= 1 && q < PH_FINAL && (q - 1) % 10 == K_MIX && MIXFLAGS != 3) { ph2 = q + 1; break; }
            a.ph_hi = ph2;
            hipLaunchKernelGGL(mk_fwd, dim3(grid), dim3(NTHR), LDS_BYTES, stream, a);
            if (ph2 >= 2 && ph2 - 1 < PH_FINAL && (ph2 - 2) % 10 == K_MIX && MIXFLAGS != 3) {
                const int l = (ph2 - 2) / 10; const bool last = (l == 1);
                if (!(MIXFLAGS & 1)) { nv_mout<<<dim3(NCHUNK, 32), 256, (128 * 129 + 1024) * 4, stream>>>(QP, KP, MVT, GATES, CST, NST, MST, HSUM, last ? 1 : 0);
                    nv_mnorm<<<MROWS, 256, 0, stream>>>(HSUM, PA, mnorm_w + l * 512, ACT, last ? 1 : 0); }
                if (!(MIXFLAGS & 2)) { nv_na<<<dim3(SEQ, 8, 8), 128, 0, stream>>>(PA, NVT, rpb + (size_t)l * 8 * 15 * 31, ACT, 0);
                    if (!last) nv_na<<<dim3(CTXL, 8, 8), 128, 0, stream>>>(PA, NVT, rpb + (size_t)l * 8 * 15 * 31, ACT, 1); }
            }
            ph = ph2; continue;
        }
        if (ph == PH_PRO) { nv_mod<<<dim3(24, 9, 2), 256, 0, stream>>>(c, c_ctx, ada_w, ada_b, MOD); ++ph; continue; }
        if (ph == PH_FINAL) {
            nv_combine<<<MROWS, 256, 0, stream>>>(out, CTXB, MOD + (size_t)9 * 6144, TOK_SLOT, TOK_W, Y, 1);
            nv_final<<<NB * SEQ, 256, 0, stream>>>(out, final_w); ++ph; continue; }
        const int l = (ph - 1) / 10, k = (ph - 1) % 10; const bool last = (l == 1); const int lo = 32 * l;
        const float* MODl = MOD + (size_t)l * 9 * 6144;
        const float* sl = l == 0 ? x : out; const float* scx = l == 0 ? ctx : CTXB;
        int* TILE_E = TILE_E0 + 512 * l;
        switch (k) {
        case K_NORM1:
            if (l == 1) nv_combine<<<MROWS, 256, 0, stream>>>(out, CTXB, MOD, TOK_SLOT, TOK_W, Y, 0);
            nv_norm<<<MROWS, 256, 0, stream>>>(sl, scx, norm1_w + l * 1024, MODl, 0, 1, ACT, 0, nullptr, nullptr, nullptr, nullptr, nullptr, 0); break;
        case K_GEMM_IN: { EpiIn ei{QKRAW, PA, MVT, NVT, GATES, gate_b + l * 16}; EpiOut eo{};
            nv_gemm<0><<<dim3((N_IN + 63) / 64, MROWS / 64), 256, 0, stream>>>(ACT, w_in + (size_t)l * 1024 * N_IN, N_IN, N_IN, 1024, ei, eo); } break;
        case K_PREP: nv_prep<<<MROWS * 1024 / 256, 256, 0, stream>>>(QKRAW, conv_w + l * 3072, conv_b + l * 1024, QP, KP, KPT); break;
        case K_SCAN: nv_scan<<<dim3(64, 64), 256, 0, stream>>>(KP, MVT, GATES, CST, NST, MST); break;
        case K_MIX:
            nv_mout<<<dim3(NCHUNK, 32), 256, (128 * 129 + 1024) * 4, stream>>>(QP, KP, MVT, GATES, CST, NST, MST, HSUM, last ? 1 : 0);
            nv_mnorm<<<MROWS, 256, 0, stream>>>(HSUM, PA, mnorm_w + l * 512, ACT, last ? 1 : 0);
            nv_na<<<dim3(SEQ, 8, 8), 128, 0, stream>>>(PA, NVT, rpb + (size_t)l * 8 * 15 * 31, ACT, 0);
            if (!last) nv_na<<<dim3(CTXL, 8, 8), 128, 0, stream>>>(PA, NVT, rpb + (size_t)l * 8 * 15 * 31, ACT, 1);
            break;
        case K_GEMM_OUT: { EpiOut eo2{sl, scx, out, CTXB, MODl, last ? 1 : 0, 0}; EpiIn ei2{};
            nv_gemm<1><<<dim3(16, MROWS / 64), 256, 0, stream>>>(ACT, w_out + (size_t)l * 1024 * 1024, 1024, 1024, 1024, ei2, eo2); } break;
        case K_NORM2: nv_norm<<<MROWS, 256, 0, stream>>>(out, CTXB, norm2_w + l * 1024, MODl, 3, 4, ACT, 1, router_w, router_b, TOK_E, TOK_W, CTL + CW_CNT + lo, last ? 1 : 0); break;
        case K_SLOTS:
            nv_slots_off<<<1, 256, 0, stream>>>(CTL, SLOT_TOK, SLOT_W, TILE_E, lo);
            nv_slots_assign<<<MROWS / 256, 256, 0, stream>>>(CTL, TOK_E, TOK_W, TOK_SLOT, SLOT_TOK, SLOT_W, last ? 1 : 0, lo); break;
        case K_MOE1: nv_moe1<<<MAXSLOTS, 256, 0, stream>>>(CTL, ACT, SLOT_TOK, SLOT_W, TILE_E, exp_w1 + (size_t)l * 16 * 1024 * 512, exp_w3 + (size_t)l * 16 * 1024 * 512, ACTM, lo); break;
        case K_MOE2: nv_moe2<<<MAXSLOTS, 256, 0, stream>>>(CTL, ACTM, SLOT_W, TILE_E, exp_w2 + (size_t)l * 16 * 512 * 1024, Y, lo); break;
        }
        ++ph;
    }
}
```

```cpp
#include <hip/hip_runtime.h>
#include <cstdio>
#include <cstdint>

typedef unsigned short bf16;
__device__ __forceinline__ float bf2f(bf16 b) { return __uint_as_float(((unsigned)b) << 16); }
__device__ __forceinline__ bf16 f2bf(float f) { unsigned u = __float_as_uint(f); u += 0x7fffu + ((u >> 16) & 1u); return (bf16)(u >> 16); }

constexpr int DM = 1024, NB = 8, SEQ = 4096, CTXL = 256, UT = SEQ + CTXL  ;
constexpr int UTP = 4416;
constexpr int MROWS = NB * UT;
constexpr int NCHUNK = UT / 128;
constexpr int N_IN = 3600;
constexpr float EPS = 1e-6f;
constexpr int MAXSLOTS = 73728;

constexpr size_t MiB = 1u << 20;
constexpr size_t WS_CTL = 0;
constexpr size_t WS_MOD = 1 * MiB;
constexpr size_t WS_CTX = 2 * MiB;
constexpr size_t WS_WIN = 10 * MiB;
constexpr size_t WS_WOUT = 25 * MiB;
constexpr size_t WS_GATES = 29 * MiB;
constexpr size_t WS_ROUTE = 32 * MiB;
constexpr size_t WS_ACT = 34 * MiB;
constexpr size_t WS_PA = 102 * MiB;
constexpr size_t WS_QKRAW = 204 * MiB;
constexpr size_t WS_CST = 204 * MiB;
constexpr size_t WS_MVT = 272 * MiB;
constexpr size_t WS_NVT = 307 * MiB;
constexpr size_t WS_QP = 342 * MiB;
constexpr size_t WS_KP = 376 * MiB;
constexpr size_t WS_KPT = 410 * MiB;
constexpr size_t WS_NST = 445 * MiB;
constexpr size_t WS_MST = 446 * MiB + 512 * 1024;
constexpr size_t WS_HSUM = 444 * MiB;
constexpr size_t WS_DUMMY = 449 * MiB;
constexpr size_t WS_ACTM = 150 * MiB;
constexpr size_t WS_Y = 222 * MiB;
constexpr size_t WS_END = 512 * MiB;
constexpr size_t RT_TOK_E = 0, RT_TOK_W = 300 * 1024, RT_TOK_SLOT = 600 * 1024, RT_SLOT_TOK = 900 * 1024, RT_SLOT_W = 1200 * 1024, RT_TILE_E = 1500 * 1024;
constexpr int CW_CNT = 1024, CW_CUR = 1088, CW_OFF = 1152  , CW_NT = 1216;

__device__ __forceinline__ float silu_f(float v) { return v / (1.f + expf(-v)); }
__device__ __forceinline__ float sigmoid_f(float v) { return 1.f / (1.f + expf(-v)); }
__device__ __forceinline__ float logsig_f(float x) { return fminf(x, 0.f) - log1pf(expf(-fabsf(x))); }

__global__ void nv_mod(const float* c, const float* c_ctx, const float* ada_w, const float* ada_b, float* MOD) {
    const int j = blockIdx.x * 256 + threadIdx.x, r = blockIdx.y, l = blockIdx.z;
    __shared__ float s[1024];
    const float* src = r < 8 ? c + r * 1024 : c_ctx;
    for (int k = threadIdx.x; k < 1024; k += 256) s[k] = silu_f(src[k]);
    __syncthreads();
    const float* w = ada_w + (size_t)l * 1024 * 6144;
    float acc = 0.f;
    for (int k = 0; k < 1024; ++k) acc += s[k] * w[(size_t)k * 6144 + j];
    MOD[((size_t)l * 9 + r) * 6144 + j] = acc + ada_b[l * 6144 + j];
}

__device__ __forceinline__ float block_sum256(float v, float* red) {
    for (int o = 32; o >= 1; o >>= 1) v += __shfl_xor(v, o);
    __syncthreads();
    if ((threadIdx.x & 63) == 0) red[threadIdx.x >> 6] = v;
    __syncthreads();
    return red[0] + red[1] + red[2] + red[3];
}

__global__ void nv_norm(const float* xl, const float* xc, const float* nw, const float* MODl, int sh, int sc, bf16* ACT, int do_router,
                        const float* router_w, const float* router_b, int* TOK_E, float* TOK_W, unsigned* CNT, int skip_ctx) {
    const int row = blockIdx.x, b = row / UT, u = row % UT, tid = threadIdx.x;
    const bool ctx = u < CTXL;
    if (ctx && skip_ctx) return;
    __shared__ float red[4];
    __shared__ float lg[4][16];
    const float* xr = ctx ? xc + ((size_t)b * CTXL + u) * DM : xl + ((size_t)b * SEQ + (u - CTXL)) * DM;
    float v[4]; float ss = 0.f;
    for (int i = 0; i < 4; ++i) { v[i] = xr[tid + 256 * i]; ss += v[i] * v[i]; }
    ss = block_sum256(ss, red);
    const float rstd = rsqrtf(ss * (1.f / DM) + EPS);
    const float* md = MODl + (size_t)(ctx ? 8 : b) * 6144;
    float h[4];
    for (int i = 0; i < 4; ++i) { const int col = tid + 256 * i; h[i] = v[i] * rstd * nw[col] * (1.f + md[sc * 1024 + col]) + md[sh * 1024 + col]; ACT[(size_t)row * DM + col] = f2bf(h[i]); }
    if (!do_router) return;
    float pl[16];
    for (int e = 0; e < 16; ++e) { float a = 0.f; for (int i = 0; i < 4; ++i) a += h[i] * router_w[(tid + 256 * i) * 16 + e]; pl[e] = a; }
    for (int e = 0; e < 16; ++e) { float a = pl[e]; for (int o = 32; o >= 1; o >>= 1) a += __shfl_xor(a, o); if ((tid & 63) == 0) lg[tid >> 6][e] = a; }
    __syncthreads();
    if (tid == 0) {
        float p[16], sel[16], mx = -1e30f, sum = 0.f;
        for (int e = 0; e < 16; ++e) { p[e] = lg[0][e] + lg[1][e] + lg[2][e] + lg[3][e]; mx = fmaxf(mx, p[e]); }
        for (int e = 0; e < 16; ++e) { p[e] = expf(p[e] - mx); sum += p[e]; }
        for (int e = 0; e < 16; ++e) { p[e] /= sum; sel[e] = p[e] + router_b[e]; }
        int best = 0; float bgs = -1e30f;
        for (int g = 0; g < 4; ++g) {
            float m1 = -1e30f, m2 = -1e30f;
            for (int k = 0; k < 4; ++k) { const float s = sel[4 * g + k]; if (s > m1) { m2 = m1; m1 = s; } else if (s > m2) m2 = s; }
            if (m1 + m2 > bgs) { bgs = m1 + m2; best = g; }
        }
        int i0 = 4 * best; for (int k = 1; k < 4; ++k) if (sel[4 * best + k] > sel[i0]) i0 = 4 * best + k;
        int i1 = -1; for (int k = 0; k < 4; ++k) { const int e = 4 * best + k; if (e == i0) continue; if (i1 < 0 || sel[e] > sel[i1]) i1 = e; }
        const float w0 = p[i0], w1 = p[i1], ws = w0 + w1;
        TOK_E[row * 2] = i0; TOK_E[row * 2 + 1] = i1; TOK_W[row * 2] = w0 / ws; TOK_W[row * 2 + 1] = w1 / ws;
        atomicAdd(&CNT[i0], 1u); atomicAdd(&CNT[i1], 1u);
    }
}

struct EpiIn { bf16* QKRAW; bf16* PA; bf16* MVT; bf16* NVT; float* GATES; const float* gate_b; };
struct EpiOut { const float* sl; const float* sc; float* dl; float* dc; const float* MODl; int skip_ctx; int pad; };

template <int MODE> __global__ void nv_gemm(const bf16* A, const float* W, int ldw, int N, int K, EpiIn ei, EpiOut eo) {
    __shared__ float As[16][65], Bs[16][64];
    const int tid = threadIdx.x, tx = tid & 15, ty = tid >> 4, row0 = blockIdx.y * 64, col0 = blockIdx.x * 64;
    float acc[4][4];
    for (int i = 0; i < 4; ++i) for (int j = 0; j < 4; ++j) acc[i][j] = 0.f;
    for (int kt = 0; kt < K; kt += 16) {
        for (int i = 0; i < 4; ++i) { const int idx = tid + 256 * i, m = idx >> 4, k = idx & 15; As[k][m] = bf2f(A[(size_t)(row0 + m) * K + kt + k]); }
        for (int i = 0; i < 4; ++i) { const int idx = tid + 256 * i, k = idx >> 6, n = idx & 63; Bs[k][n] = (col0 + n < N) ? W[(size_t)(kt + k) * ldw + col0 + n] : 0.f; }
        __syncthreads();
        for (int k = 0; k < 16; ++k) {
            float a[4], bb[4];
            for (int i = 0; i < 4; ++i) a[i] = As[k][ty * 4 + i];
            for (int j = 0; j < 4; ++j) bb[j] = Bs[k][tx * 4 + j];
            for (int i = 0; i < 4; ++i) for (int j = 0; j < 4; ++j) acc[i][j] += a[i] * bb[j];
        }
        __syncthreads();
    }
    for (int i = 0; i < 4; ++i) for (int j = 0; j < 4; ++j) {
        const int row = row0 + ty * 4 + i, n = col0 + tx * 4 + j; if (n >= N) continue;
        const float v = acc[i][j]; const int b = row / UT, u = row % UT;
        if (MODE == 0) {
            if (n < 512) ei.QKRAW[(size_t)row * 1024 + n] = f2bf(v);
            else if (n < 1024) ei.PA[(size_t)row * 1536 + (n - 512)] = f2bf(v);
            else if (n < 1536) ei.PA[(size_t)row * 1536 + 512 + (n - 1024)] = f2bf(v);
            else if (n < 2048) ei.QKRAW[(size_t)row * 1024 + 512 + (n - 1536)] = f2bf(v);
            else if (n < 2560) { const int c = n - 2048; ei.MVT[((size_t)(b * 4 + c / 128) * 128 + c % 128) * UTP + u] = f2bf(v); }
            else if (n < 2576) ei.GATES[(size_t)row * 16 + (n - 2560)] = v + ei.gate_b[n - 2560];
            else if (n < 3088) ei.PA[(size_t)row * 1536 + 1024 + (n - 2576)] = f2bf(v);
            else { const int c = n - 3088; ei.NVT[((size_t)(b * 8 + c / 64) * 64 + c % 64) * UTP + u] = f2bf(v); }
        } else {
            const bool ctx = u < CTXL; if (ctx && eo.skip_ctx) continue;
            const size_t off = ctx ? ((size_t)b * CTXL + u) * DM + n : ((size_t)b * SEQ + (u - CTXL)) * DM + n;
            const float md = eo.MODl[(size_t)(ctx ? 8 : b) * 6144 + 2 * 1024 + n];
            if (ctx) eo.dc[off] = eo.sc[off] + md * v; else eo.dl[off] = eo.sl[off] + md * v;
        }
    }
}

__device__ __forceinline__ float conv_silu(const bf16* QKRAW, int row, int u, int col, const float* cw, const float* cb) {
    const int lo = u < CTXL ? 0 : CTXL, hi = u < CTXL ? CTXL - 1 : UT - 1;
    float y = cb[col] + cw[1024 + col] * bf2f(QKRAW[(size_t)row * 1024 + col]);
    if (u > lo) y += cw[col] * bf2f(QKRAW[(size_t)(row - 1) * 1024 + col]);
    if (u < hi) y += cw[2048 + col] * bf2f(QKRAW[(size_t)(row + 1) * 1024 + col]);
    return silu_f(y);
}
__global__ void nv_prep(const bf16* QKRAW, const float* cw, const float* cb, bf16* QP, bf16* KP, bf16* KPT) {
    const size_t gid = (size_t)blockIdx.x * 256 + threadIdx.x;
    const int row = (int)(gid >> 10), col = (int)(gid & 1023), b = row / UT, u = row % UT;
    const int c = col & 511, head = c >> 7, d = c & 127;
    float val = conv_silu(QKRAW, row, u, col, cw, cb);
    if (u >= CTXL) {
        const int t = u - CTXL, blk = d >> 6, dd = d & 63, i = dd & 31;
        const float pos = (float)(blk == 0 ? (t >> 6) : (t & 63));
        const float inv = powf(10000.f, -(float)(2 * i) / 64.f);
        const float ang = pos * inv, cs = cosf(ang), sn = sinf(ang);
        const float pv = conv_silu(QKRAW, row, u, dd < 32 ? col + 32 : col - 32, cw, cb);
        val = dd < 32 ? val * cs - pv * sn : pv * sn + val * cs;
    }
    if (col < 512) QP[(size_t)row * 512 + c] = f2bf(val);
    else { val *= 0.08838834764831845f; KP[(size_t)row * 512 + c] = f2bf(val); KPT[((size_t)(b * 4 + head) * 128 + d) * UTP + u] = f2bf(val); }
}

__device__ __forceinline__ int u_of(int dir, int j, int s) {
    if (dir == 0) return 128 * j + s;
    return j < 2 ? 255 - (128 * j + s) : UT - 1 - 128 * (j - 2) - s;
}
__global__ void nv_scan(const bf16* KP, const bf16* MVT, const float* GATES, bf16* CST, float* NST, float* MST) {
    const int chain = blockIdx.x, b = chain >> 3, h = (chain >> 1) & 3, dir = chain & 1, tid = threadIdx.x;
    const int dk = tid & 127, dv = blockIdx.y * 2 + (tid >> 7);
    __shared__ float wt[128], lf[128], ig[128], scal[2];
    __shared__ int us[128];
    float C = 0.f, n = 0.f;
    if (tid == 0) scal[1] = 0.f;
    __syncthreads();
    for (int j = 0; j < NCHUNK; ++j) {
        CST[((size_t)(chain * NCHUNK + j) * 128 + dv) * 128 + dk] = f2bf(C);
        if (blockIdx.y == 0 && tid < 128) NST[(size_t)(chain * NCHUNK + j) * 128 + dk] = n;
        if (blockIdx.y == 0 && tid == 0) MST[chain * NCHUNK + j] = scal[1];
        if (tid < 128) { const int u = u_of(dir, j, tid); us[tid] = u; const size_t row = (size_t)b * UT + u;
            lf[tid] = logsig_f(GATES[row * 16 + (2 * dir + 1) * 4 + h]); ig[tid] = GATES[row * 16 + (2 * dir) * 4 + h]; }
        __syncthreads();
        if (tid == 0) {
            float run = 0.f; for (int s = 0; s < 128; ++s) { run += lf[s]; lf[s] = run; }
            const float bend = run; float gmax = -1e30f;
            for (int s = 0; s < 128; ++s) { const float g = bend - lf[s] + ig[s]; ig[s] = g; gmax = fmaxf(gmax, g); }
            const float m = scal[1], mn = fmaxf(bend + m, gmax);
            scal[0] = expf(bend + m - mn); scal[1] = mn;
            for (int s = 0; s < 128; ++s) wt[s] = expf(ig[s] - mn);
        }
        __syncthreads();
        const float wo = scal[0]; float accC = 0.f, accn = 0.f;
        for (int s = 0; s < 128; ++s) { const int u = us[s]; const float kk = wt[s] * bf2f(KP[((size_t)b * UT + u) * 512 + h * 128 + dk]);
            accC += kk * bf2f(MVT[((size_t)(b * 4 + h) * 128 + dv) * UTP + u]); accn += kk; }
        C = wo * C + accC; n = wo * n + accn;
        __syncthreads();
    }
}

__global__ void nv_mout(const bf16* QP, const bf16* KP, const bf16* MVT, const float* GATES, const bf16* CST, const float* NST, const float* MST, float* HSUM, int last) {
    const int c = blockIdx.x, bh = blockIdx.y, b = bh >> 2, h = bh & 3, tid = threadIdx.x;
    if (last && c < 2) return;
    extern __shared__ float sm[];
    float* S = sm; float* bb = S + 128 * 129; float* ig = bb + 128; float* den = ig + 128; float* wint = den + 128;
    const int p = tid & 127, half = tid >> 7;
    for (int dir = 0; dir < 2; ++dir) {
        const int j = dir == 0 ? c : (c < 2 ? 1 - c : 35 - c), chain = (b * 4 + h) * 2 + dir;
        if (tid < 128) { const int tau = tid, pp = dir ? 127 - tau : tau; const size_t row = (size_t)b * UT + 128 * c + tau;
            bb[pp] = logsig_f(GATES[row * 16 + (2 * dir + 1) * 4 + h]); ig[pp] = GATES[row * 16 + (2 * dir) * 4 + h]; }
        __syncthreads();
        if (tid == 0) { float run = 0.f; for (int s = 0; s < 128; ++s) { run += bb[s]; bb[s] = run; } }
        __syncthreads();
        const float m = MST[chain * NCHUNK + j];
        const size_t rowp = (size_t)b * UT + 128 * c + (dir ? 127 - p : p);
        const bf16* qrow = QP + rowp * 512 + h * 128;
        for (int p2 = 64 * half; p2 < 64 * half + 64; ++p2) {
            if (p2 > p) continue;
            const bf16* krow = KP + ((size_t)b * UT + 128 * c + (dir ? 127 - p2 : p2)) * 512 + h * 128;
            float dot = 0.f; for (int d = 0; d < 128; ++d) dot += bf2f(qrow[d]) * bf2f(krow[d]);
            S[p * 129 + p2] = dot;
        }
        __syncthreads();
        if (tid < 128) {
            const float inter = bb[p] + m; float mx = inter;
            for (int p2 = 0; p2 <= p; ++p2) mx = fmaxf(mx, bb[p] - bb[p2] + ig[p2]);
            float sum = 0.f;
            for (int p2 = 0; p2 <= p; ++p2) { const float dd = expf(bb[p] - bb[p2] + ig[p2] - mx); const float sv = S[p * 129 + p2] * dd; S[p * 129 + p2] = sv; sum += sv; }
            const float wi = expf(inter - mx);
            float qn = 0.f; const float* nn = NST + (size_t)(chain * NCHUNK + j) * 128;
            for (int d = 0; d < 128; ++d) qn += bf2f(qrow[d]) * nn[d];
            qn = sum + wi * qn;
            den[p] = fmaxf(fabsf(qn), expf(-mx)); wint[p] = wi;
        }
        __syncthreads();
        for (int dv = 64 * half; dv < 64 * half + 64; ++dv) {
            const bf16* vt = MVT + ((size_t)(b * 4 + h) * 128 + dv) * UTP + 128 * c;
            float acc = 0.f;
            for (int p2 = 0; p2 <= p; ++p2) acc += S[p * 129 + p2] * bf2f(vt[dir ? 127 - p2 : p2]);
            const bf16* cc = CST + ((size_t)(chain * NCHUNK + j) * 128 + dv) * 128;
            float qc = 0.f; for (int d = 0; d < 128; ++d) qc += bf2f(qrow[d]) * bf2f(cc[d]);
            const float hv = (acc + wint[p] * qc) / den[p];
            float* o = HSUM + rowp * 512 + h * 128 + dv;
            if (dir == 0) *o = hv; else *o += hv;
        }
        __syncthreads();
    }
}

__global__ void nv_mnorm(const float* HSUM, const bf16* PA, const float* mnw, bf16* ACT, int skip_ctx) {
    const int row = blockIdx.x, u = row % UT, h = threadIdx.x >> 6, lane = threadIdx.x & 63;
    if (u < CTXL && skip_ctx) return;
    const float a = HSUM[(size_t)row * 512 + h * 128 + lane], bq = HSUM[(size_t)row * 512 + h * 128 + 64 + lane];
    float ss = a * a + bq * bq; for (int o = 32; o >= 1; o >>= 1) ss += __shfl_xor(ss, o);
    const float rstd = rsqrtf(ss * (1.f / 128.f) + EPS);
    for (int k = 0; k < 2; ++k) { const int col = h * 128 + 64 * k + lane; const float v = (k ? bq : a) * rstd * mnw[col] * sigmoid_f(bf2f(PA[(size_t)row * 1536 + col]));
        ACT[(size_t)row * 1024 + col] = f2bf(v); }
}

__global__ void nv_na(const bf16* PA, const bf16* NVT, const float* rpb, bf16* ACT, int ctxq) {
    const int tq = blockIdx.x, hd = blockIdx.y, b = blockIdx.z, tid = threadIdx.x;
    __shared__ float q[64], sc[384], red[4], o2[2][64];
    __shared__ int uk[384];
    const size_t rowq = (size_t)b * UT + (ctxq ? tq : CTXL + tq);
    if (tid < 64) q[tid] = bf2f(PA[rowq * 1536 + 512 + hd * 64 + tid]) * 0.125f;
    __syncthreads();
    const int nkeys = ctxq ? 256 : 384;
    for (int key = tid; key < nkeys; key += 128) {
        int uu; float bias = 0.f;
        if (!ctxq && key < 128) { const int i = key >> 4, j = key & 15, r = tq >> 6, c = tq & 63;
            const int rs = min(max(r - 4, 0), 56), cs = min(max(c - 8, 0), 48);
            uu = CTXL + (rs + i) * 64 + cs + j; bias = rpb[(hd * 15 + (rs + i - r + 7)) * 31 + (cs + j - c + 15)]; }
        else uu = ctxq ? key : key - 128;
        const bf16* kr = PA + ((size_t)b * UT + uu) * 1536 + 1024 + hd * 64;
        float dot = 0.f; for (int d = 0; d < 64; ++d) dot += q[d] * bf2f(kr[d]);
        sc[key] = dot + bias; uk[key] = uu;
    }
    __syncthreads();
    float mx = -1e30f; for (int key = tid; key < nkeys; key += 128) mx = fmaxf(mx, sc[key]);
    for (int o = 32; o >= 1; o >>= 1) mx = fmaxf(mx, __shfl_xor(mx, o));
    if ((tid & 63) == 0) red[tid >> 6] = mx;
    __syncthreads();
    mx = fmaxf(red[0], red[1]);
    float sum = 0.f; for (int key = tid; key < nkeys; key += 128) { const float e = expf(sc[key] - mx); sc[key] = e; sum += e; }
    for (int o = 32; o >= 1; o >>= 1) sum += __shfl_xor(sum, o);
    __syncthreads();
    if ((tid & 63) == 0) red[2 + (tid >> 6)] = sum;
    __syncthreads();
    sum = red[2] + red[3];
    const int dv = tid & 63, part = tid >> 6; const bf16* vt = NVT + ((size_t)(b * 8 + hd) * 64 + dv) * UTP;
    float acc = 0.f; for (int key = part * (nkeys / 2); key < (part + 1) * (nkeys / 2); ++key) acc += sc[key] * bf2f(vt[uk[key]]);
    o2[part][dv] = acc;
    __syncthreads();
    if (tid < 64) ACT[rowq * 1024 + 512 + hd * 64 + tid] = f2bf((o2[0][tid] + o2[1][tid]) / sum);
}

__global__ void nv_slots_off(unsigned* CTL, int* SLOT_TOK, float* SLOT_W, int* TILE_E, int lo) {
    __shared__ unsigned off[17];
    if (threadIdx.x == 0) { unsigned o = 0; for (int e = 0; e < 16; ++e) { off[e] = o; CTL[CW_OFF + lo + e] = o; o += (CTL[CW_CNT + lo + e] + 255u) & ~255u; CTL[CW_CUR + lo + e] = 0u; } off[16] = o; CTL[CW_OFF + lo + 16] = o; CTL[CW_NT + lo] = o >> 8; }
    __syncthreads();
    for (int e = 0; e < 16; ++e) {
        const unsigned cnt = CTL[CW_CNT + lo + e];
        for (unsigned i = off[e] + cnt + threadIdx.x; i < off[e + 1]; i += blockDim.x) { SLOT_TOK[i] = 0; SLOT_W[i] = 0.f; }
        for (unsigned t = (off[e] >> 8) + threadIdx.x; t < (off[e + 1] >> 8); t += blockDim.x) TILE_E[t] = e;
    }
}
__global__ void nv_slots_assign(unsigned* CTL, const int* TOK_E, const float* TOK_W, int* TOK_SLOT, int* SLOT_TOK, float* SLOT_W, int skip_ctx, int lo) {
    const int row = blockIdx.x * 256 + threadIdx.x; if (row >= MROWS) return;
    if ((row % UT) < CTXL && skip_ctx) return;
    for (int k = 0; k < 2; ++k) { const int e = TOK_E[row * 2 + k]; const unsigned pos = atomicAdd(&CTL[CW_CUR + lo + e], 1u); const int slot = (int)(CTL[CW_OFF + lo + e] + pos);
        SLOT_TOK[slot] = row; SLOT_W[slot] = TOK_W[row * 2 + k]; TOK_SLOT[row * 2 + k] = slot; }
}
__global__ void nv_moe1(const unsigned* CTL, const bf16* ACT, const int* SLOT_TOK, const float* SLOT_W, const int* TILE_E, const float* w1, const float* w3, bf16* ACTM, int lo) {
    const int slot = blockIdx.x, tid = threadIdx.x; if ((unsigned)slot >= CTL[CW_OFF + lo + 16]) return;
    const float w = SLOT_W[slot]; if (w == 0.f) return;
    const int e = TILE_E[slot >> 8], tok = SLOT_TOK[slot];
    __shared__ float t[1024];
    for (int k = tid; k < 1024; k += 256) t[k] = bf2f(ACT[(size_t)tok * 1024 + k]);
    __syncthreads();
    const float* a1 = w1 + (size_t)e * 1024 * 512; const float* a3 = w3 + (size_t)e * 1024 * 512;
    for (int cc = 0; cc < 2; ++cc) { const int col = tid + 256 * cc; float g1 = 0.f, g3 = 0.f;
        for (int k = 0; k < 1024; ++k) { g1 += t[k] * a1[(size_t)k * 512 + col]; g3 += t[k] * a3[(size_t)k * 512 + col]; }
        ACTM[(size_t)slot * 512 + col] = f2bf(silu_f(g1) * g3); }
}
__global__ void nv_moe2(const unsigned* CTL, const bf16* ACTM, const float* SLOT_W, const int* TILE_E, const float* w2, bf16* Y, int lo) {
    const int slot = blockIdx.x, tid = threadIdx.x; if ((unsigned)slot >= CTL[CW_OFF + lo + 16]) return;
    if (SLOT_W[slot] == 0.f) return;
    const int e = TILE_E[slot >> 8];
    __shared__ float a[512];
    for (int k = tid; k < 512; k += 256) a[k] = bf2f(ACTM[(size_t)slot * 512 + k]);
    __syncthreads();
    const float* ww = w2 + (size_t)e * 512 * 1024;
    for (int cc = 0; cc < 4; ++cc) { const int col = tid + 256 * cc; float acc = 0.f; for (int k = 0; k < 512; ++k) acc += a[k] * ww[(size_t)k * 1024 + col]; Y[(size_t)slot * 1024 + col] = f2bf(acc); }
}
__global__ void nv_combine(float* xl, float* xc, const float* MODl, const int* TOK_SLOT, const float* TOK_W, const bf16* Y, int skip_ctx) {
    const int row = blockIdx.x, b = row / UT, u = row % UT, tid = threadIdx.x; const bool ctx = u < CTXL;
    if (ctx && skip_ctx) return;
    float* xr = ctx ? xc + ((size_t)b * CTXL + u) * DM : xl + ((size_t)b * SEQ + (u - CTXL)) * DM;
    const int s0 = TOK_SLOT[row * 2], s1 = TOK_SLOT[row * 2 + 1]; const float w0 = TOK_W[row * 2], w1 = TOK_W[row * 2 + 1]; const float* md = MODl + (size_t)(ctx ? 8 : b) * 6144 + 5 * 1024;
    for (int i = 0; i < 4; ++i) { const int col = tid + 256 * i; xr[col] += md[col] * (w0 * bf2f(Y[(size_t)s0 * 1024 + col]) + w1 * bf2f(Y[(size_t)s1 * 1024 + col])); }
}
__global__ void nv_final(float* xl, const float* fw) {
    const int row = blockIdx.x, tid = threadIdx.x; __shared__ float red[4];
    float* xr = xl + (size_t)row * DM; float v[4]; float ss = 0.f;
    for (int i = 0; i < 4; ++i) { v[i] = xr[tid + 256 * i]; ss += v[i] * v[i]; }
    ss = block_sum256(ss, red); const float rstd = rsqrtf(ss * (1.f / DM) + EPS);
    for (int i = 0; i < 4; ++i) xr[tid + 256 * i] = v[i] * rstd * fw[tid + 256 * i];
}

constexpr int CW_DEP = 1300;
constexpr size_t WS_X16 = WS_ACT;
#define LAS __attribute__((address_space(3)))
#define GAS __attribute__((address_space(1)))
constexpr int NWAVES = 8, NTHR = 512;
constexpr int RING_BYTES = 131072, SCR_BYTES = 147456, LDSCTL_OFF = SCR_BYTES, MISC_OFF = LDSCTL_OFF + 320, LDS_BYTES = 163840;
constexpr size_t WS_EW13_L1 = 462 * MiB, WS_EW2_L1 = 494 * MiB;
constexpr int CW_CONV = 16;
constexpr size_t WS_EW13 = 102 * MiB;
constexpr size_t WS_EW2 = 134 * MiB;
constexpr size_t WS_AG = 366 * MiB;
constexpr size_t WS_PARTO = WS_KPT;
constexpr size_t WS_PARTM = 447 * MiB;
constexpr size_t WS_GA = 458 * MiB;
constexpr int CW_BAR = 4096;
constexpr int N_BAR_REGIONS = 24;
constexpr int PH_PRO = 0, PH_FINAL = 21, NPHASE = 22;
constexpr int K_NORM1 = 0, K_GEMM_IN = 1, K_PREP = 2, K_SCAN = 3, K_MIX = 4, K_GEMM_OUT = 5, K_NORM2 = 6, K_SLOTS = 7, K_MOE1 = 8, K_MOE2 = 9;

typedef float f32x4 __attribute__((ext_vector_type(4)));
typedef float f32x2 __attribute__((ext_vector_type(2)));
typedef unsigned u32x4 __attribute__((ext_vector_type(4)));
typedef unsigned u32x2 __attribute__((ext_vector_type(2)));
typedef short bf16x8 __attribute__((ext_vector_type(8)));
#define LDS_WAIT() asm volatile("s_waitcnt lgkmcnt(0)" ::: "memory")
#define VM_WAIT() asm volatile("s_waitcnt vmcnt(0)" ::: "memory")
__device__ __forceinline__ unsigned cvt_pk_bf16(float lo, float hi) { unsigned r; asm volatile("v_cvt_pk_bf16_f32 %0, %1, %2" : "=v"(r) : "v"(lo), "v"(hi)); return r; }
__device__ __forceinline__ unsigned ld_u32(const unsigned* p) { return __hip_atomic_load(p, __ATOMIC_RELAXED, __HIP_MEMORY_SCOPE_AGENT); }
__device__ __forceinline__ int ld_i32(const int* p) { return __hip_atomic_load(p, __ATOMIC_RELAXED, __HIP_MEMORY_SCOPE_AGENT); }
__device__ __forceinline__ float ld_f32(const float* p) { return __uint_as_float(__hip_atomic_load((const unsigned*)p, __ATOMIC_RELAXED, __HIP_MEMORY_SCOPE_AGENT)); }
__device__ __forceinline__ int lane_id() { int l; asm volatile("v_mbcnt_lo_u32_b32 %0, -1, 0\n\tv_mbcnt_hi_u32_b32 %0, -1, %0" : "=v"(l)); return l; }
template <int CTRL> __device__ __forceinline__ float dpp_f(float v) { return __int_as_float(__builtin_amdgcn_update_dpp(0, __float_as_int(v), CTRL, 0xF, 0xF, true)); }
__device__ __forceinline__ float red16_add(float v) { const auto r = __builtin_amdgcn_permlane16_swap(__float_as_uint(v), __float_as_uint(v), false, false); return __uint_as_float(r[0]) + __uint_as_float(r[1]); }
__device__ __forceinline__ float red32_add(float v) { const auto r = __builtin_amdgcn_permlane32_swap(__float_as_uint(v), __float_as_uint(v), false, false); return __uint_as_float(r[0]) + __uint_as_float(r[1]); }
__device__ __forceinline__ float red16_max(float v) { const auto r = __builtin_amdgcn_permlane16_swap(__float_as_uint(v), __float_as_uint(v), false, false); return fmaxf(__uint_as_float(r[0]), __uint_as_float(r[1])); }
__device__ __forceinline__ float red32_max(float v) { const auto r = __builtin_amdgcn_permlane32_swap(__float_as_uint(v), __float_as_uint(v), false, false); return fmaxf(__uint_as_float(r[0]), __uint_as_float(r[1])); }
__device__ __forceinline__ float red_hi_add(float v) { return red32_add(red16_add(v)); }
__device__ __forceinline__ float red_hi_max(float v) { return red32_max(red16_max(v)); }
__device__ __forceinline__ float wave_sum(float v) {
    v += dpp_f<0xB1>(v);
    v += dpp_f<0x4E>(v);
    v += dpp_f<0x141>(v);
    v += dpp_f<0x140>(v);
    return red_hi_add(v);
}
__device__ __forceinline__ float fast_silu(float v) { return v * __builtin_amdgcn_rcpf(1.f + __expf(-v)); }
__device__ __forceinline__ void st_wt16(void* p, u32x4 v) { asm volatile("global_store_dwordx4 %0, %1, off sc1\n\ts_nop 1" : : "v"(p), "v"(v) : "memory"); }
__device__ __forceinline__ void st_wt8(void* p, u32x2 v) { asm volatile("global_store_dwordx2 %0, %1, off sc1" : : "v"(p), "v"(v) : "memory"); }
__device__ __forceinline__ void st_sel16(void* p, u32x4 v, bool wt) { if (wt) st_wt16(p, v); else *(u32x4*)p = v; }
__device__ __forceinline__ void st_sel8(void* p, u32x2 v, bool wt) { if (wt) st_wt8(p, v); else *(u32x2*)p = v; }

#define XB_TMO      128
#define XB_XCNT(j)  (256  + 64 * (j))
#define XB_XSUB(j)  (1280 + 64 * (j))
#define XB_XGEN(j)  (2304 + 64 * (j))
#define XB_TOP      3328
#define XB_TOPGEN   3392
#define XCD_BAR_WORDS 3456
#define XB_SPIN_CAP (1u << 18)
__device__ __forceinline__ unsigned xb_ld(unsigned* p)              { return __hip_atomic_load(p, __ATOMIC_RELAXED, __HIP_MEMORY_SCOPE_AGENT); }
__device__ __forceinline__ unsigned xb_add(unsigned* p, unsigned v) { return __hip_atomic_fetch_add(p, v, __ATOMIC_RELAXED, __HIP_MEMORY_SCOPE_AGENT); }
__device__ __forceinline__ unsigned xb_xcc_id() { return (unsigned)__builtin_amdgcn_s_getreg((3 << 11) | 20) & 0xFu; }
#define XB_SPIN(cond, bar) do { unsigned _sp = 0; while (cond) { __builtin_amdgcn_s_sleep(1); \
    if ((++_sp & 255u) == 0u) { if (xb_ld(&(bar)[XB_TMO])) break; if (_sp > XB_SPIN_CAP) { atomicAdd(&(bar)[XB_TMO], 1u); break; } } } } while (0)
struct XcdBarrier { unsigned* bar; unsigned x; volatile LAS unsigned* st; };
__device__ __forceinline__ XcdBarrier xcd_barrier_post(unsigned* bar, volatile LAS unsigned* st, bool leader) {
    XcdBarrier b; b.bar = bar; b.x = xb_xcc_id(); b.st = st;
    if (leader) (void)xb_add(&bar[XB_XCNT(b.x)], 1u);
    return b;
}
__device__ __forceinline__ void xcd_barrier_complete(unsigned* bar, unsigned x, unsigned& nloc, unsigned& nx) {
    const unsigned G = gridDim.x * gridDim.y * gridDim.z;
    unsigned sum, cnt, mine, sp = 0u;
    for (;;) {
        sum = 0u; cnt = 0u;
#pragma unroll
        for (unsigned j = 0; j < 16; ++j) { const unsigned c = xb_ld(&bar[XB_XCNT(j)]); sum += c; cnt += (c > 0u) ? 1u : 0u; }
        mine = xb_ld(&bar[XB_XCNT(x)]);
        if (sum == G) break;
        __builtin_amdgcn_s_sleep(1);
        if ((++sp & 255u) == 0u) { if (xb_ld(&bar[XB_TMO])) break; if (sp > XB_SPIN_CAP) { atomicAdd(&bar[XB_TMO], 1u); break; } }
    }
    nloc = mine > 0u ? mine : 1u; nx = cnt > 0u ? cnt : 1u;
}
__device__ __forceinline__ void xcd_barrier(const XcdBarrier& b, bool leader) {
    asm volatile("s_waitcnt vmcnt(0)" ::: "memory");
    __syncthreads();
    if (leader) {
        unsigned* bar = b.bar;
        __builtin_amdgcn_s_waitcnt(0);
        unsigned nloc = b.st[0], nx = b.st[1];
        if (nloc == 0u) { xcd_barrier_complete(bar, b.x, nloc, nx); b.st[0] = nloc; b.st[1] = nx; }
        const unsigned old = xb_add(&bar[XB_XSUB(b.x)], 1u);
        const unsigned gen = old / nloc;
        __builtin_amdgcn_fence(__ATOMIC_ACQUIRE, "agent");
        if (old + 1u == (gen + 1u) * nloc) {
            __builtin_amdgcn_fence(__ATOMIC_RELEASE, "agent");
            asm volatile("s_waitcnt vmcnt(0)" ::: "memory");
            const unsigned og = xb_add(&bar[XB_TOP], 1u);
            const unsigned tg = og / nx;
            if (og + 1u == (tg + 1u) * nx) xb_add(&bar[XB_TOPGEN], 1u);
            else XB_SPIN(xb_ld(&bar[XB_TOPGEN]) == tg, bar);
            asm volatile("s_waitcnt vmcnt(0)" ::: "memory");
        } else {
            XB_SPIN(xb_ld(&bar[XB_TOPGEN]) == gen, bar);
            asm volatile("s_waitcnt vmcnt(0)" ::: "memory");
        }
    }
    __syncthreads();
}

namespace pg8 {
constexpr int BM = 256, BK = 64, HALF = 128, HTB = HALF * BK * 2, STAGE_BYTES = 8 * HTB, NXCD = 8, WGM = 8;
__host__ __device__ __forceinline__ int lds_byte(int r, int c) { const int st = (r >> 4) * 2 + (c >> 5), rr = r & 15, cc = c & 31, ob = rr * 64 + cc * 2; return st * 1024 + (ob ^ (((ob >> 9) & 1) << 5)); }
__host__ __device__ __forceinline__ void stage_rc(int b, int& R, int& C) { const int st = b / 1024, sb = b % 1024, swz = sb ^ (((sb >> 9) & 1) << 5); R = (st >> 1) * 16 + swz / 64; C = (st & 1) * 32 + (swz % 64) / 2; }
__host__ __device__ __forceinline__ int perm32(int rho) { const int n = rho >> 4, i = rho & 15; return 8 * (i >> 2) + 4 * n + (i & 3); }
struct Unit { int pm, pn; const char* A; const char* B; };
struct GridOrder {
    int nM, nN, nwg, G, c;
    __device__ void init(int nM_, int nN_, int G_, int c_) { nM = nM_; nN = nN_; nwg = nM * nN; G = G_; c = c_; }
    __device__ bool map(int i, int& pm, int& pn) const { return mapL((long)i * G + c, pm, pn); }
    __device__ bool mapL(const long L, int& pm, int& pn) const {
        if (L >= nwg) return false;
        int wgid = (int)L; { const int q = nwg / NXCD, r = nwg % NXCD, xcd = wgid % NXCD, off = wgid / NXCD; wgid = (xcd < r ? xcd * (q + 1) : r * (q + 1) + (xcd - r) * q) + off; }
        const int nig = WGM * nN, gid = wgid / nig, fm = gid * WGM, gsz = (nM - fm) < WGM ? (nM - fm) : WGM;
        pm = fm + ((wgid % nig) % gsz); pn = (wgid % nig) / gsz; return true;
    }
};
template <class Epi, class Sched, bool ALIGN_EPI = true, bool SP2 = true, bool GATHER = false>
__device__ __forceinline__ void gemm_phase(LAS unsigned char* lds, const int K, const Sched& S, const Epi& E, const int wave_) {
    int tid_ = wave_ * 64 + lane_id(); asm volatile("" : "+v"(tid_));
    const int tid = tid_, wid = __builtin_amdgcn_readfirstlane(tid >> 6), lane = tid & 63, wr = wid >> 2, wc = wid & 3, fr = lane & 15, fq = lane >> 4;
    const int nt = K / BK;
    static_assert(!GATHER || SP2, "row gather is implemented for the SP2 loop");
    unsigned voffA[2], voffB[2]; int Rr[2]; unsigned Cb[2];
#pragma unroll
    for (int i = 0; i < 2; ++i) { int R, C; stage_rc(tid * 16 + i * 8192, R, C); const int Rb = Epi::PERM ? ((R & ~31) + perm32(R & 31)) : R;
        voffA[i] = (unsigned)(R * K + C) * 2u; voffB[i] = (unsigned)(Rb * K + C) * 2u; Rr[i] = R; Cb[i] = (unsigned)C * 2u; }
    const size_t kstep = (size_t)(BK * 2);
    const size_t hstep = (size_t)HALF * K * 2;
    unsigned gA[2][2], gN[2][2];
    const unsigned ldsw = (unsigned)wid * 1024u;
    const int aoff = lds_byte(wr * 64 + fr, fq * 8), boff = lds_byte(wc * 32 + fr, fq * 8);
#define PG8_SA(b, h) (((b) * 2 + (h)) * HTB)
#define PG8_SB(b, h) ((4 + (b) * 2 + (h)) * HTB)
#define PG8_STAGE(bufoff, gbase, voff) do { _Pragma("unroll") for (int _i = 0; _i < 2; ++_i) \
        __builtin_amdgcn_global_load_lds((const unsigned*)((const char*)(gbase) + (voff)[_i]), (LAS unsigned*)(lds + (bufoff) + ldsw + _i * 8192), 16, 0, 0); } while (0)
#define PG8_LDA(dst, b, h) do { _Pragma("unroll") for (int m = 0; m < 4; ++m) _Pragma("unroll") for (int k = 0; k < 2; ++k) dst[m][k] = *(const LAS bf16x8*)(lds + PG8_SA(b, h) + aoff + m * 2048 + k * 1024); } while (0)
#define PG8_LDB(dst, b, h) do { _Pragma("unroll") for (int n = 0; n < 2; ++n) _Pragma("unroll") for (int k = 0; k < 2; ++k) dst[n][k] = *(const LAS bf16x8*)(lds + PG8_SB(b, h) + boff + n * 2048 + k * 1024); } while (0)
#define PG8_MMA(ai, bj, At, Bt) do { __builtin_amdgcn_s_setprio(1); _Pragma("unroll") for (int m = 0; m < 4; ++m) _Pragma("unroll") for (int n = 0; n < 2; ++n) _Pragma("unroll") for (int k = 0; k < 2; ++k) \
        acc[ai][bj][m][n] = __builtin_amdgcn_mfma_f32_16x16x32_bf16(Bt[n][k], At[m][k], acc[ai][bj][m][n], 0, 0, 0); __builtin_amdgcn_s_setprio(0); } while (0)
#define PG8_WAIT_V(n) asm volatile("s_waitcnt vmcnt(" #n ")" ::: "memory")
#define PG8_WAIT_L(n) asm volatile("s_waitcnt lgkmcnt(" #n ")" ::: "memory")
#define PG8_BAR __builtin_amdgcn_s_barrier()
#define PG8_SCHED __builtin_amdgcn_sched_barrier(0)
    Unit cur, nxt; int ui = 0;
    if (!S.next(0, cur)) return;
    f32x4 acc[2][2][4][2];
#pragma unroll
    for (int a = 0; a < 2; ++a)
#pragma unroll
        for (int b = 0; b < 2; ++b)
#pragma unroll
            for (int m = 0; m < 4; ++m)
#pragma unroll
                for (int n = 0; n < 2; ++n) acc[a][b][m][n] = (f32x4){0.f, 0.f, 0.f, 0.f};
    bf16x8 At[4][2], B0[2][2], B1[2][2];
    const char* cA = cur.A; const char* cB = cur.B;
#pragma unroll
    for (int h = 0; h < 2; ++h)
#pragma unroll
        for (int i = 0; i < 2; ++i) { if constexpr (GATHER) gA[h][i] = (unsigned)S.arow(cur, h * HALF + Rr[i]) * (unsigned)(K * 2) + Cb[i]; else gA[h][i] = voffA[i] + (unsigned)(h * hstep); gN[h][i] = gA[h][i]; }
    if constexpr (SP2) {
        PG8_STAGE(PG8_SB(0, 0), cB, voffB); PG8_STAGE(PG8_SB(0, 1), cB + hstep, voffB); PG8_STAGE(PG8_SA(0, 0), cA, gA[0]); PG8_STAGE(PG8_SA(0, 1), cA, gA[1]);
        if (wr == 1) PG8_BAR;
        PG8_WAIT_V(2); PG8_BAR;
        PG8_STAGE(PG8_SB(1, 0), cB + kstep, voffB); PG8_STAGE(PG8_SA(1, 0), cA + kstep, gA[0]); PG8_STAGE(PG8_SB(1, 1), cB + hstep + kstep, voffB);
        PG8_WAIT_V(6); PG8_BAR;
    } else {
        PG8_STAGE(PG8_SB(0, 0), cB, voffB); PG8_STAGE(PG8_SA(0, 0), cA, voffA); PG8_STAGE(PG8_SB(0, 1), cB + hstep, voffB); PG8_STAGE(PG8_SA(0, 1), cA + hstep, voffA);
        if (wr == 1) PG8_BAR;
        PG8_WAIT_V(4); PG8_BAR;
        PG8_STAGE(PG8_SB(1, 0), cB + kstep, voffB); PG8_STAGE(PG8_SA(1, 0), cA + kstep, voffA); PG8_STAGE(PG8_SB(1, 1), cB + hstep + kstep, voffB);
        PG8_WAIT_V(6); PG8_BAR;
    }
    for (;;) {
        const bool has_next = S.next(ui + 1, nxt);
        const char* nA = has_next ? nxt.A : cA; const char* nB = has_next ? nxt.B : cB;
        if constexpr (GATHER) { if (has_next) {
#pragma unroll
            for (int h = 0; h < 2; ++h)
#pragma unroll
                for (int i = 0; i < 2; ++i) gN[h][i] = (unsigned)S.arow(nxt, h * HALF + Rr[i]) * (unsigned)(K * 2) + Cb[i]; } }
        for (int t = 0; t < nt; t += 2) {
            const bool last = (t == nt - 2);
            const char* a1 = cA + (size_t)(t + 1) * kstep;
            const char* a2 = last ? nA : cA + (size_t)(t + 2) * kstep; const char* b2 = last ? nB : cB + (size_t)(t + 2) * kstep;
            const char* a3 = a2 + kstep; const char* b3 = b2 + kstep;
            if constexpr (SP2) {
            unsigned g2[2][2];
#pragma unroll
            for (int h = 0; h < 2; ++h)
#pragma unroll
                for (int i = 0; i < 2; ++i) g2[h][i] = last ? gN[h][i] : gA[h][i];
            PG8_LDB(B0, 0, 0); PG8_LDB(B1, 0, 1); PG8_SCHED; PG8_LDA(At, 0, 0); PG8_STAGE(PG8_SA(1, 1), a1, gA[1]);
            PG8_WAIT_V(8); PG8_WAIT_L(0); PG8_BAR; PG8_MMA(0, 0, At, B0); PG8_MMA(0, 1, At, B1); PG8_BAR; PG8_SCHED;
            PG8_LDA(At, 0, 1); PG8_STAGE(PG8_SB(0, 0), b2, voffB); PG8_STAGE(PG8_SB(0, 1), b2 + hstep, voffB); PG8_STAGE(PG8_SA(0, 0), a2, g2[0]);
            PG8_WAIT_V(8); PG8_WAIT_L(0); PG8_BAR; PG8_MMA(1, 0, At, B0); PG8_MMA(1, 1, At, B1); PG8_BAR; PG8_SCHED;
            PG8_LDB(B0, 1, 0); PG8_LDB(B1, 1, 1); PG8_SCHED; PG8_LDA(At, 1, 0); PG8_STAGE(PG8_SA(0, 1), a2, g2[1]);
            PG8_WAIT_V(8); PG8_WAIT_L(0); PG8_BAR; PG8_MMA(0, 0, At, B0); PG8_MMA(0, 1, At, B1); PG8_BAR; PG8_SCHED;
            PG8_LDA(At, 1, 1); PG8_STAGE(PG8_SB(1, 0), b3, voffB); PG8_STAGE(PG8_SB(1, 1), b3 + hstep, voffB); PG8_STAGE(PG8_SA(1, 0), a3, g2[0]);
            PG8_WAIT_V(8); PG8_WAIT_L(0); PG8_BAR; PG8_MMA(1, 0, At, B0); PG8_MMA(1, 1, At, B1); PG8_BAR; PG8_SCHED;
            } else {
            PG8_LDB(B0, 0, 0); PG8_SCHED; PG8_LDA(At, 0, 0); PG8_STAGE(PG8_SA(1, 1), a1 + hstep, voffA);
            PG8_WAIT_L(8); PG8_BAR; PG8_WAIT_L(0); PG8_MMA(0, 0, At, B0); PG8_BAR; PG8_SCHED;
            PG8_LDB(B1, 0, 1); PG8_STAGE(PG8_SB(0, 0), b2, voffB);
            PG8_BAR; PG8_WAIT_L(0); PG8_MMA(0, 1, At, B1); PG8_BAR;
            PG8_LDA(At, 0, 1); PG8_STAGE(PG8_SA(0, 0), a2, voffA);
            PG8_BAR; PG8_WAIT_L(0); PG8_MMA(1, 0, At, B0); PG8_BAR; PG8_SCHED;
            PG8_STAGE(PG8_SB(0, 1), b2 + hstep, voffB);
            PG8_WAIT_V(6); PG8_BAR; PG8_MMA(1, 1, At, B1); PG8_BAR;
            PG8_LDB(B0, 1, 0); PG8_SCHED; PG8_LDA(At, 1, 0); PG8_STAGE(PG8_SA(0, 1), a2 + hstep, voffA);
            PG8_WAIT_L(8); PG8_BAR; PG8_WAIT_L(0); PG8_MMA(0, 0, At, B0); PG8_BAR; PG8_SCHED;
            PG8_LDB(B1, 1, 1); PG8_STAGE(PG8_SB(1, 0), b3, voffB);
            PG8_BAR; PG8_WAIT_L(0); PG8_MMA(0, 1, At, B1); PG8_BAR;
            PG8_LDA(At, 1, 1); PG8_STAGE(PG8_SA(1, 0), a3, voffA);
            PG8_BAR; PG8_WAIT_L(0); PG8_MMA(1, 0, At, B0); PG8_BAR; PG8_SCHED;
            PG8_STAGE(PG8_SB(1, 1), b3 + hstep, voffB);
            PG8_WAIT_V(6); PG8_BAR; PG8_MMA(1, 1, At, B1); PG8_BAR;
            }
        }
        if constexpr (ALIGN_EPI) { if (wr == 0) PG8_BAR; }
        E(acc, cur, wr, wc, fr, fq, !has_next);
        if (!has_next) break;
#pragma unroll
        for (int a = 0; a < 2; ++a)
#pragma unroll
            for (int b = 0; b < 2; ++b)
#pragma unroll
                for (int m = 0; m < 4; ++m)
#pragma unroll
                    for (int n = 0; n < 2; ++n) acc[a][b][m][n] = (f32x4){0.f, 0.f, 0.f, 0.f};
        cur = nxt; cA = nA; cB = nB; ++ui;
#pragma unroll
        for (int h = 0; h < 2; ++h)
#pragma unroll
            for (int i = 0; i < 2; ++i) gA[h][i] = gN[h][i];
        if constexpr (ALIGN_EPI) { if (wr == 1) PG8_BAR; }
    }
    PG8_WAIT_V(0);
    if constexpr (!ALIGN_EPI) { if (wr == 0) PG8_BAR; }
    PG8_BAR;
#undef PG8_SA
#undef PG8_SB
#undef PG8_STAGE
#undef PG8_LDA
#undef PG8_LDB
#undef PG8_MMA
#undef PG8_WAIT_V
#undef PG8_WAIT_L
#undef PG8_BAR
#undef PG8_SCHED
}
}

struct SchedDense : pg8::GridOrder {
    const char* A; const char* B; size_t tstep;
    __device__ bool next(int i, pg8::Unit& u) const { int pm, pn; if (!map(i, pm, pn)) return false; u.pm = pm; u.pn = pn; u.A = A + (size_t)pm * tstep; u.B = B + (size_t)pn * tstep; return true; }
};
struct SchedIn : pg8::GridOrder {
    const char* A; const char* B; size_t tstep;
    __device__ bool next(int i, pg8::Unit& u) const { int pm, pn; if (!map(i, pm, pn)) return false; u.pm = pm; u.pn = pn;
        const char* a = A + (size_t)pm * tstep; const char* b = B + (size_t)pn * tstep; const bool sw = (pn >= 10 && pn < 14); u.A = sw ? b : a; u.B = sw ? a : b; return true; }
};
struct SchedLatent : pg8::GridOrder {
    const char* A; const char* B; size_t tstep; int lat;
    __device__ bool next(int i, pg8::Unit& u) const { int pm, pn; if (!map(i, pm, pn)) return false; if (lat) pm = pm + (pm >> 4) + 1; u.pm = pm; u.pn = pn; u.A = A + (size_t)pm * tstep; u.B = B + (size_t)pn * tstep; return true; }
};
struct SchedMoe : pg8::GridOrder {
    const char* A; const char* B; size_t tstep; const int* TILE_E;
    __device__ bool next(int i, pg8::Unit& u) const { int pm, pn; if (!map(i, pm, pn)) return false; const int e = __builtin_amdgcn_readfirstlane(ld_i32(TILE_E + pm)); u.pm = pm; u.pn = pn;
        u.A = A + (size_t)pm * tstep; u.B = B + ((size_t)e * 4 + pn) * tstep; return true; }
};

struct SchedMoeG : pg8::GridOrder {
    const char* A; const char* B; size_t tstepB; const int* TILE_E; const int* SLOT_TOK; int one_pm, one_pn;
    __device__ bool next(int i, pg8::Unit& u) const { int pm, pn;
        if (one_pm >= 0) { if (i > 0) return false; pm = one_pm; pn = one_pn; } else if (!map(i, pm, pn)) return false;
        const int e = __builtin_amdgcn_readfirstlane(ld_i32(TILE_E + pm)); u.pm = pm; u.pn = pn;
        u.A = A; u.B = B + ((size_t)e * 4 + pn) * tstepB; return true; }
    __device__ __forceinline__ int arow(const pg8::Unit& u, int r) const { return SLOT_TOK[u.pm * 256 + r]; }
};
struct SchedMoeDep : pg8::GridOrder {
    const char* A; const char* B; size_t tstep; const int* TILE_E; const unsigned* dep; int rem, T0, cp;
    __device__ bool next(int j, pg8::Unit& u) const { int pm, pn;
        const bool isA = cp >= G - rem;
        const long idx = isA ? (long)(G - rem) + (long)j * G + cp : (j == 0 ? (long)cp : (long)(G - rem) + (long)(j - 1) * G + cp);
        if (idx >= (long)nwg + rem) return false;
        if (idx < nwg) mapL(idx, pm, pn);
        else { const int q = (int)(idx - nwg); pm = T0 + (q >> 2); pn = q & 3;
            while (ld_u32(dep) < (unsigned)rem) __builtin_amdgcn_s_sleep(4);
            __builtin_amdgcn_fence(__ATOMIC_ACQUIRE, "agent"); }
        const int e = __builtin_amdgcn_readfirstlane(ld_i32(TILE_E + pm)); u.pm = pm; u.pn = pn;
        u.A = A + (size_t)pm * tstep; u.B = B + ((size_t)e * 4 + pn) * tstep; return true; }
};
struct EpiInP {
    static constexpr bool PERM = true;
    bf16* QKRAW; bf16* PA; bf16* MVT; bf16* NVT; float* GATES; const float* gate_b; int dbg;
    __device__ __forceinline__ void operator()(const f32x4 (&acc)[2][2][4][2], const pg8::Unit& u, int wr, int wc, int fr, int fq, const bool wt) const {
        if (dbg & 1024) return;
        const int pn = u.pn;
        if (pn < 10) {
            bf16* base; int ldc, colt; if (pn < 4) { base = QKRAW; ldc = 1024; colt = pn * 256; } else { base = PA; ldc = 1536; colt = (pn - 4) * 256; }
            const int row0 = u.pm * 256 + wr * 64 + fr, col0 = colt + wc * 32 + 8 * fq;
#pragma unroll
            for (int ai = 0; ai < 2; ++ai)
#pragma unroll
                for (int m = 0; m < 4; ++m) { bf16* rowp = base + (size_t)(row0 + ai * 128 + m * 16) * ldc + col0;
#pragma unroll
                    for (int bj = 0; bj < 2; ++bj) { const f32x4 v0 = acc[ai][bj][m][0], v1 = acc[ai][bj][m][1];
                        u32x4 w; w.x = cvt_pk_bf16(v0[0], v0[1]); w.y = cvt_pk_bf16(v0[2], v0[3]); w.z = cvt_pk_bf16(v1[0], v1[1]); w.w = cvt_pk_bf16(v1[2], v1[3]);
                        st_sel16(rowp + bj * 128, w, wt); } }
        } else if (pn < 14) {
            const int b = u.pm / 17, u0 = (u.pm % 17) * 256 + wc * 32 + 8 * fq;
#pragma unroll
            for (int ai = 0; ai < 2; ++ai)
#pragma unroll
                for (int m = 0; m < 4; ++m) { const int ch = ai * 128 + wr * 64 + m * 16 + fr;
                    bf16* dst = pn < 12 ? MVT + ((size_t)(b * 4 + (pn - 10) * 2 + (ch >> 7)) * 128 + (ch & 127)) * UTP : NVT + ((size_t)(b * 8 + (pn - 12) * 4 + (ch >> 6)) * 64 + (ch & 63)) * UTP;
#pragma unroll
                    for (int bj = 0; bj < 2; ++bj) { const f32x4 v0 = acc[ai][bj][m][0], v1 = acc[ai][bj][m][1];
                        u32x4 w; w.x = cvt_pk_bf16(v0[0], v0[1]); w.y = cvt_pk_bf16(v0[2], v0[3]); w.z = cvt_pk_bf16(v1[0], v1[1]); w.w = cvt_pk_bf16(v1[2], v1[3]);
                        st_sel16(dst + u0 + bj * 128, w, wt); } }
        } else {
            if (wc == 0 && fq < 2) {
                const int row0 = u.pm * 256 + wr * 64 + fr;
#pragma unroll
                for (int n = 0; n < 2; ++n) { const f32x4 gb = *(const f32x4*)(gate_b + fq * 8 + n * 4);
#pragma unroll
                    for (int ai = 0; ai < 2; ++ai)
#pragma unroll
                        for (int m = 0; m < 4; ++m) *(f32x4*)(GATES + (size_t)(row0 + ai * 128 + m * 16) * 16 + fq * 8 + n * 4) = acc[ai][0][m][n] + gb; }
            }
        }
    }
};
struct EpiOutP {
    static constexpr bool PERM = true;
    bf16* YB;
    __device__ __forceinline__ void operator()(const f32x4 (&acc)[2][2][4][2], const pg8::Unit& u, int wr, int wc, int fr, int fq, const bool wt) const {
        const int row0 = u.pm * 256 + wr * 64 + fr, col0 = u.pn * 256 + wc * 32 + 8 * fq;
#pragma unroll
        for (int ai = 0; ai < 2; ++ai)
#pragma unroll
            for (int m = 0; m < 4; ++m) { bf16* rowp = YB + (size_t)(row0 + ai * 128 + m * 16) * 1024 + col0;
#pragma unroll
                for (int bj = 0; bj < 2; ++bj) { const f32x4 v0 = acc[ai][bj][m][0], v1 = acc[ai][bj][m][1];
                    u32x4 w; w.x = cvt_pk_bf16(v0[0], v0[1]); w.y = cvt_pk_bf16(v0[2], v0[3]); w.z = cvt_pk_bf16(v1[0], v1[1]); w.w = cvt_pk_bf16(v1[2], v1[3]);
                    st_sel16(rowp + bj * 128, w, wt); } }
    }
};
struct EpiMoe1 {
    static constexpr bool PERM = true;
    bf16* ACTM;
    __device__ __forceinline__ void operator()(const f32x4 (&acc)[2][2][4][2], const pg8::Unit& u, int wr, int wc, int fr, int fq, const bool wt) const {
        const int row0 = u.pm * 256 + wr * 64 + fr;
#pragma unroll
        for (int ai = 0; ai < 2; ++ai)
#pragma unroll
            for (int m = 0; m < 4; ++m) { bf16* rowp = ACTM + (size_t)(row0 + ai * 128 + m * 16) * 512;
#pragma unroll
                for (int bj = 0; bj < 2; ++bj) { const int j0 = (u.pn * 256 + bj * 128 + wc * 32 + fq * 8) >> 1; const f32x4 g1 = acc[ai][bj][m][0], g3 = acc[ai][bj][m][1];
                    u32x2 w; w.x = cvt_pk_bf16(fast_silu(g1[0]) * g3[0], fast_silu(g1[1]) * g3[1]); w.y = cvt_pk_bf16(fast_silu(g1[2]) * g3[2], fast_silu(g1[3]) * g3[3]);
                    st_sel8(rowp + j0, w, wt); } }
    }
};
struct EpiMoe2 {
    static constexpr bool PERM = true;
    bf16* Y;
    __device__ __forceinline__ void operator()(const f32x4 (&acc)[2][2][4][2], const pg8::Unit& u, int wr, int wc, int fr, int fq, const bool wt) const {
        const int row0 = u.pm * 256 + wr * 64 + fr, col0 = u.pn * 256 + wc * 32 + 8 * fq;
#pragma unroll
        for (int ai = 0; ai < 2; ++ai)
#pragma unroll
            for (int m = 0; m < 4; ++m) { bf16* rowp = Y + (size_t)(row0 + ai * 128 + m * 16) * 1024 + col0;
#pragma unroll
                for (int bj = 0; bj < 2; ++bj) { const f32x4 v0 = acc[ai][bj][m][0], v1 = acc[ai][bj][m][1];
                    u32x4 w; w.x = cvt_pk_bf16(v0[0], v0[1]); w.y = cvt_pk_bf16(v0[2], v0[3]); w.z = cvt_pk_bf16(v1[0], v1[1]); w.w = cvt_pk_bf16(v1[2], v1[3]);
                    st_sel16(rowp + bj * 128, w, wt); } }
    }
};

struct Args { const float* in[21]; float* out; unsigned char* ws; int ph_lo, ph_hi, bar_region, mixflags; };
typedef const Args __attribute__((address_space(4)))* KargP;
__device__ __forceinline__ KargP kargs() { KargP p = (KargP)__builtin_amdgcn_kernarg_segment_ptr(); asm volatile("" : "+s"(p)); return p; }
struct Ctx { LAS unsigned char* lds; int wave, G, gw, ngw; };

struct ConvJob { const float* sp; float msk; size_t ld; bf16* dst; int K, n0, k0; };
__device__ __forceinline__ void conv_load(const ConvJob& J, f32x4 (&v)[8], int lane) {
    const int kq = lane >> 3;
#pragma unroll
    for (int it = 0; it < 8; ++it) v[it] = __builtin_nontemporal_load((const f32x4*)(J.sp + (size_t)(J.k0 + 8 * it + kq) * J.ld));
}
__device__ __forceinline__ void conv_finish(const ConvJob& J, const f32x4 (&v)[8], LAS float* scr, int lane) {
    const int kq = lane >> 3, nq = lane & 7;
#pragma unroll
    for (int it = 0; it < 8; ++it) { LAS float* w = scr + (8 * it + kq) * 33 + 4 * nq; w[0] = v[it][0] * J.msk; w[1] = v[it][1] * J.msk; w[2] = v[it][2] * J.msk; w[3] = v[it][3] * J.msk; }
    LDS_WAIT(); asm volatile("" ::: "memory");
    const int c = lane & 7;
#pragma unroll
    for (int j = 0; j < 4; ++j) { const int n = (lane >> 3) + 8 * j; const LAS float* s = scr + (8 * c) * 33 + n;
        u32x4 o; o.x = cvt_pk_bf16(s[0 * 33], s[1 * 33]); o.y = cvt_pk_bf16(s[2 * 33], s[3 * 33]); o.z = cvt_pk_bf16(s[4 * 33], s[5 * 33]); o.w = cvt_pk_bf16(s[6 * 33], s[7 * 33]);
        __builtin_nontemporal_store(o, (u32x4*)(J.dst + (size_t)(J.n0 + n) * J.K + J.k0 + 8 * c)); }
    LDS_WAIT(); asm volatile("" ::: "memory");
}
__device__ __forceinline__ int win_src(int n) {
    if (n < 512) return n;
    if (n < 1024) return 1536 + (n - 512);
    if (n < 1536) return 512 + (n - 1024);
    if (n < 2048) return 1024 + (n - 1536);
    if (n < 2560) return 2576 + (n - 2048);
    if (n < 3072) return 2048 + (n - 2560);
    if (n < 3584) return 3088 + (n - 3072);
    if (n < 3600) return 2560 + (n - 3584);
    return -1;
}
__device__ __forceinline__ void phase_prologue(const Ctx& X) {
    KargP ka = kargs(); unsigned char* const ws = ka->ws; (void)ka; (void)ws;
    int tid_ = X.wave * 64 + lane_id(); asm volatile("" : "+v"(tid_)); const int TID = tid_, LANE = tid_ & 63;
    LAS float* s = (LAS float*)X.lds;
    LAS float* red = s + 9 * 1024;
    for (int i = TID; i < 9 * 1024; i += NTHR) { const int r = i >> 10, k = i & 1023; const float v = r < 8 ? ka->in[1][r * 1024 + k] : ka->in[3][k]; s[i] = v / (1.f + __expf(-v)); }
    __syncthreads();
    const int gc0 = blockIdx.x * 48, l = gc0 / 6144, j0 = gc0 % 6144;
    if (blockIdx.x < 256) {
        const int kg = TID / 12, c4 = TID % 12;
        if (kg < 42) {
            f32x4 a[9];
#pragma unroll
            for (int r = 0; r < 9; ++r) a[r] = (f32x4){0.f, 0.f, 0.f, 0.f};
            const float* w = ka->in[4] + (size_t)l * 1024 * 6144 + j0 + 4 * c4;
#pragma unroll 1
            for (int i0 = 0; i0 < 25; i0 += 5) { f32x4 wv[5];
#pragma unroll
                for (int u = 0; u < 5; ++u) { const int k = min(kg + 42 * (i0 + u), 1023); wv[u] = __builtin_nontemporal_load((const f32x4*)(w + (size_t)k * 6144)); }
#pragma unroll
                for (int u = 0; u < 5; ++u) { const int k = kg + 42 * (i0 + u), kc = min(k, 1023); const float mk = k < 1024 ? 1.f : 0.f;
#pragma unroll
                    for (int r = 0; r < 9; ++r) a[r] += (s[r * 1024 + kc] * mk) * wv[u]; } }
#pragma unroll
            for (int r = 0; r < 9; ++r) *(LAS f32x4*)(red + (kg * 9 + r) * 48 + 4 * c4) = a[r];
        }
        __syncthreads();
        if (TID < 432) { const int r = TID / 48, col = TID % 48; float a = 0.f;
#pragma unroll 6
            for (int q = 0; q < 42; ++q) a += red[(q * 9 + r) * 48 + col];
            ((float*)(ws + WS_MOD))[((size_t)l * 9 + r) * 6144 + j0 + col] = a + ka->in[5][l * 6144 + j0 + col]; }
    }
}
__device__ __forceinline__ void phase_wconv(const Ctx& X) {
    KargP ka = kargs(); unsigned char* const ws = ka->ws; (void)ka; (void)ws;
    int tid_ = X.wave * 64 + lane_id(); asm volatile("" : "+v"(tid_)); const int LANE = tid_ & 63;
    LAS float* scr = (LAS float*)(X.lds + X.wave * 16384);
    constexpr int I_IN = 120 * 16, I_OUT = 32 * 16, NIT = 2 * (I_IN + I_OUT);
    auto job_of = [&](int it) { ConvJob J; int r = it; const int ly = r / (I_IN + I_OUT); r -= ly * (I_IN + I_OUT);
        if (r < I_IN) { const int nb = r / 16, kb = r % 16, n = nb * 32 + 4 * (LANE & 7), sc = win_src(n);
            J.sp = ka->in[7] + (size_t)ly * 1024 * N_IN + (sc < 0 ? 0 : sc); J.msk = sc < 0 ? 0.f : 1.f; J.ld = N_IN; J.dst = (bf16*)(ws + WS_WIN) + (size_t)ly * 3840 * 1024; J.K = 1024; J.n0 = nb * 32; J.k0 = kb * 64; }
        else { r -= I_IN; const int nb = r / 16, kb = r % 16;
            J.sp = ka->in[13] + (size_t)ly * 1024 * 1024 + nb * 32 + 4 * (LANE & 7); J.msk = 1.f; J.ld = 1024; J.dst = (bf16*)(ws + WS_WOUT) + (size_t)ly * 1024 * 1024; J.K = 1024; J.n0 = nb * 32; J.k0 = kb * 64; }
        return J; };
    { f32x4 va[8], vb[8]; int it = X.gw; ConvJob Ja = job_of(min(it, NIT - 1)); conv_load(Ja, va, LANE);
      for (; it < NIT; it += 2 * X.ngw) {
          ConvJob Jb = job_of(min(it + X.ngw, NIT - 1)); conv_load(Jb, vb, LANE);
          conv_finish(Ja, va, scr, LANE);
          Ja = job_of(min(it + 2 * X.ngw, NIT - 1)); conv_load(Ja, va, LANE);
          if (it + X.ngw < NIT) conv_finish(Jb, vb, scr, LANE); } }
}
__device__ __forceinline__ void convert_experts(const Ctx& X, int ly, int first, int end, int wid, int stride) {
    KargP ka = kargs(); unsigned char* const ws = ka->ws; (void)ka; (void)ws;
    int tid_ = X.wave * 64 + lane_id(); asm volatile("" : "+v"(tid_)); const int LANE = tid_ & 63;
    LAS float* scr = (LAS float*)(X.lds + X.wave * 16384);
    constexpr int I13 = 16 * 32 * 16, I2 = 16 * 32 * 8, NIT = I13 + I2;
    if (end > NIT) end = NIT;
    bf16* const e13 = (bf16*)(ws + (ly ? WS_EW13_L1 : WS_EW13)); bf16* const e2 = (bf16*)(ws + (ly ? WS_EW2_L1 : WS_EW2));
    auto job_of = [&](int it) { ConvJob J;
        if (it < I13) { const int e = it / 512, r = it % 512, nb = r / 16, kb = r % 16, n = nb * 32 + 4 * (LANE & 7), g = n >> 3, i = n & 7;
            J.sp = (i < 4 ? ka->in[17] : ka->in[18]) + ((size_t)ly * 16 + e) * 1024 * 512 + 4 * g; J.msk = 1.f; J.ld = 512; J.dst = e13 + (size_t)e * 1024 * 1024; J.K = 1024; J.n0 = nb * 32; J.k0 = kb * 64; }
        else { const int r0 = it - I13, e = r0 / 256, r = r0 % 256, nb = r / 8, kb = r % 8;
            J.sp = ka->in[19] + ((size_t)ly * 16 + e) * 512 * 1024 + nb * 32 + 4 * (LANE & 7); J.msk = 1.f; J.ld = 1024; J.dst = e2 + (size_t)e * 1024 * 512; J.K = 512; J.n0 = nb * 32; J.k0 = kb * 64; }
        return J; };
    int it = first + wid; const int lastit = end - 1;
    if (it < end) { f32x4 va[8], vb[8]; ConvJob Ja = job_of(min(it, lastit)); conv_load(Ja, va, LANE);
        for (; it < end; it += 2 * stride) {
            const ConvJob Jb = job_of(min(it + stride, lastit)); conv_load(Jb, vb, LANE);
            conv_finish(Ja, va, scr, LANE);
            Ja = job_of(min(it + 2 * stride, lastit)); conv_load(Ja, va, LANE);
            if (it + stride < end) conv_finish(Jb, vb, scr, LANE); } }
}
constexpr int CONV_TAIL_OUT = 224 * 8 * 4;

template <bool COMBINE, bool ROUTER, bool FINAL, bool ADDY = false, bool SRC16 = false>
__device__ __forceinline__ void rows_phase(const Ctx& X, const float* xl_src, const float* xc_src, float* out_dst, const float* nw, const float* MODn, int sh, int sc,
                                           const float* MODc  , bool latent_only, int lyr, const int dbg = 0) {
    KargP ka = kargs(); unsigned char* const ws = ka->ws; (void)ka; (void)ws;
    int tid_ = X.wave * 64 + lane_id(); asm volatile("" : "+v"(tid_)); const int TID = tid_, LANE = tid_ & 63;
    bf16* ACT = (bf16*)ka->out; const bf16* Y = (const bf16*)(ws + WS_Y); bf16* X16 = (bf16*)(ws + WS_X16);
    const int* TOK_SLOT = (const int*)(ws + WS_ROUTE + RT_TOK_SLOT); const float* TOK_Wc = (const float*)(ws + WS_ROUTE + RT_TOK_W);
    int* TOK_E = (int*)(ws + WS_ROUTE + RT_TOK_E); float* TOK_W = (float*)(ws + WS_ROUTE + RT_TOK_W);
    LAS float* rwL = (LAS float*)X.lds;
    LAS unsigned* hist = (LAS unsigned*)(X.lds + 65536);
    LAS float* rbL = (LAS float*)(X.lds + 65536 + 64);
    if (ROUTER) {
        { f32x4 t[8];
#pragma unroll
          for (int u = 0; u < 8; ++u) t[u] = *(const f32x4*)(ka->in[15] + (size_t)(TID + NTHR * u) * 4);
#pragma unroll
          for (int u = 0; u < 8; ++u) { const int i4 = TID + NTHR * u, cidx = i4 >> 2, q = i4 & 3, ji = (cidx >> 8) * 4 + (cidx & 3), ln = (cidx & 255) >> 2;
              *(LAS f32x4*)(rwL + ((ji * 4 + q) * 64 + ln) * 4) = t[u]; } }
        if (TID < 16) { hist[TID] = 0u; rbL[TID] = ka->in[16][TID]; }
        __syncthreads();
    }
    const int nrow = latent_only ? 16 : 17;
    const bf16* YB = (const bf16*)(ws + WS_Y);
    int key = -1; f32x4 wv[4], shv[4], m5[4];
#define RP_DESC(ii, ROW, B, U) do { const int i_ = min((ii), nrow - 1); if (latent_only) { const int lr = X.gw * 16 + i_; B = lr >> 12; U = CTXL + (lr & 4095); ROW = B * UT + U; } \
        else { ROW = X.gw * 17 + i_; B = ROW / UT; U = ROW - B * UT; } } while (0)
#define RP_XPTR(B, U) (((U) < CTXL ? xc_src : xl_src) + ((U) < CTXL ? ((size_t)(B) * CTXL + (U)) * DM : ((size_t)(B) * SEQ + ((U) - CTXL)) * DM))
    f32x4 vn[4]; u32x2 xn16[4]; u32x2 yan[4], ybn[4]; int sl0 = 0, sl1 = 0; float sw0 = 0.f, sw1 = 0.f;
    int nl0 = 0, nl1 = 0; float nw0 = 0.f, nw1 = 0.f;
    { int row, b, u; RP_DESC(0, row, b, u);
      if (COMBINE) { sl0 = __builtin_amdgcn_readfirstlane(ld_i32(TOK_SLOT + row * 2)); sl1 = __builtin_amdgcn_readfirstlane(ld_i32(TOK_SLOT + row * 2 + 1)); sw0 = ld_f32(TOK_Wc + row * 2); sw1 = ld_f32(TOK_Wc + row * 2 + 1); }
      const float* xs = RP_XPTR(b, u);
#pragma unroll
      for (int j = 0; j < 4; ++j) { if (SRC16) xn16[j] = *(const u32x2*)(X16 + (size_t)row * DM + 4 * LANE + 256 * j); else vn[j] = __builtin_nontemporal_load((const f32x4*)(xs + 4 * LANE + 256 * j));
          if (ADDY) yan[j] = __builtin_nontemporal_load((const u32x2*)(YB + (size_t)row * DM + 4 * LANE + 256 * j));
          if (COMBINE) { yan[j] = __builtin_nontemporal_load((const u32x2*)(Y + (size_t)sl0 * 1024 + 4 * LANE + 256 * j)); ybn[j] = __builtin_nontemporal_load((const u32x2*)(Y + (size_t)sl1 * 1024 + 4 * LANE + 256 * j)); } }
      if (COMBINE) { int r1, b1, u1; RP_DESC(1, r1, b1, u1); nl0 = ld_i32(TOK_SLOT + r1 * 2); nl1 = ld_i32(TOK_SLOT + r1 * 2 + 1); nw0 = ld_f32(TOK_Wc + r1 * 2); nw1 = ld_f32(TOK_Wc + r1 * 2 + 1); } }
    int split = nrow;
    { int r0, b0, u0; RP_DESC(0, r0, b0, u0); const int k0 = u0 < CTXL ? 8 : b0;
      for (int i = 1; i < nrow; ++i) { int r1, b1, u1; RP_DESC(i, r1, b1, u1); const int k1 = u1 < CTXL ? 8 : b1; if (k1 != k0 && split == nrow) split = i; } }
#pragma unroll 1
    for (int seg = 0; seg < 2; ++seg) {
    const int ilo = seg ? split : 0, ihi = seg ? nrow : split;
    if (ilo < ihi) {
        int rk, bk, uk; RP_DESC(ilo, rk, bk, uk); const int k2 = uk < CTXL ? 8 : bk; key = k2;
#pragma unroll
        for (int j = 0; j < 4; ++j) { const int col = 4 * LANE + 256 * j;
            if (FINAL) wv[j] = *(const f32x4*)(nw + col);
            else { const f32x4 w = *(const f32x4*)(nw + col), s1 = *(const f32x4*)(MODn + (size_t)k2 * 6144 + sc * 1024 + col); wv[j] = w * (1.f + s1); shv[j] = *(const f32x4*)(MODn + (size_t)k2 * 6144 + sh * 1024 + col); }
            if (COMBINE) m5[j] = *(const f32x4*)(MODc + (size_t)k2 * 6144 + 5 * 1024 + col);
            if (ADDY) m5[j] = *(const f32x4*)(MODn + (size_t)k2 * 6144 + 2 * 1024 + col); }
#pragma unroll
        for (int j = 0; j < 4; ++j) { asm volatile("" : "+v"(wv[j])); if (SRC16) asm volatile("" : "+v"(xn16[j])); else asm volatile("" : "+v"(vn[j])); if (!FINAL) asm volatile("" : "+v"(shv[j])); if (COMBINE || ADDY) asm volatile("" : "+v"(m5[j]), "+v"(yan[j])); if (COMBINE) asm volatile("" : "+v"(ybn[j])); }
    }
#pragma unroll 1
    for (int i = ilo; i < ihi; ++i) {
        int row, b, u; RP_DESC(i, row, b, u);
        const bool ctx = u < CTXL;
        const size_t xoff = ctx ? ((size_t)b * CTXL + u) * DM : ((size_t)b * SEQ + (u - CTXL)) * DM;
        f32x4 v[4]; u32x2 ya_[4], yb_[4]; const float w0 = sw0, w1 = sw1;
#pragma unroll
        for (int j = 0; j < 4; ++j) { ya_[j] = yan[j]; yb_[j] = ybn[j];
            if (SRC16) { const u32x2 a = xn16[j]; v[j][0] = __uint_as_float(a.x << 16); v[j][1] = __uint_as_float(a.x & 0xffff0000u); v[j][2] = __uint_as_float(a.y << 16); v[j][3] = __uint_as_float(a.y & 0xffff0000u); }
            else v[j] = vn[j]; }
        { int r1, b1, u1; RP_DESC(i + 1, r1, b1, u1);
          if (COMBINE) { sl0 = __builtin_amdgcn_readfirstlane(nl0); sl1 = __builtin_amdgcn_readfirstlane(nl1); sw0 = nw0; sw1 = nw1; }
          const float* xs = RP_XPTR(b1, u1);
#pragma unroll
          for (int j = 0; j < 4; ++j) { if (SRC16) xn16[j] = *(const u32x2*)(X16 + (size_t)r1 * DM + 4 * LANE + 256 * j); else vn[j] = __builtin_nontemporal_load((const f32x4*)(xs + 4 * LANE + 256 * j));
              if (ADDY) yan[j] = __builtin_nontemporal_load((const u32x2*)(YB + (size_t)r1 * DM + 4 * LANE + 256 * j));
              if (COMBINE) { yan[j] = __builtin_nontemporal_load((const u32x2*)(Y + (size_t)sl0 * 1024 + 4 * LANE + 256 * j)); ybn[j] = __builtin_nontemporal_load((const u32x2*)(Y + (size_t)sl1 * 1024 + 4 * LANE + 256 * j)); } }
          if (COMBINE) { int r2, b2, u2; RP_DESC(i + 2, r2, b2, u2); nl0 = ld_i32(TOK_SLOT + r2 * 2); nl1 = ld_i32(TOK_SLOT + r2 * 2 + 1); nw0 = ld_f32(TOK_Wc + r2 * 2); nw1 = ld_f32(TOK_Wc + r2 * 2 + 1); } }
        if (ADDY) {
#pragma unroll
            for (int j = 0; j < 4; ++j) { const u32x2 a = ya_[j];
                f32x4 ya; ya[0] = __uint_as_float(a.x << 16); ya[1] = __uint_as_float(a.x & 0xffff0000u); ya[2] = __uint_as_float(a.y << 16); ya[3] = __uint_as_float(a.y & 0xffff0000u);
                v[j] = v[j] + m5[j] * ya; }
            if (!(dbg & 2048)) {
#pragma unroll
            for (int j = 0; j < 4; ++j) { u32x2 o; o.x = cvt_pk_bf16(v[j][0], v[j][1]); o.y = cvt_pk_bf16(v[j][2], v[j][3]); *(u32x2*)(X16 + (size_t)row * DM + 4 * LANE + 256 * j) = o; } }
        }
        if (COMBINE) {
#pragma unroll
            for (int j = 0; j < 4; ++j) { const u32x2 a = ya_[j], bq = yb_[j];
                f32x4 ya, yb; ya[0] = __uint_as_float(a.x << 16); ya[1] = __uint_as_float(a.x & 0xffff0000u); ya[2] = __uint_as_float(a.y << 16); ya[3] = __uint_as_float(a.y & 0xffff0000u);
                yb[0] = __uint_as_float(bq.x << 16); yb[1] = __uint_as_float(bq.x & 0xffff0000u); yb[2] = __uint_as_float(bq.y << 16); yb[3] = __uint_as_float(bq.y & 0xffff0000u);
                v[j] = v[j] + m5[j] * (w0 * ya + w1 * yb); }
            if (!FINAL && !(dbg & 2048)) {
#pragma unroll
                for (int j = 0; j < 4; ++j) { u32x2 o; o.x = cvt_pk_bf16(v[j][0], v[j][1]); o.y = cvt_pk_bf16(v[j][2], v[j][3]); *(u32x2*)(X16 + (size_t)row * DM + 4 * LANE + 256 * j) = o; } }
        }
        float ss = 0.f;
#pragma unroll
        for (int j = 0; j < 4; ++j) ss += (v[j][0] * v[j][0] + v[j][1] * v[j][1]) + (v[j][2] * v[j][2] + v[j][3] * v[j][3]);
        const float rstd = rsqrtf(wave_sum(ss) * (1.f / DM) + EPS);
        if (FINAL) { float* xd = out_dst + xoff;
#pragma unroll
            for (int j = 0; j < 4; ++j) *(f32x4*)(xd + 4 * LANE + 256 * j) = v[j] * rstd * wv[j];
            continue; }
        f32x4 h[4];
#pragma unroll
        for (int j = 0; j < 4; ++j) { h[j] = v[j] * rstd * wv[j] + shv[j]; u32x2 o; o.x = cvt_pk_bf16(h[j][0], h[j][1]); o.y = cvt_pk_bf16(h[j][2], h[j][3]); *(u32x2*)(ACT + (size_t)row * DM + 4 * LANE + 256 * j) = o; }
        if (ROUTER && !(dbg & 512)) {
            float p[16];
            { f32x2 pa[8];
#pragma unroll
              for (int e = 0; e < 8; ++e) pa[e] = (f32x2){0.f, 0.f};
#pragma unroll
              for (int j = 0; j < 4; ++j)
#pragma unroll
                for (int ii = 0; ii < 4; ++ii) { const f32x2 hh = (f32x2){h[j][ii], h[j][ii]};
#pragma unroll
                    for (int q = 0; q < 4; ++q) { const f32x4 w = *(const LAS f32x4*)(rwL + (((j * 4 + ii) * 4 + q) * 64 + LANE) * 4);
                        pa[2 * q] = __builtin_elementwise_fma(hh, (f32x2){w[0], w[1]}, pa[2 * q]); pa[2 * q + 1] = __builtin_elementwise_fma(hh, (f32x2){w[2], w[3]}, pa[2 * q + 1]); } }
#pragma unroll
              for (int e = 0; e < 8; ++e) { p[2 * e] = pa[e][0]; p[2 * e + 1] = pa[e][1]; } }
            float q8[8], q4[4], q2[2], q1;
#pragma unroll
            for (int t = 0; t < 8; ++t) { const auto r = __builtin_amdgcn_permlane32_swap(__float_as_uint(p[t]), __float_as_uint(p[t + 8]), false, false); q8[t] = __uint_as_float(r[0]) + __uint_as_float(r[1]); }
#pragma unroll
            for (int t = 0; t < 4; ++t) { const auto r = __builtin_amdgcn_permlane16_swap(__float_as_uint(q8[t]), __float_as_uint(q8[t + 4]), false, false); q4[t] = __uint_as_float(r[0]) + __uint_as_float(r[1]); }
            { const bool hi = (LANE & 8) != 0;
#pragma unroll
              for (int t = 0; t < 2; ++t) { const float a = dpp_f<0x128>(q4[t]), c = dpp_f<0x128>(q4[t + 2]); q2[t] = hi ? q4[t + 2] + c : q4[t] + a; } }
            { const bool hi = (LANE & 4) != 0; const float a0 = dpp_f<0x104>(q2[0]), a1 = dpp_f<0x114>(q2[1]); q1 = hi ? q2[1] + a1 : q2[0] + a0; }
            q1 += dpp_f<0xB1>(q1); q1 += dpp_f<0x4E>(q1);
            float mx = q1;
            mx = fmaxf(mx, dpp_f<0x124>(mx)); mx = fmaxf(mx, dpp_f<0x128>(mx)); mx = red_hi_max(mx);
            const float pe = __expf(q1 - mx); float sum = pe;
            sum += dpp_f<0x124>(sum); sum += dpp_f<0x128>(sum); sum = red_hi_add(sum);
            const float prob = pe * (1.f / sum), sv = prob + rbL[LANE >> 2];
            const bool b2_ = (LANE & 4) != 0; const float s2 = dpp_f<0x128>(sv);
            float s1m = dpp_f<0x114>(sv), s1p = dpp_f<0x104>(sv), s3m = dpp_f<0x114>(s2), s3p = dpp_f<0x104>(s2); asm volatile("" : "+v"(s1m), "+v"(s1p), "+v"(s3m), "+v"(s3p));
            const float s1 = b2_ ? s1m : s1p, s3 = b2_ ? s3m : s3p;
            const int kk = (LANE >> 2) & 3;
            const int rank = ((s1 > sv) || (s1 == sv && (kk ^ 1) < kk) ? 1 : 0) + ((s2 > sv) || (s2 == sv && (kk ^ 2) < kk) ? 1 : 0) + ((s3 > sv) || (s3 == sv && (kk ^ 3) < kk) ? 1 : 0);
            const float hi01 = fmaxf(sv, s1), lo01 = fminf(sv, s1), hi23 = fmaxf(s2, s3), lo23 = fminf(s2, s3);
            const float gs = fmaxf(hi01, hi23) + fmaxf(fminf(hi01, hi23), fmaxf(lo01, lo23));
            const float gmax = red_hi_max(gs);
            const int best = (__ffsll((unsigned long long)__ballot(gs == gmax)) - 1) >> 4;
            const bool inb = (LANE >> 4) == best;
            const int l0 = __ffsll((unsigned long long)__ballot(inb && rank == 0)) - 1, l1 = __ffsll((unsigned long long)__ballot(inb && rank == 1)) - 1;
            const float p0 = __uint_as_float(__builtin_amdgcn_readlane(__float_as_uint(prob), l0)), p1 = __uint_as_float(__builtin_amdgcn_readlane(__float_as_uint(prob), l1));
            const int i0 = (l0 >> 2) & 3, i1 = (l1 >> 2) & 3;
            if (LANE == 0) { const int e0 = 4 * best + i0, e1 = 4 * best + i1; const float wsum = p0 + p1;
                TOK_E[row * 2] = e0; TOK_E[row * 2 + 1] = e1; TOK_W[row * 2] = p0 / wsum; TOK_W[row * 2 + 1] = p1 / wsum;
                __hip_atomic_fetch_add(hist + e0, 1u, __ATOMIC_RELAXED, __HIP_MEMORY_SCOPE_WORKGROUP); __hip_atomic_fetch_add(hist + e1, 1u, __ATOMIC_RELAXED, __HIP_MEMORY_SCOPE_WORKGROUP); }
        }
    }
    }
    if (ROUTER) {
        __syncthreads();
        if (TID < 16 && !(dbg & 128)) __hip_atomic_fetch_add(((unsigned*)ws) + CW_CNT + 32 * lyr + TID, hist[TID], __ATOMIC_RELAXED, __HIP_MEMORY_SCOPE_AGENT);
    }
}

__device__ __forceinline__ void phase_slots(const Ctx& X, int lyr, bool latent_only) {
    KargP ka = kargs(); unsigned char* const ws = ka->ws; (void)ka; (void)ws;
    int tid_ = X.wave * 64 + lane_id(); asm volatile("" : "+v"(tid_)); const int TID = tid_, LANE = tid_ & 63;
    LAS unsigned* off = (LAS unsigned*)X.lds;
    LAS unsigned* lcnt = off + 32;
    LAS unsigned* lbase = off + 64;
    const int* TOK_E = (const int*)(ws + WS_ROUTE + RT_TOK_E); const float* TOK_W = (const float*)(ws + WS_ROUTE + RT_TOK_W);
    int* TOK_SLOT = (int*)(ws + WS_ROUTE + RT_TOK_SLOT); int* SLOT_TOK = (int*)(ws + WS_ROUTE + RT_SLOT_TOK); float* SLOT_W = (float*)(ws + WS_ROUTE + RT_SLOT_W); int* TILE_E = (int*)(ws + WS_ROUTE + RT_TILE_E) + 512 * lyr;
    const bf16* ACT = (const bf16*)ka->out; bf16* AG = (bf16*)(ws + WS_AG);
    unsigned* CNT = ((unsigned*)ws) + CW_CNT + 32 * lyr; unsigned* CUR = ((unsigned*)ws) + CW_CUR + 32 * lyr;
    LAS unsigned* cntL = off + 96;
    if (TID < 16) { cntL[TID] = ld_u32(CNT + TID); lcnt[TID] = 0u; }
    __syncthreads();
    if (TID == 0) { unsigned o = 0; for (int e = 0; e < 16; ++e) { off[e] = o; o += (cntL[e] + 255u) & ~255u; } off[16] = o; }
    __syncthreads();
    if (blockIdx.x == 0) {
        if (TID <= 16) ((unsigned*)ws)[CW_OFF + 32 * lyr + TID] = off[TID];
        if (TID == 0) ((unsigned*)ws)[CW_NT + 32 * lyr] = off[16] >> 8;
        { const int e = TID >> 5; for (unsigned i = off[e] + cntL[e] + (TID & 31); i < off[e + 1]; i += 32) { SLOT_TOK[i] = 0; SLOT_W[i] = 0.f; } }
        for (unsigned t = TID; t < (off[16] >> 8); t += NTHR) { int e = 0;
#pragma unroll
            for (int q = 1; q < 16; ++q) e += (off[q] >> 8) <= t ? 1 : 0;
            TILE_E[t] = e; }
    }
    const int nrow = latent_only ? 16 : 17;
    int row = -1, e0 = 0, e1 = 0; unsigned lp0 = 0, lp1 = 0;
    if (LANE < nrow) {
        if (latent_only) { const int lr = X.gw * 16 + LANE; row = (lr >> 12) * UT + CTXL + (lr & 4095); } else row = X.gw * 17 + LANE;
        e0 = TOK_E[row * 2]; e1 = TOK_E[row * 2 + 1];
        lp0 = __hip_atomic_fetch_add(lcnt + e0, 1u, __ATOMIC_RELAXED, __HIP_MEMORY_SCOPE_WORKGROUP); lp1 = __hip_atomic_fetch_add(lcnt + e1, 1u, __ATOMIC_RELAXED, __HIP_MEMORY_SCOPE_WORKGROUP);
    }
    __syncthreads();
    if (TID < 16) lbase[TID] = off[TID] + __hip_atomic_fetch_add(CUR + TID, lcnt[TID], __ATOMIC_RELAXED, __HIP_MEMORY_SCOPE_AGENT);
    __syncthreads();
    int s0 = 0, s1 = 0;
    if (LANE < nrow) { s0 = (int)(lbase[e0] + lp0); s1 = (int)(lbase[e1] + lp1); TOK_SLOT[row * 2] = s0; TOK_SLOT[row * 2 + 1] = s1;
        SLOT_TOK[s0] = row; SLOT_TOK[s1] = row; SLOT_W[s0] = TOK_W[row * 2]; SLOT_W[s1] = TOK_W[row * 2 + 1]; }
}

__device__ __forceinline__ void unpack8(const u32x4 v, float (&f)[8]) {
    f[0] = __uint_as_float(v.x << 16); f[1] = __uint_as_float(v.x & 0xffff0000u); f[2] = __uint_as_float(v.y << 16); f[3] = __uint_as_float(v.y & 0xffff0000u);
    f[4] = __uint_as_float(v.z << 16); f[5] = __uint_as_float(v.z & 0xffff0000u); f[6] = __uint_as_float(v.w << 16); f[7] = __uint_as_float(v.w & 0xffff0000u);
}
__device__ __forceinline__ void phase_prep(const Ctx& X, int l) {
    KargP ka = kargs(); unsigned char* const ws = ka->ws; (void)ka; (void)ws;
    int tid_ = X.wave * 64 + lane_id(); asm volatile("" : "+v"(tid_)); const int TID = tid_, LANE = tid_ & 63;
    LAS float* tcos = (LAS float*)X.lds; LAS float* tsin = tcos + 2048;
    for (int i = TID; i < 2048; i += NTHR) { const int pos = i >> 5, ii = i & 31; const float inv = exp2f(-(float)(2 * ii) * (13.287712379549449f / 64.f)); const float ang = (float)pos * inv; tcos[i] = cosf(ang); tsin[i] = sinf(ang); }
    __syncthreads();
    const bf16* QKRAW = (const bf16*)(ws + WS_QKRAW); bf16* QP = (bf16*)(ws + WS_QP); bf16* KP = (bf16*)(ws + WS_KP); bf16* KPT = (bf16*)(ws + WS_KPT);
    const float* cw = ka->in[8] + l * 3072; const float* cb = ka->in[9] + l * 1024;
    const int t8 = LANE & 7, cg = LANE >> 3, i0 = 8 * (cg & 3); const bool low = cg < 4;
#pragma unroll 1
    for (int it = X.gw; it < 2 * 8 * (MROWS / 64); it += X.ngw) {
        const int hf = it & 1, cbk = (it >> 1) & 7, tb = it >> 4, b = tb / (UT / 64), ub = (tb - b * (UT / 64)) * 64, u0 = ub + 8 * t8;
        const int col0 = hf * 512 + cbk * 64 + 8 * cg, blk = cbk & 1, hd = cbk >> 1;
        const int seglo = ub < CTXL ? 0 : CTXL, seghi = ub < CTXL ? CTXL : UT;
        const size_t rowb = (size_t)b * UT + u0;
        float w0[8], w1[8], w2[8], bb[8];
#pragma unroll
        for (int j = 0; j < 8; ++j) { w0[j] = cw[col0 + j]; w1[j] = cw[1024 + col0 + j]; w2[j] = cw[2048 + col0 + j]; bb[j] = cb[col0 + j]; }
        u32x4 raw[10];
#pragma unroll
        for (int i = 0; i < 10; ++i) { const int u = u0 - 1 + i; const bool ok = (u >= seglo) && (u < seghi); const size_t rr = ok ? rowb - 1 + i : rowb;
            const u32x4 v = __builtin_nontemporal_load((const u32x4*)(QKRAW + rr * 1024 + col0)); raw[i] = ok ? v : (u32x4){0u, 0u, 0u, 0u}; }
        float xp[8], xc[8], xr[8];
        unpack8(raw[0], xp); unpack8(raw[1], xc);
        u32x4 o[8];
#pragma unroll
        for (int i = 0; i < 8; ++i) {
            unpack8(raw[i + 2], xr);
            float s[8];
#pragma unroll
            for (int j = 0; j < 8; ++j) { const float y = bb[j] + w0[j] * xp[j] + w1[j] * xc[j] + w2[j] * xr[j]; s[j] = y * __builtin_amdgcn_rcpf(1.f + __expf(-y)); }
            if (ub >= CTXL) {
                const int t = u0 + i - CTXL, pos = blk ? (t & 63) : (t >> 6);
                const f32x4 c0 = *(const LAS f32x4*)(tcos + pos * 32 + i0), c1 = *(const LAS f32x4*)(tcos + pos * 32 + i0 + 4), s0 = *(const LAS f32x4*)(tsin + pos * 32 + i0), s1 = *(const LAS f32x4*)(tsin + pos * 32 + i0 + 4);
#pragma unroll
                for (int j = 0; j < 8; ++j) { const auto r_ = __builtin_amdgcn_permlane32_swap(__float_as_uint(s[j]), __float_as_uint(s[j]), false, false); const float pv = __uint_as_float(low ? r_[1] : r_[0]);     const float cs = j < 4 ? c0[j & 3] : c1[j & 3], sn = j < 4 ? s0[j & 3] : s1[j & 3]; s[j] = s[j] * cs + (low ? -pv : pv) * sn; }
            }
            if (hf == 1) {
#pragma unroll
                for (int j = 0; j < 8; ++j) s[j] *= 0.08838834764831845f; }
            o[i].x = cvt_pk_bf16(s[0], s[1]); o[i].y = cvt_pk_bf16(s[2], s[3]); o[i].z = cvt_pk_bf16(s[4], s[5]); o[i].w = cvt_pk_bf16(s[6], s[7]);
            if (hf == 0) *(u32x4*)(QP + (rowb + i) * 512 + cbk * 64 + 8 * cg) = o[i]; else *(u32x4*)(KP + (rowb + i) * 512 + cbk * 64 + 8 * cg) = o[i];
#pragma unroll
            for (int j = 0; j < 8; ++j) { xp[j] = xc[j]; xc[j] = xr[j]; }
        }
        if (hf == 1) {
            bf16* kt = KPT + ((size_t)(b * 4 + hd) * 128 + blk * 64 + 8 * cg) * UTP + u0;
#pragma unroll
            for (int j = 0; j < 8; ++j) { u32x4 tv;
#pragma unroll
                for (int q = 0; q < 4; ++q) { const unsigned a = j < 2 ? o[2 * q].x : j < 4 ? o[2 * q].y : j < 6 ? o[2 * q].z : o[2 * q].w, c = j < 2 ? o[2 * q + 1].x : j < 4 ? o[2 * q + 1].y : j < 6 ? o[2 * q + 1].z : o[2 * q + 1].w;
                    const unsigned w = (j & 1) ? ((a >> 16) | (c & 0xffff0000u)) : ((a & 0xffffu) | (c << 16)); if (q == 0) tv.x = w; else if (q == 1) tv.y = w; else if (q == 2) tv.z = w; else tv.w = w; }
                *(u32x4*)(kt + (size_t)j * UTP) = tv; }
        }
    }
}

__device__ __forceinline__ f32x4 mfma16(bf16x8 a, bf16x8 b, f32x4 c) { return __builtin_amdgcn_mfma_f32_16x16x32_bf16(a, b, c, 0, 0, 0); }
__device__ __forceinline__ float logsig_fast(float x) { return fminf(x, 0.f) - __logf(1.f + __expf(-fabsf(x))); }
__device__ __forceinline__ int chunk_of(int dir, int k) { return dir == 0 ? k : (k < 2 ? 1 - k : 35 - k); }
__device__ __forceinline__ void phase_scan(const Ctx& X, const int dbg) {
    KargP ka = kargs(); unsigned char* const ws = ka->ws; (void)ka; (void)ws;
    int tid_ = X.wave * 64 + lane_id(); asm volatile("" : "+v"(tid_)); const int TID = tid_, LANE = tid_ & 63;
    const int bid = blockIdx.x, chain = (bid & 7) + 8 * (bid >> 5), q4 = (bid >> 3) & 3, b = chain >> 3, h = (chain >> 1) & 3, dir = chain & 1;
    LAS float* gl = (LAS float*)X.lds;
    LAS float* bend = gl + NCHUNK * 128; LAS float* gmx = bend + 64; LAS float* wold = gmx + 64; LAS float* mst = wold + 64; LAS float* mnx = mst + 64;
    const float* GATES = (const float*)(ws + WS_GATES);
    for (int k = X.wave; k < NCHUNK; k += NWAVES) {
        const int c = chunk_of(dir, k), p0 = 2 * LANE, t0 = dir ? 127 - p0 : p0, t1 = dir ? 126 - p0 : p0 + 1;
        const size_t row0 = (size_t)b * UT + 128 * c;
        const float f0 = GATES[(row0 + t0) * 16 + (2 * dir + 1) * 4 + h], f1 = GATES[(row0 + t1) * 16 + (2 * dir + 1) * 4 + h];
        const float i0 = GATES[(row0 + t0) * 16 + (2 * dir) * 4 + h], i1 = GATES[(row0 + t1) * 16 + (2 * dir) * 4 + h];
        const float l0 = logsig_fast(f0), l1 = logsig_fast(f1);
        float v = l0 + l1;
#pragma unroll
        for (int o = 1; o < 64; o <<= 1) { const float t = __shfl_up(v, o); if (LANE >= o) v += t; }
        const float be = __shfl(v, 63), b1 = v, b0 = v - l1;
        const float g0 = be - b0 + i0, g1 = be - b1 + i1;
        float gm = fmaxf(g0, g1);
#pragma unroll
        for (int o = 1; o < 64; o <<= 1) gm = fmaxf(gm, __shfl_xor(gm, o));
        gl[k * 128 + t0] = g0; gl[k * 128 + t1] = g1;
        if (LANE == 0) { bend[k] = be; gmx[k] = gm; }
        if (q4 == 0) {
            const float a0 = i0 - b0, a1 = i1 - b1; float mx = fmaxf(a0, a1);
#pragma unroll
            for (int o = 1; o < 64; o <<= 1) { const float t = __shfl_up(mx, o); if (LANE >= o) mx = fmaxf(mx, t); }
            float mprev = __shfl_up(mx, 1); if (LANE == 0) mprev = -1e30f;
            float* gaw = (float*)(ws + WS_GA) + (size_t)(chain * NCHUNK + k) * 384;
            gaw[t0] = a0; gaw[t1] = a1; gaw[128 + t0] = fmaxf(mprev, a0); gaw[128 + t1] = mx; gaw[256 + t0] = b0; gaw[256 + t1] = b1;
        }
    }
    __syncthreads();
    if (TID == 0) { float m = 0.f; for (int k = 0; k < NCHUNK; ++k) { mst[k] = m; const float mn = fmaxf(bend[k] + m, gmx[k]); wold[k] = __expf(bend[k] + m - mn); mnx[k] = mn; m = mn; } }
    __syncthreads();
    for (int i = TID; i < NCHUNK * 128; i += NTHR) gl[i] = __expf(gl[i] - mnx[i >> 7]);
    if (q4 == 0 && TID < NCHUNK) ((float*)(ws + WS_MST))[chain * NCHUNK + TID] = mst[TID];
    __syncthreads();
    const bf16* KPT = (const bf16*)(ws + WS_KPT); const bf16* MVT = (const bf16*)(ws + WS_MVT); bf16* CST = (bf16*)(ws + WS_CST); float* NST = (float*)(ws + WS_NST);
    const int n = LANE & 15, g = LANE >> 4;
    constexpr int SLOT0 = 20480, SLOTB = 40960;
    const int sr = LANE >> 4, sp = LANE & 15;
    const bf16* ksrc[4];
#pragma unroll
    for (int i = 0; i < 4; ++i) { const int r = 16 * X.wave + 4 * i + sr; ksrc[i] = KPT + ((size_t)(b * 4 + h) * 128 + r) * UTP + 8 * (sp ^ (((r & 3) << 2) | ((r >> 2) & 3))); }
    const bf16* vsrc; { const int r = 4 * X.wave + sr; vsrc = MVT + ((size_t)(b * 4 + h) * 128 + 32 * q4 + r) * UTP + 8 * (sp ^ (((r & 3) << 2) | ((r >> 2) & 3))); }
    unsigned rb[4];
#pragma unroll
    for (int ks = 0; ks < 4; ++ks) rb[ks] = 256u * n + 64u * (unsigned)(ks ^ (n & 3)) + 16u * (unsigned)(g ^ ((n >> 2) & 3));
    f32x4 C0 = {0.f, 0.f, 0.f, 0.f}, C1 = {0.f, 0.f, 0.f, 0.f}, Cn = {0.f, 0.f, 0.f, 0.f};
    bf16x8 ones;
#pragma unroll
    for (int j = 0; j < 8; ++j) ones[j] = (short)0x3F80;
    bf16* const cst_dummy = (bf16*)(ws + WS_DUMMY);
#define SC_DMA(kk) do { const int u_ = 128 * chunk_of(dir, min((kk), NCHUNK - 1)); LAS unsigned char* sl_ = X.lds + SLOT0 + ((kk) % 3) * SLOTB; \
        _Pragma("unroll") for (int i = 0; i < 4; ++i) __builtin_amdgcn_global_load_lds((const unsigned*)(ksrc[i] + u_), (LAS unsigned*)(sl_ + (16 * X.wave + 4 * i) * 256), 16, 0, 0); \
        __builtin_amdgcn_global_load_lds((const unsigned*)(vsrc + u_), (LAS unsigned*)(sl_ + 32768 + 4 * X.wave * 256), 16, 0, 0); } while (0)
#define SC_ST(buf, half) (X.lds + ((buf) ? ((half) ? LDSCTL_OFF + 1024 + 8192 : SLOT0 + 3 * SLOTB) : LDSCTL_OFF + 1024 + 4096 * (half)))
#define SC_STEP(kk, WAITSTR) do { const int k = min((kk), NCHUNK - 1); const bool real = (kk) < NCHUNK; \
        asm volatile(WAITSTR ::: "memory"); __builtin_amdgcn_s_barrier(); asm volatile("" ::: "memory"); \
        SC_DMA((kk) + 2); asm volatile("" ::: "memory"); \
        { const int kp = (kk) - 1, kpc = min(max(kp, 0), NCHUNK - 1); const bool preal = kp >= 0 && kp < NCHUNK; \
          const u32x4 tv = *(const LAS u32x4*)(SC_ST(kp & 1, TID >> 8) + ((TID >> 4) & 15) * 256 + (TID & 15) * 16); \
          bf16* cd = (preal ? CST + (size_t)(chain * NCHUNK + kpc) * 16384 : cst_dummy + (size_t)blockIdx.x * 16384) + (size_t)(32 * q4 + (TID >> 4)) * 128 + (TID & 15) * 8; \
          *(u32x4*)cd = tv; \
          float* ns = real ? NST + (size_t)(chain * NCHUNK + k) * 128 : (float*)(cst_dummy + (size_t)256 * 16384) + (size_t)blockIdx.x * 128; ns[16 * X.wave + n] = Cn[0]; } \
        { LAS unsigned char* s0 = SC_ST((kk) & 1, 0) + (4 * g) * 256 + (16 * X.wave + n) * 2; LAS unsigned char* s1 = SC_ST((kk) & 1, 1) + (4 * g) * 256 + (16 * X.wave + n) * 2; \
          _Pragma("unroll") for (int r = 0; r < 4; ++r) { *(LAS bf16*)(s0 + r * 256) = f2bf(C0[r]); *(LAS bf16*)(s1 + r * 256) = f2bf(C1[r]); } } \
        const float wo = wold[k]; C0 = C0 * wo; C1 = C1 * wo; Cn = Cn * wo; \
        const LAS unsigned char* sl = X.lds + SLOT0 + ((kk) % 3) * SLOTB; \
        _Pragma("unroll") for (int ks = 0; ks < 4; ++ks) { \
            const f32x4 wa = *(const LAS f32x4*)(gl + k * 128 + 32 * ks + 8 * g), wb = *(const LAS f32x4*)(gl + k * 128 + 32 * ks + 8 * g + 4); \
            float kf[8]; unpack8(*(const LAS u32x4*)(sl + 4096 * X.wave + rb[ks]), kf); \
            u32x4 kw; kw.x = cvt_pk_bf16(kf[0] * wa[0], kf[1] * wa[1]); kw.y = cvt_pk_bf16(kf[2] * wa[2], kf[3] * wa[3]); kw.z = cvt_pk_bf16(kf[4] * wb[0], kf[5] * wb[1]); kw.w = cvt_pk_bf16(kf[6] * wb[2], kf[7] * wb[3]); \
            const bf16x8 bfr = __builtin_bit_cast(bf16x8, kw); \
            C0 = mfma16(*(const LAS bf16x8*)(sl + 32768 + rb[ks]), bfr, C0); C1 = mfma16(*(const LAS bf16x8*)(sl + 32768 + 4096 + rb[ks]), bfr, C1); Cn = mfma16(ones, bfr, Cn); } \
        asm volatile("s_waitcnt lgkmcnt(0)" ::: "memory"); } while (0)
    const int kend = (dbg & 64) ? 0 : 36;
    __syncthreads();
    SC_DMA(0); SC_DMA(1);
    if (kend) { SC_STEP(0, "s_waitcnt vmcnt(0)"); SC_STEP(1, "s_waitcnt vmcnt(7)"); SC_STEP(2, "s_waitcnt vmcnt(9)"); }
#pragma unroll 1
    for (int kb = 3; kb < kend; kb += 3) { SC_STEP(kb, "s_waitcnt vmcnt(9)"); SC_STEP(kb + 1, "s_waitcnt vmcnt(9)"); SC_STEP(kb + 2, "s_waitcnt vmcnt(9)"); }
    asm volatile("s_waitcnt vmcnt(0)" ::: "memory"); __syncthreads();
#undef SC_DMA
#undef SC_STEP
#undef SC_ST
}

__device__ __forceinline__ unsigned swz_b(unsigned row, unsigned ch) { return 256u * row + 16u * (ch ^ (((row & 3u) << 2) | ((row >> 2) & 3u))); }
__device__ __forceinline__ void stage_tile128(LAS unsigned char* dst, const char* src, size_t gpitch, int TID) {
#pragma unroll
    for (int i = 0; i < 4; ++i) { const int nn = TID + NTHR * i, row = nn >> 4, ch = nn & 15; const u32x4 v = *(const u32x4*)(src + (size_t)row * gpitch + ch * 16); *(LAS u32x4*)(dst + swz_b(row, ch)) = v; }
}
__device__ __forceinline__ void dma_tile128(LAS unsigned char* dst, const char* src, size_t gpitch, int wave, int LANE) {
    const int sr = LANE >> 4, sp = LANE & 15;
#pragma unroll
    for (int i = 0; i < 4; ++i) { const int rg = i * 8 + wave, r = 4 * rg + sr;
        __builtin_amdgcn_global_load_lds((const unsigned*)(src + (size_t)r * gpitch + 16 * (sp ^ (((r & 3) << 2) | ((r >> 2) & 3)))), (LAS unsigned*)(dst + rg * 1024), 16, 0, 2); }
}
struct MUnit { int b, h, c; };
__device__ __forceinline__ bool munit_of(int v, int l, MUnit& u) {
    const int nun = (l == 0) ? 32 * NCHUNK : 32 * 32; if (v >= nun) return false;
    int bh; if (l == 0) { bh = v / NCHUNK; u.c = v - bh * NCHUNK; } else { bh = v >> 5; u.c = 2 + (v & 31); }
    u.b = bh >> 2; u.h = bh & 3; return true;
}
__device__ __forceinline__ void mlstm_run(const Ctx& X, int l, int TID_, int LANE_) {
    KargP ka = kargs(); unsigned char* const ws = ka->ws;
    const bf16* QP = (const bf16*)(ws + WS_QP); const bf16* KP = (const bf16*)(ws + WS_KP); const bf16* MVT = (const bf16*)(ws + WS_MVT); const bf16* CST = (const bf16*)(ws + WS_CST);
    const float* NST = (const float*)(ws + WS_NST); const float* MST = (const float*)(ws + WS_MST); const float* GA = (const float*)(ws + WS_GA);
    const bf16* PA = (const bf16*)(ws + WS_PA); bf16* ACT = (bf16*)ka->out;
    LAS unsigned char* TK = X.lds; LAS unsigned char* TV = X.lds + 32768; LAS unsigned char* TCF = X.lds + 65536; LAS unsigned char* TCB = X.lds + 98304;
    LAS unsigned char* SIDE = X.lds + LDSCTL_OFF + 1024;
    MUnit cu, nu; int ui = 0;
    if (!munit_of(blockIdx.x, l, cu)) return;
#define MU_DMA_A(U, sbuf) do { const size_t row0_ = (size_t)(U).b * UT + 128 * (U).c; const int chF_ = ((U).b * 4 + (U).h) * 2, jf_ = (U).c, jb_ = (U).c < 2 ? 1 - (U).c : 35 - (U).c; \
        dma_tile128(TK, (const char*)(KP + row0_ * 512 + (U).h * 128), 1024, X.wave, LANE); \
        dma_tile128(TV, (const char*)(MVT + (size_t)((U).b * 4 + (U).h) * 128 * UTP + 128 * (U).c), (size_t)UTP * 2, X.wave, LANE); \
        if (X.wave < 3) { int l32 = LANE & 31, hi_ = LANE >> 5; asm volatile("" : "+v"(l32), "+v"(hi_));     \
            const int ch_ = chF_ + hi_, jj_ = hi_ ? jb_ : jf_; \
            const float* s_ = X.wave == 0 ? GA + (size_t)(ch_ * NCHUNK + jj_) * 384 + 4 * l32 : X.wave == 1 ? NST + (size_t)(ch_ * NCHUNK + jj_) * 128 + 4 * l32 : ka->in[11] + l * 512 + (U).h * 128 + 4 * l32; \
            __builtin_amdgcn_global_load_lds((const unsigned*)s_, (LAS unsigned*)(SIDE + (sbuf) * 4096 + X.wave * 1024), 16, 0, 2); } } while (0)
#define MU_LOAD_P1(U, QF, SC) do { const size_t rowt_ = (size_t)(U).b * UT + 128 * (U).c + t; const int chF_ = ((U).b * 4 + (U).h) * 2, jf_ = (U).c, jb_ = (U).c < 2 ? 1 - (U).c : 35 - (U).c; \
        _Pragma("unroll") for (int ks = 0; ks < 4; ++ks) QF[ks] = *(const u32x4*)(QP + rowt_ * 512 + (U).h * 128 + 32 * ks + 8 * g); \
        const float* gf_ = GA + (size_t)(chF_ * NCHUNK + jf_) * 384; const float* gb_ = GA + (size_t)((chF_ + 1) * NCHUNK + jb_) * 384; \
        SC[0] = gf_[128 + t]; SC[1] = gf_[256 + t]; SC[2] = gb_[128 + t]; SC[3] = gb_[256 + t]; SC[4] = MST[chF_ * NCHUNK + jf_]; SC[5] = MST[(chF_ + 1) * NCHUNK + jb_]; } while (0)
    int TID = TID_, LANE = LANE_; asm volatile("" : "+v"(TID), "+v"(LANE));
    int n = LANE & 15, g = LANE >> 4, t = 16 * (TID >> 6) + n; const int dblk = X.wave >> 1;
    u32x4 qf[4], qn_[4]; float sc[6], scn[6];
    MU_DMA_A(cu, 0); MU_LOAD_P1(cu, qf, sc);
    asm volatile("s_waitcnt vmcnt(0)" ::: "memory"); __syncthreads();
#pragma unroll 1
    for (;;) {
        const int sb = ui & 1;
        LAS float* side = (LAS float*)(SIDE + sb * 4096);
        LAS float* aF = side; LAS float* aB = side + 128; LAS float* nF = side + 256; LAS float* nB = side + 384; LAS float* mnw = side + 512;
        asm volatile("" : "+v"(n), "+v"(g), "+v"(t));
        const size_t rowt = (size_t)cu.b * UT + 128 * cu.c + t;
        const int chF = (cu.b * 4 + cu.h) * 2, jf = cu.c, jb = cu.c < 2 ? 1 - cu.c : 35 - cu.c;
        dma_tile128(TCF, (const char*)(CST + (size_t)(chF * NCHUNK + jf) * 16384), 256, X.wave, LANE);
        dma_tile128(TCB, (const char*)(CST + (size_t)((chF + 1) * NCHUNK + jb) * 16384), 256, X.wave, LANE);
        u32x2 mo[8];
#pragma unroll
        for (int mt = 0; mt < 8; ++mt) mo[mt] = *(const u32x2*)(PA + rowt * 1536 + cu.h * 128 + 16 * mt + 4 * g);
        unsigned rb[4], ka_[4], kb_[4];
#pragma unroll
        for (int ks = 0; ks < 4; ++ks) { const unsigned cx = 64u * (unsigned)(ks ^ (n & 3));
            rb[ks] = 256u * n + cx + 16u * (unsigned)(g ^ ((n >> 2) & 3));
            ka_[ks] = 256u * (8 * (n >> 2) + (n & 3)) + cx + 16u * (unsigned)(g ^ ((2 * (n >> 2)) & 3));
            kb_[ks] = 256u * (8 * (n >> 2) + (n & 3) + 4) + cx + 16u * (unsigned)(g ^ ((2 * (n >> 2) + 1) & 3)); }
        float qnf = 0.f, qnb = 0.f;
#pragma unroll
        for (int ks = 0; ks < 4; ++ks) { float q8[8]; unpack8(qf[ks], q8);
            const f32x4 a0 = *(const LAS f32x4*)(nF + 32 * ks + 8 * g), a1 = *(const LAS f32x4*)(nF + 32 * ks + 8 * g + 4), c0 = *(const LAS f32x4*)(nB + 32 * ks + 8 * g), c1 = *(const LAS f32x4*)(nB + 32 * ks + 8 * g + 4);
#pragma unroll
            for (int j = 0; j < 4; ++j) { qnf += q8[j] * a0[j] + q8[4 + j] * a1[j]; qnb += q8[j] * c0[j] + q8[4 + j] * c1[j]; } }
        qnf = red_hi_add(qnf); qnb = red_hi_add(qnb);
        const float mf = sc[4], mb = sc[5], MFt = fmaxf(mf, sc[0]), bFt = sc[1], MBt = fmaxf(mb, sc[2]), bBt = sc[3];
        float pp[4][8], pdb[8]; float sumF = 0.f, sumB = 0.f;
#pragma unroll
        for (int j = 0; j < 8; ++j) pdb[j] = 0.f;
        f32x4 sA[4], sB[4];
#pragma unroll
        for (int blk = 0; blk < 4; ++blk) { sA[blk] = (f32x4){0.f, 0.f, 0.f, 0.f}; sB[blk] = (f32x4){0.f, 0.f, 0.f, 0.f}; }
#pragma unroll
        for (int ks = 0; ks < 4; ++ks) {
            bf16x8 A0[4], A1[4];
#pragma unroll
            for (int blk = 0; blk < 4; ++blk) { A0[blk] = *(const LAS bf16x8*)(TK + ka_[ks] + blk * 8192); A1[blk] = *(const LAS bf16x8*)(TK + kb_[ks] + blk * 8192); }
#pragma unroll
            for (int blk = 0; blk < 4; ++blk) { sA[blk] = mfma16(A0[blk], __builtin_bit_cast(bf16x8, qf[ks]), sA[blk]); sB[blk] = mfma16(A1[blk], __builtin_bit_cast(bf16x8, qf[ks]), sB[blk]); }
        }
#pragma unroll
        for (int blk = 0; blk < 4; ++blk) {
            const f32x4 sa = sA[blk], sb2 = sB[blk];
            if (blk <= dblk) {
                const f32x4 af0 = *(const LAS f32x4*)(aF + 32 * blk + 8 * g), af1 = *(const LAS f32x4*)(aF + 32 * blk + 8 * g + 4);
#pragma unroll
                for (int j = 0; j < 8; ++j) { const int s = 32 * blk + 8 * g + j; const float sv = j < 4 ? sa[j & 3] : sb2[j & 3]; const float afs = j < 4 ? af0[j & 3] : af1[j & 3];
                    const float v = (s <= t) ? sv * __expf(afs - MFt) : 0.f; pp[blk][j] = v; sumF += v; }
            }
            if (blk >= dblk) {
                const f32x4 ab0 = *(const LAS f32x4*)(aB + 32 * blk + 8 * g), ab1 = *(const LAS f32x4*)(aB + 32 * blk + 8 * g + 4);
#pragma unroll
                for (int j = 0; j < 8; ++j) { const int s = 32 * blk + 8 * g + j; const float sv = j < 4 ? sa[j & 3] : sb2[j & 3]; const float abs_ = j < 4 ? ab0[j & 3] : ab1[j & 3];
                    const float v = (s >= t) ? sv * __expf(abs_ - MBt) : 0.f; if (blk == dblk) pdb[j] = v; else pp[blk][j] = v; sumB += v; }
            }
        }
        sumF = red_hi_add(sumF); sumB = red_hi_add(sumB);
        const float wiF = __expf(mf - MFt), wiB = __expf(mb - MBt);
        const float rF = 1.f / fmaxf(fabsf(sumF + wiF * qnf), __expf(-bFt - MFt)), rB = 1.f / fmaxf(fabsf(sumB + wiB * qnb), __expf(-bBt - MBt));
        bf16x8 pfr[4];
#pragma unroll
        for (int blk = 0; blk < 4; ++blk) { const float s1 = blk <= dblk ? rF : rB; const float sd = blk == dblk ? rB : 0.f; float q[8];
#pragma unroll
            for (int j = 0; j < 8; ++j) q[j] = pp[blk][j] * s1 + pdb[j] * sd;
            u32x4 w; w.x = cvt_pk_bf16(q[0], q[1]); w.y = cvt_pk_bf16(q[2], q[3]); w.z = cvt_pk_bf16(q[4], q[5]); w.w = cvt_pk_bf16(q[6], q[7]); pfr[blk] = __builtin_bit_cast(bf16x8, w); }
        const float cF = wiF * rF, cB = wiB * rB;
        f32x4 O[8];
#pragma unroll
        for (int mt = 0; mt < 8; ++mt) O[mt] = (f32x4){0.f, 0.f, 0.f, 0.f};
#pragma unroll
        for (int ks = 0; ks < 4; ++ks) { bf16x8 Af[8];
#pragma unroll
            for (int mt = 0; mt < 8; ++mt) Af[mt] = *(const LAS bf16x8*)(TV + rb[ks] + mt * 4096);
#pragma unroll
            for (int mt = 0; mt < 8; ++mt) O[mt] = mfma16(Af[mt], pfr[ks], O[mt]); }
        asm volatile("s_waitcnt vmcnt(0) lgkmcnt(0)" ::: "memory"); __syncthreads();
        const bool has_next = munit_of(blockIdx.x + X.G * (ui + 1), l, nu);
        if (has_next) { MU_DMA_A(nu, sb ^ 1); MU_LOAD_P1(nu, qn_, scn); }
        float ss = 0.f;
#pragma unroll
        for (int hh = 0; hh < 2; ++hh) { f32x4 aF_[4], aB_[4];
#pragma unroll
          for (int m4 = 0; m4 < 4; ++m4) { aF_[m4] = (f32x4){0.f, 0.f, 0.f, 0.f}; aB_[m4] = (f32x4){0.f, 0.f, 0.f, 0.f}; }
#pragma unroll
          for (int ks = 0; ks < 4; ++ks) { bf16x8 Cf[4], Cb[4];
#pragma unroll
            for (int m4 = 0; m4 < 4; ++m4) { Cf[m4] = *(const LAS bf16x8*)(TCF + rb[ks] + (4 * hh + m4) * 4096); Cb[m4] = *(const LAS bf16x8*)(TCB + rb[ks] + (4 * hh + m4) * 4096); }
#pragma unroll
            for (int m4 = 0; m4 < 4; ++m4) { aF_[m4] = mfma16(Cf[m4], __builtin_bit_cast(bf16x8, qf[ks]), aF_[m4]); aB_[m4] = mfma16(Cb[m4], __builtin_bit_cast(bf16x8, qf[ks]), aB_[m4]); } }
#pragma unroll
          for (int m4 = 0; m4 < 4; ++m4) { const int mt = 4 * hh + m4; O[mt] = O[mt] + cF * aF_[m4] + cB * aB_[m4];
            ss += (O[mt][0] * O[mt][0] + O[mt][1] * O[mt][1]) + (O[mt][2] * O[mt][2] + O[mt][3] * O[mt][3]); } }
        ss = red_hi_add(ss);
        const float rstd = rsqrtf(ss * (1.f / 128.f) + EPS);
#pragma unroll
        for (int mt = 0; mt < 8; ++mt) { const int dv0 = 16 * mt + 4 * g; const f32x4 w4 = *(const LAS f32x4*)(mnw + dv0);
            const float g0 = __uint_as_float(mo[mt].x << 16), g1 = __uint_as_float(mo[mt].x & 0xffff0000u), g2 = __uint_as_float(mo[mt].y << 16), g3 = __uint_as_float(mo[mt].y & 0xffff0000u);
            const float o0 = O[mt][0] * rstd * w4[0] * __builtin_amdgcn_rcpf(1.f + __expf(-g0)), o1 = O[mt][1] * rstd * w4[1] * __builtin_amdgcn_rcpf(1.f + __expf(-g1));
            const float o2 = O[mt][2] * rstd * w4[2] * __builtin_amdgcn_rcpf(1.f + __expf(-g2)), o3 = O[mt][3] * rstd * w4[3] * __builtin_amdgcn_rcpf(1.f + __expf(-g3));
            u32x2 w; w.x = cvt_pk_bf16(o0, o1); w.y = cvt_pk_bf16(o2, o3); *(u32x2*)(ACT + rowt * 1024 + cu.h * 128 + dv0) = w; }
        asm volatile("s_waitcnt vmcnt(0) lgkmcnt(0)" ::: "memory"); __syncthreads();
        if (!has_next) break;
        cu = nu; ++ui;
#pragma unroll
        for (int ks = 0; ks < 4; ++ks) qf[ks] = qn_[ks];
#pragma unroll
        for (int j = 0; j < 6; ++j) sc[j] = scn[j];
    }
#undef MU_DMA_A
#undef MU_LOAD_P1
}

constexpr float NA_C2 = 0.125f * 1.4426950408889634f;
template <bool PARTIAL>
__device__ __forceinline__ void na_ctx_tile(LAS unsigned char* CK, LAS unsigned char* CV, const u32x4 qf0, const u32x4 qf1  , bf16* orow  , float* pm, int n, int g) {
    u32x4 qf[2]; qf[0] = qf0; qf[1] = qf1;
    const unsigned ka0 = (unsigned)(8 * (n >> 2) + (n & 3)) * 144u + 16u * g, ka1 = ka0 + 4u * 144u, vb = (unsigned)n * 528u + 16u * g;
    f32x4 s[8][2]; float mx = -1e30f;
#pragma unroll
    for (int blk = 0; blk < 8; ++blk) { s[blk][0] = (f32x4){0.f, 0.f, 0.f, 0.f}; s[blk][1] = (f32x4){0.f, 0.f, 0.f, 0.f}; }
#pragma unroll
    for (int ks = 0; ks < 2; ++ks)
#pragma unroll
        for (int hb = 0; hb < 4; ++hb) { bf16x8 A0[2], A1[2];
#pragma unroll
            for (int b4 = 0; b4 < 2; ++b4) { A0[b4] = *(const LAS bf16x8*)(CK + ka0 + (2 * hb + b4) * 4608 + ks * 64); A1[b4] = *(const LAS bf16x8*)(CK + ka1 + (2 * hb + b4) * 4608 + ks * 64); }
#pragma unroll
            for (int b4 = 0; b4 < 2; ++b4) { s[2 * hb + b4][0] = mfma16(A0[b4], __builtin_bit_cast(bf16x8, qf[ks]), s[2 * hb + b4][0]); s[2 * hb + b4][1] = mfma16(A1[b4], __builtin_bit_cast(bf16x8, qf[ks]), s[2 * hb + b4][1]); } }
#pragma unroll
    for (int blk = 0; blk < 8; ++blk)
        mx = fmaxf(mx, fmaxf(fmaxf(fmaxf(s[blk][0][0], s[blk][0][1]), fmaxf(s[blk][0][2], s[blk][0][3])), fmaxf(fmaxf(s[blk][1][0], s[blk][1][1]), fmaxf(s[blk][1][2], s[blk][1][3]))));
    mx = red_hi_max(mx) * NA_C2;
    float sum = 0.f; bf16x8 pfr[8];
#pragma unroll
    for (int blk = 0; blk < 8; ++blk) { float e[8];
#pragma unroll
        for (int j = 0; j < 8; ++j) { e[j] = __builtin_amdgcn_exp2f(__builtin_fmaf(s[blk][j >> 2][j & 3], NA_C2, -mx)); sum += e[j]; }
        u32x4 w; w.x = cvt_pk_bf16(e[0], e[1]); w.y = cvt_pk_bf16(e[2], e[3]); w.z = cvt_pk_bf16(e[4], e[5]); w.w = cvt_pk_bf16(e[6], e[7]); pfr[blk] = __builtin_bit_cast(bf16x8, w); }
    sum = red_hi_add(sum);
    const float inv = 1.f / sum;
    f32x4 oo[4];
#pragma unroll
    for (int mt = 0; mt < 4; ++mt) oo[mt] = (f32x4){0.f, 0.f, 0.f, 0.f};
#pragma unroll
    for (int b2 = 0; b2 < 4; ++b2) { bf16x8 Vf[2][4];
#pragma unroll
        for (int q = 0; q < 2; ++q)
#pragma unroll
            for (int mt = 0; mt < 4; ++mt) Vf[q][mt] = *(const LAS bf16x8*)(CV + vb + mt * 8448 + (2 * b2 + q) * 64);
#pragma unroll
        for (int q = 0; q < 2; ++q)
#pragma unroll
            for (int mt = 0; mt < 4; ++mt) oo[mt] = mfma16(Vf[q][mt], pfr[2 * b2 + q], oo[mt]); }
#pragma unroll
    for (int mt = 0; mt < 4; ++mt) { const f32x4 o = oo[mt]; u32x2 w; w.x = cvt_pk_bf16(o[0] * inv, o[1] * inv); w.y = cvt_pk_bf16(o[2] * inv, o[3] * inv); *(u32x2*)(orow + 16 * mt + 4 * g) = w; }
    if (PARTIAL && g == 0) { pm[0] = mx; pm[1] = sum; }
}
__device__ __forceinline__ void na_job(const Ctx& X, int job, int l, int TID, int LANE) {
    KargP ka = kargs(); unsigned char* const ws = ka->ws;
    asm volatile("" : "+v"(TID), "+v"(LANE));
    const int bhd = job >> 2, qq = job & 3, b = bhd >> 3, hd = bhd & 7, n_ = LANE & 15, g_ = LANE >> 4;
    const bf16* PA = (const bf16*)(ws + WS_PA); const bf16* NVT = (const bf16*)(ws + WS_NVT); bf16* ACT = (bf16*)ka->out;
    bf16* PARTO = (bf16*)(ws + WS_PARTO) + (size_t)bhd * 4096 * 64; float* PARTM = (float*)(ws + WS_PARTM) + (size_t)bhd * 4096 * 2;
    const bf16* vtb = NVT + (size_t)(b * 8 + hd) * 64 * UTP;
    LAS unsigned char* CK = X.lds; LAS unsigned char* CV = X.lds + 36864; LAS float* rpbL = (LAS float*)(X.lds + LDSCTL_OFF + 4096);
#pragma unroll
    for (int i = 0; i < 4; ++i) { const int nn = TID + NTHR * i, key = nn >> 3, ch = nn & 7; *(LAS u32x4*)(CK + key * 144 + ch * 16) = *(const u32x4*)(PA + ((size_t)b * UT + key) * 1536 + 1024 + hd * 64 + ch * 8); }
#pragma unroll
    for (int i = 0; i < 4; ++i) { const int nn = TID + NTHR * i, dv = nn >> 5, ch = nn & 31; *(LAS u32x4*)(CV + dv * 528 + ch * 16) = *(const u32x4*)(vtb + (size_t)dv * UTP + ch * 8); }
    if (TID < 528) rpbL[TID] = (TID >= 16 && TID < 481) ? (ka->in[12] + (size_t)l * 8 * 465 + hd * 465)[TID - 16] * 1.4426950408889634f : 0.f;
    __syncthreads();
#ifndef NA_SKIP_C
#define NA_QPTR(un_) (PA + ((size_t)b * UT + CTXL + (size_t)((16 * qq + 2 * (un_) + (X.wave >> 2)) * 64 + 16 * (X.wave & 3) + n_)) * 1536 + 512 + hd * 64 + 8 * g_)
    { u32x4 qc0 = *(const u32x4*)NA_QPTR(0), qc1 = *(const u32x4*)(NA_QPTR(0) + 32);
#pragma unroll 1
    for (int un = 0; un < 8; ++un) { int n = n_, g = g_; asm volatile("" : "+v"(n), "+v"(g)); const int r = 16 * qq + 2 * un + (X.wave >> 2), tq = r * 64 + 16 * (X.wave & 3) + n;
        const u32x4 q0 = qc0, q1 = qc1; const int un1 = min(un + 1, 7); qc0 = *(const u32x4*)NA_QPTR(un1); qc1 = *(const u32x4*)(NA_QPTR(un1) + 32);
        na_ctx_tile<true>(CK, CV, q0, q1, PARTO + (size_t)tq * 64, PARTM + (size_t)tq * 2, n, g); } }
    if (l == 0 && qq < 2) { const int n = n_, g = g_; const size_t row = (size_t)b * UT + 128 * qq + 16 * X.wave + n; const bf16* qrow = PA + row * 1536 + 512 + hd * 64 + 8 * g;
        na_ctx_tile<false>(CK, CV, *(const u32x4*)qrow, *(const u32x4*)(qrow + 32), ACT + row * 1024 + 512 + hd * 64, nullptr, n, g); }
#endif
    __syncthreads();
#ifndef NA_SKIP_W
    LAS unsigned char* WK = X.lds; LAS unsigned char* WV = X.lds + 73728;
    int have_hi = -1;
    u32x4 pk_[2], pv_[2];
    const int skey = TID >> 3, sch = TID & 7;
#define NA_ROW_LOAD(kr, KD, VD) do { const size_t tok_ = (size_t)b * UT + CTXL + (size_t)(kr) * 64; \
        KD = *(const u32x4*)(PA + (tok_ + skey) * 1536 + 1024 + hd * 64 + sch * 8); VD = *(const u32x4*)(vtb + (size_t)skey * UTP + CTXL + (kr) * 64 + sch * 8); } while (0)
#define NA_ROW_STORE(kr, KD, VD) do { const int sl_ = (kr) % 9; *(LAS u32x4*)(WK + (sl_ * 64 + skey) * 128 + ((sch ^ (skey & 7)) * 16)) = KD; \
        *(LAS u32x4*)(WV + skey * 1152 + (sl_ * 8 + (sch ^ (skey & 7))) * 16) = VD; } while (0)
    {
        const int r0 = 16 * qq, rs_lo = min(max(r0 - 4, 0), 56), nrows = min(9, 64 - rs_lo);
        for (int kr = rs_lo; kr < rs_lo + nrows; ++kr) { u32x4 kd, vd; NA_ROW_LOAD(kr, kd, vd); NA_ROW_STORE(kr, kd, vd); }
        have_hi = rs_lo + nrows - 1;
    }
    __syncthreads();
    u32x4 qn0, qn1; float mcn, lcn; u32x2 pcn[4];
#define NA_UNIT_LOAD(un_) do { const int tq_ = (16 * qq + 2 * (un_) + (X.wave >> 2)) * 64 + 16 * (X.wave & 3) + n_; \
        qn0 = *(const u32x4*)NA_QPTR(un_); qn1 = *(const u32x4*)(NA_QPTR(un_) + 32); mcn = PARTM[(size_t)tq_ * 2]; lcn = PARTM[(size_t)tq_ * 2 + 1]; \
        _Pragma("unroll") for (int mt_ = 0; mt_ < 4; ++mt_) pcn[mt_] = *(const u32x2*)(PARTO + (size_t)tq_ * 64 + 16 * mt_ + 4 * g_); } while (0)
    NA_UNIT_LOAD(0);
#pragma unroll 1
    for (int un = 0; un < 8; ++un) {
        const int r0 = 16 * qq + 2 * un;
        u32x4 qf[2]; qf[0] = qn0; qf[1] = qn1; const float m_c = mcn, l_c = lcn; u32x2 pc_[4];
#pragma unroll
        for (int mt = 0; mt < 4; ++mt) pc_[mt] = pcn[mt];
        NA_UNIT_LOAD(min(un + 1, 7));
        int nnew = 0, new0 = 0;
        if (un < 7) { const int r1 = r0 + 2, lo1 = min(max(r1 - 4, 0), 56), hi1 = lo1 + min(9, 64 - lo1) - 1; nnew = hi1 - have_hi; new0 = have_hi + 1; }
        if (nnew > 0) NA_ROW_LOAD(new0, pk_[0], pv_[0]);
        if (nnew > 1) NA_ROW_LOAD(new0 + 1, pk_[1], pv_[1]);
        {
            int n = n_, g = g_; asm volatile("" : "+v"(n), "+v"(g));
            const int r = r0 + (X.wave >> 2), c0 = 16 * (X.wave & 3), rs = min(max(r - 4, 0), 56), cs0 = min(max(c0 - 8, 0), 32);
            const int c = c0 + n, csq = min(max(c - 8, 0), 48), tq = r * 64 + c; const size_t row = (size_t)b * UT + CTXL + tq;
            const unsigned kb0 = (unsigned)(cs0 + 8 * (n >> 2) + (n & 3)) * 128u + 16u * (unsigned)(g ^ (n & 3)), kb1 = kb0 + 4u * 128u;
            const unsigned vb = (unsigned)n * 1152u + 16u * (unsigned)(((cs0 >> 3) + g) ^ (n & 7));
            const int dk0 = cs0 + 8 * g - csq;
            const LAS float* rpl = rpbL + 16 + (rs - r + 7) * 31 + (cs0 + 8 * g - c + 15);
            f32x4 s[8][2]; float mx = m_c;
            int slot[8];
#pragma unroll
            for (int i = 0; i < 8; ++i) slot[i] = (rs + i) % 9;
#pragma unroll
            for (int i = 0; i < 8; ++i) {
                f32x4 sa = {0.f, 0.f, 0.f, 0.f}, sb = {0.f, 0.f, 0.f, 0.f};
#pragma unroll
                for (int ks = 0; ks < 2; ++ks) { sa = mfma16(*(const LAS bf16x8*)(WK + kb0 + slot[i] * 8192 + 64 * ks), __builtin_bit_cast(bf16x8, qf[ks]), sa);
                    sb = mfma16(*(const LAS bf16x8*)(WK + kb1 + slot[i] * 8192 + 64 * (ks ^ 1)), __builtin_bit_cast(bf16x8, qf[ks]), sb); }
                const LAS float* bp = rpl + i * 31;
#pragma unroll
                for (int j = 0; j < 8; ++j) { const bool ok = (unsigned)(dk0 + j) < 16u; const float bias = bp[j]; const float sv = (j < 4 ? sa[j & 3] : sb[j & 3]);
                    const float x = ok ? __builtin_fmaf(sv, NA_C2, bias) : -1e30f; s[i][j >> 2][j & 3] = x; mx = fmaxf(mx, x); }
                asm volatile("" ::: "memory");
            }
            mx = red_hi_max(mx);
            float sum = 0.f; bf16x8 pfr[8];
#pragma unroll
            for (int i = 0; i < 8; ++i) { float e[8];
#pragma unroll
                for (int j = 0; j < 8; ++j) { e[j] = __builtin_amdgcn_exp2f(s[i][j >> 2][j & 3] - mx); sum += e[j]; }
                u32x4 w; w.x = cvt_pk_bf16(e[0], e[1]); w.y = cvt_pk_bf16(e[2], e[3]); w.z = cvt_pk_bf16(e[4], e[5]); w.w = cvt_pk_bf16(e[6], e[7]); pfr[i] = __builtin_bit_cast(bf16x8, w); }
            sum = red_hi_add(sum);
            const float wc = __builtin_amdgcn_exp2f(m_c - mx) * l_c, inv = 1.f / (wc + sum);
#pragma unroll
            for (int mt = 0; mt < 4; ++mt) { f32x4 o = {0.f, 0.f, 0.f, 0.f};
#pragma unroll
                for (int i = 0; i < 8; ++i) o = mfma16(*(const LAS bf16x8*)(WV + vb + mt * 18432 + slot[i] * 128), pfr[i], o);
                const u32x2 pc = pc_[mt];
                const float p0 = __uint_as_float(pc.x << 16), p1 = __uint_as_float(pc.x & 0xffff0000u), p2 = __uint_as_float(pc.y << 16), p3 = __uint_as_float(pc.y & 0xffff0000u);
                u32x2 w; w.x = cvt_pk_bf16((o[0] + wc * p0) * inv, (o[1] + wc * p1) * inv); w.y = cvt_pk_bf16((o[2] + wc * p2) * inv, (o[3] + wc * p3) * inv);
                *(u32x2*)(ACT + row * 1024 + 512 + hd * 64 + 16 * mt + 4 * g) = w; }
        }
        __syncthreads();
        if (nnew > 0) NA_ROW_STORE(new0, pk_[0], pv_[0]);
        if (nnew > 1) NA_ROW_STORE(new0 + 1, pk_[1], pv_[1]);
        if (nnew > 0) have_hi += nnew;
        __syncthreads();
    }
#undef NA_ROW_LOAD
#undef NA_ROW_STORE
#undef NA_UNIT_LOAD
#endif
}
__device__ __forceinline__ void phase_mix(const Ctx& X, int l, int flags) {
    int tid_ = X.wave * 64 + lane_id(); asm volatile("" : "+v"(tid_)); const int TID = tid_, LANE = tid_ & 63;
#ifdef MIXONLY
    flags &= MIXONLY;
#endif
    if (flags & 1) mlstm_run(X, l, TID, LANE);
    if (flags & 2) { for (int job = blockIdx.x; job < 256; job += X.G) na_job(X, job, l, TID, LANE); }
}

#ifndef CPH
#define CPH 0xFFFFFFFFu
#endif
#define CEN(bit) ((CPH >> (bit)) & 1u)
#define IN(k) (lo <= (k) && (k) < hi)
#define SEAM(k) do { if (IN(k) && IN((k) + 1)) xcd_barrier(bar, LEADER); } while (0)
#ifndef REPMASK
#define REPMASK 0u
#endif
#define REP(bit) for (int rep_ = 0; rep_ < ((((REPMASK) >> (bit)) & 1u) ? 2 : 1); ++rep_)
#define REPBAR if (rep_) xcd_barrier(bar, LEADER)
template <int l>
__device__ __forceinline__ void layer_body(const Ctx& X, const XcdBarrier& bar, const int lo, const int hi, const int mixflags) {
#define LEADER (X.wave == 0 && lane_id() == 0)

        const int pb = 1 + 10 * l; const bool last = (l == 1);
        if (CEN(1) && IN(pb + K_NORM1)) REP(1) { REPBAR;
            KargP ka = kargs(); unsigned char* const ws = ka->ws; float* MOD = (float*)(ws + WS_MOD);
            if (l == 0) { rows_phase<false, false, false>(X, ka->in[0], ka->in[2], nullptr, ka->in[6], MOD, 0, 1, nullptr, false, 0); __syncthreads(); phase_wconv(X); }
            else rows_phase<true, false, false, false, true>(X, nullptr, nullptr, nullptr, ka->in[6] + 1024, MOD + (size_t)9 * 6144, 0, 1, MOD, false, 0, mixflags);
        } SEAM(pb + K_NORM1);
        if (CEN(2) && IN(pb + K_GEMM_IN)) REP(2) { REPBAR;
            KargP ka = kargs(); unsigned char* const ws = ka->ws;
            SchedIn S; S.init(136, 15, X.G, (int)blockIdx.x); S.A = (const char*)ka->out; S.B = (const char*)(ws + WS_WIN) + (size_t)l * 3840 * 1024 * 2; S.tstep = (size_t)256 * 1024 * 2;
            EpiInP E{(bf16*)(ws + WS_QKRAW), (bf16*)(ws + WS_PA), (bf16*)(ws + WS_MVT), (bf16*)(ws + WS_NVT), (float*)(ws + WS_GATES), ka->in[10] + l * 16, mixflags};
            pg8::gemm_phase<EpiInP, SchedIn>(X.lds, 1024, S, E, X.wave);
        } SEAM(pb + K_GEMM_IN);
        if (CEN(3) && IN(pb + K_PREP)) REP(3) { REPBAR; phase_prep(X, l); } SEAM(pb + K_PREP);
        if (CEN(4) && IN(pb + K_SCAN)) REP(4) { REPBAR; phase_scan(X, mixflags); } SEAM(pb + K_SCAN);
        if (CEN(5) && IN(pb + K_MIX)) REP(5) { REPBAR; phase_mix(X, l, mixflags); } SEAM(pb + K_MIX);
        if (CEN(6) && IN(pb + K_GEMM_OUT)) REP(6) { REPBAR;
            KargP ka = kargs(); unsigned char* const ws = ka->ws;
            EpiOutP E{(bf16*)(ws + WS_Y)};
            SchedLatent S; S.init(last ? 128 : 136, 4, X.G, (int)blockIdx.x); S.lat = last ? 1 : 0; S.A = (const char*)ka->out; S.B = (const char*)(ws + WS_WOUT) + (size_t)l * 1024 * 1024 * 2; S.tstep = (size_t)256 * 1024 * 2;
            pg8::gemm_phase<EpiOutP, SchedLatent>(X.lds, 1024, S, E, X.wave);
            if (l == 0 && (int)blockIdx.x >= 32) convert_experts(X, 0, 0, CONV_TAIL_OUT, ((int)blockIdx.x - 32) * NWAVES + X.wave, 224 * NWAVES);
        } SEAM(pb + K_GEMM_OUT);
        if (CEN(7) && IN(pb + K_NORM2)) REP(7) { REPBAR;
            { KargP ka = kargs(); unsigned char* const ws = ka->ws;
              rows_phase<false, true, false, true, l != 0>(X, ka->in[0], ka->in[2], nullptr,
                                                   ka->in[14] + l * 1024, (const float*)(ws + WS_MOD) + (size_t)l * 9 * 6144, 3, 4, nullptr, last, l, mixflags); }
            __syncthreads();
            if (!(mixflags & 256)) {
                int first = CONV_TAIL_OUT;
                if (l == 1) { KargP ka = kargs(); const int nt0 = (int)ld_u32((unsigned*)ka->ws + CW_NT), rem = (nt0 * 4) % X.G, nf = rem ? X.G - rem : 0; first = nf * NWAVES * 6; }
                convert_experts(X, l, first, 1 << 30, X.gw, X.ngw); }
        } SEAM(pb + K_NORM2);
        if (CEN(8) && IN(pb + K_SLOTS)) REP(8) { REPBAR; phase_slots(X, l, last); } SEAM(pb + K_SLOTS);
        if constexpr (l == 0) {
        if (CEN(9) && IN(pb + K_MOE1)) REP(9) { REPBAR;
            KargP ka = kargs(); unsigned char* const ws = ka->ws;
            const int nt = (int)ld_u32((unsigned*)ws + CW_NT + 32 * l);
            SchedMoeG S; S.init(nt, 4, X.G, (int)blockIdx.x); S.one_pm = -1; S.one_pn = 0; S.A = (const char*)ka->out; S.B = (const char*)(ws + (l ? WS_EW13_L1 : WS_EW13)); S.tstepB = (size_t)256 * 1024 * 2;
            S.TILE_E = (const int*)(ws + WS_ROUTE + RT_TILE_E) + 512 * l; S.SLOT_TOK = (const int*)(ws + WS_ROUTE + RT_SLOT_TOK);
            EpiMoe1 E{(bf16*)(ws + WS_ACTM)};
            pg8::gemm_phase<EpiMoe1, SchedMoeG, true, true, true>(X.lds, 1024, S, E, X.wave);
            { const int rem = (nt * 4) % X.G, nf = X.G - rem; if (l == 0 && rem != 0 && (int)blockIdx.x >= rem) convert_experts(X, 1, 0, nf * NWAVES * 4, ((int)blockIdx.x - rem) * NWAVES + X.wave, nf * NWAVES); }
        } SEAM(pb + K_MOE1);
        if (CEN(10) && IN(pb + K_MOE2)) REP(10) { REPBAR;
            KargP ka = kargs(); unsigned char* const ws = ka->ws;
            const int nt = (int)ld_u32((unsigned*)ws + CW_NT + 32 * l);
            SchedMoe S; S.init(nt, 4, X.G, (int)blockIdx.x); S.A = (const char*)(ws + WS_ACTM); S.B = (const char*)(ws + (l ? WS_EW2_L1 : WS_EW2)); S.tstep = (size_t)256 * 512 * 2; S.TILE_E = (const int*)(ws + WS_ROUTE + RT_TILE_E) + 512 * l;
            EpiMoe2 E{(bf16*)(ws + WS_Y)};
            pg8::gemm_phase<EpiMoe2, SchedMoe>(X.lds, 512, S, E, X.wave);
            { const int rem = (nt * 4) % X.G, nf = X.G - rem; if (l == 0 && rem != 0 && (int)blockIdx.x >= rem) convert_experts(X, 1, nf * NWAVES * 4, nf * NWAVES * 6, ((int)blockIdx.x - rem) * NWAVES + X.wave, nf * NWAVES); }
        } SEAM(pb + K_MOE2);
        } else {
        int T0 = 0, rem = 0;
        { KargP ka = kargs(); const int nt = (int)ld_u32((unsigned*)ka->ws + CW_NT + 32 * l), nt4 = nt * 4; rem = nt4 % X.G; T0 = (nt4 - rem) / 4; if (rem * 3 > X.G) { rem = 0; T0 = nt; } }
#pragma unroll 1
        for (int pass = 0; pass < 2; ++pass) {
            if (pass == 1) SEAM(pb + K_MOE1);
            const bool run = pass == 0 ? (CEN(9) && IN(pb + K_MOE1)) : (CEN(10) && IN(pb + K_MOE2) && (int)blockIdx.x < rem);
            if (run) {
                KargP ka = kargs(); unsigned char* const ws = ka->ws;
                SchedMoeG S; S.init(T0, 4, X.G, (int)blockIdx.x); S.one_pm = pass ? T0 + ((int)blockIdx.x >> 2) : -1; S.one_pn = (int)blockIdx.x & 3;
                S.A = (const char*)ka->out; S.B = (const char*)(ws + WS_EW13_L1); S.tstepB = (size_t)256 * 1024 * 2;
                S.TILE_E = (const int*)(ws + WS_ROUTE + RT_TILE_E) + 512 * l; S.SLOT_TOK = (const int*)(ws + WS_ROUTE + RT_SLOT_TOK);
                EpiMoe1 E{(bf16*)(ws + WS_ACTM)};
                pg8::gemm_phase<EpiMoe1, SchedMoeG, true, true, true>(X.lds, 1024, S, E, X.wave);
                if (pass == 1 && LEADER) { __builtin_amdgcn_fence(__ATOMIC_RELEASE, "agent"); __hip_atomic_fetch_add((unsigned*)ws + CW_DEP, 1u, __ATOMIC_RELAXED, __HIP_MEMORY_SCOPE_AGENT); }
            }
        }
        if (CEN(10) && IN(pb + K_MOE2)) {
            KargP ka = kargs(); unsigned char* const ws = ka->ws;
            SchedMoeDep S; S.init(T0, 4, X.G, (int)blockIdx.x); S.rem = rem; S.T0 = T0; S.cp = X.G - 1 - (int)blockIdx.x; S.dep = (const unsigned*)ws + CW_DEP;
            S.A = (const char*)(ws + WS_ACTM); S.B = (const char*)(ws + WS_EW2_L1); S.tstep = (size_t)256 * 512 * 2; S.TILE_E = (const int*)(ws + WS_ROUTE + RT_TILE_E) + 512 * l;
            EpiMoe2 E{(bf16*)(ws + WS_Y)};
            pg8::gemm_phase<EpiMoe2, SchedMoeDep>(X.lds, 512, S, E, X.wave);
        } SEAM(pb + K_MOE2);
        }
    }
__global__ void __launch_bounds__(NTHR, 2) mk_fwd(Args args) {
    extern __shared__ __attribute__((aligned(16))) unsigned char lds_raw[];
    Ctx X;
    X.lds = (LAS unsigned char*)lds_raw; X.wave = __builtin_amdgcn_readfirstlane(threadIdx.x >> 6); X.G = gridDim.x;
    X.gw = blockIdx.x * NWAVES + X.wave; X.ngw = X.G * NWAVES;
    volatile LAS unsigned* MISC = (volatile LAS unsigned*)(X.lds + MISC_OFF);
    for (int u = X.wave * 64 + lane_id(); u < (LDS_BYTES - LDSCTL_OFF) / 4; u += NTHR) ((LAS unsigned*)(X.lds + LDSCTL_OFF))[u] = 0u;
    __syncthreads();
    const int lo = args.ph_lo, hi = args.ph_hi;
    XcdBarrier bar; bar.bar = (unsigned*)(args.ws + WS_CTL) + CW_BAR + args.bar_region * XCD_BAR_WORDS; bar.x = 0; bar.st = nullptr;
    if (hi - lo > 1) bar = xcd_barrier_post((unsigned*)(args.ws + WS_CTL) + CW_BAR + args.bar_region * XCD_BAR_WORDS, MISC + 8, LEADER);

    if (CEN(0) && IN(PH_PRO)) { phase_prologue(X); } SEAM(PH_PRO);

    layer_body<0>(X, bar, lo, hi, args.mixflags);
    layer_body<1>(X, bar, lo, hi, args.mixflags);
    if (CEN(11) && IN(PH_FINAL)) { KargP ka = kargs(); unsigned char* const ws = ka->ws;
        rows_phase<true, false, true, false, true>(X, nullptr, nullptr, ka->out, ka->in[20], nullptr, 0, 0, (const float*)(ws + WS_MOD) + (size_t)9 * 6144, true, 1); }
#undef IN
#undef SEAM
}
constexpr unsigned PM_PRO = 1u << 0, PM_NORM1 = 1u << 1, PM_GEMM_IN = 1u << 2, PM_PREP = 1u << 3, PM_SCAN = 1u << 4, PM_MIX = 1u << 5, PM_GEMM_OUT = 1u << 6, PM_NORM2 = 1u << 7,
                   PM_SLOTS = 1u << 8, PM_MOE1 = 1u << 9, PM_MOE2 = 1u << 10, PM_FINAL = 1u << 11;
#ifndef PMASK
#define PMASK (PM_PRO | PM_NORM1 | PM_GEMM_IN | PM_PREP | PM_SCAN | PM_MIX | PM_GEMM_OUT | PM_NORM2 | PM_SLOTS | PM_MOE1 | PM_MOE2 | PM_FINAL)
#endif
#ifndef MIXFLAGS
#define MIXFLAGS 3
#endif
static bool persist_phase(int ph) { if (ph == PH_PRO) return (PMASK & PM_PRO) != 0; if (ph == PH_FINAL) return (PMASK & PM_FINAL) != 0; return (PMASK & (2u << ((ph - 1) % 10))) != 0; }

extern "C" void kernel_launch(void* const* d_in, const int* in_sizes, int n_in, void* d_out, int out_size, void* d_ws, size_t ws_size, hipStream_t stream) {
    const float* x = (const float*)d_in[0]; const float* c = (const float*)d_in[1]; const float* ctx = (const float*)d_in[2]; const float* c_ctx = (const float*)d_in[3];
    const float* ada_w = (const float*)d_in[4]; const float* ada_b = (const float*)d_in[5]; const float* norm1_w = (const float*)d_in[6]; const float* w_in = (const float*)d_in[7];
    const float* conv_w = (const float*)d_in[8]; const float* conv_b = (const float*)d_in[9]; const float* gate_b = (const float*)d_in[10]; const float* mnorm_w = (const float*)d_in[11];
    const float* rpb = (const float*)d_in[12]; const float* w_out = (const float*)d_in[13]; const float* norm2_w = (const float*)d_in[14]; const float* router_w = (const float*)d_in[15];
    const float* router_b = (const float*)d_in[16]; const float* exp_w1 = (const float*)d_in[17]; const float* exp_w3 = (const float*)d_in[18]; const float* exp_w2 = (const float*)d_in[19];
    const float* final_w = (const float*)d_in[20];
    if (ws_size < WS_END) { fprintf(stderr, "kernel_launch: workspace too small (%zu < %zu)\n", ws_size, (size_t)WS_END); return; }
    unsigned char* ws = (unsigned char*)d_ws; float* out = (float*)d_out;
    unsigned* CTL = (unsigned*)(ws + WS_CTL); float* MOD = (float*)(ws + WS_MOD); float* CTXB = (float*)(ws + WS_CTX);
    float* GATES = (float*)(ws + WS_GATES); bf16* ACT = (bf16*)(ws + WS_ACT); bf16* PA = (bf16*)(ws + WS_PA); bf16* QKRAW = (bf16*)(ws + WS_QKRAW); bf16* CST = (bf16*)(ws + WS_CST);
    bf16* MVT = (bf16*)(ws + WS_MVT); bf16* NVT = (bf16*)(ws + WS_NVT); bf16* QP = (bf16*)(ws + WS_QP); bf16* KP = (bf16*)(ws + WS_KP); bf16* KPT = (bf16*)(ws + WS_KPT);
    float* NST = (float*)(ws + WS_NST); float* MST = (float*)(ws + WS_MST); float* HSUM = (float*)(ws + WS_HSUM); bf16* ACTM = (bf16*)(ws + WS_ACTM); bf16* Y = (bf16*)(ws + WS_Y);
    int* TOK_E = (int*)(ws + WS_ROUTE + RT_TOK_E); float* TOK_W = (float*)(ws + WS_ROUTE + RT_TOK_W); int* TOK_SLOT = (int*)(ws + WS_ROUTE + RT_TOK_SLOT);
    int* SLOT_TOK = (int*)(ws + WS_ROUTE + RT_SLOT_TOK); float* SLOT_W = (float*)(ws + WS_ROUTE + RT_SLOT_W); int* TILE_E0 = (int*)(ws + WS_ROUTE + RT_TILE_E);
    static int grid = 0;
    if (grid == 0) {
        int dev = 0, cus = 0; (void)hipGetDevice(&dev); (void)hipDeviceGetAttribute(&cus, hipDeviceAttributeMultiprocessorCount, dev);
        (void)hipFuncSetAttribute((const void*)nv_mout, hipFuncAttributeMaxDynamicSharedMemorySize, 70 * 1024);
        (void)hipFuncSetAttribute((const void*)mk_fwd, hipFuncAttributeMaxDynamicSharedMemorySize, LDS_BYTES);
        int per_cu = 0; (void)hipOccupancyMaxActiveBlocksPerMultiprocessor(&per_cu, (const void*)mk_fwd, NTHR, LDS_BYTES); (void)hipGetLastError();
        grid = (cus == 256 && per_cu >= 1) ? 256 : -1;
        if (grid < 0) fprintf(stderr, "kernel_launch: persistent kernel needs 256 CUs and one resident block per CU (cus %d, per_cu %d); using the naive path\n", cus, per_cu);
    }
    (void)hipMemsetAsync(ws + WS_CTL, 0, 1 * MiB, stream);
    Args a{};
    for (int i = 0; i < 21; ++i) a.in[i] = (const float*)d_in[i];
    a.out = out; a.ws = ws;
    int region = 0;
#if defined(PROBE_PHASE)
    if (grid > 0) {
        a.mixflags = MIXFLAGS;
        if (PROBE_PHASE > 0) { a.ph_lo = 0; a.ph_hi = PROBE_PHASE; a.bar_region = region++; hipLaunchKernelGGL(mk_fwd, dim3(grid), dim3(NTHR), LDS_BYTES, stream, a); }
        #ifdef PROBE_MIXFLAGS
        a.mixflags = PROBE_MIXFLAGS;
#endif
        for (int r = 1; r < PROBE_REPS; ++r) { a.ph_lo = PROBE_PHASE; a.ph_hi = PROBE_PHASE + 1; a.bar_region = region++; hipLaunchKernelGGL(mk_fwd, dim3(grid), dim3(NTHR), LDS_BYTES, stream, a); }
        a.mixflags = MIXFLAGS;
        a.ph_lo = PROBE_PHASE; a.ph_hi = NPHASE; a.bar_region = region++; hipLaunchKernelGGL(mk_fwd, dim3(grid), dim3(NTHR), LDS_BYTES, stream, a);
        return;
    }
#endif
    for (int ph = 0; ph < NPHASE;) {
        if (grid > 0 && persist_phase(ph)) {
            int ph2 = ph; while (ph2 < NPHASE && persist_phase(ph2)) ++ph2;
            a.ph_lo = ph; a.ph_hi = ph2; a.bar_region = region++; a.mixflags = MIXFLAGS;
            for (int q = ph; q < ph2; ++q) if (q >= 1 && q < PH_FINAL && (q - 1) % 10 == K_MIX && MIXFLAGS != 3) { ph2 = q + 1; break; }
            a.ph_hi = ph2;
            hipLaunchKernelGGL(mk_fwd, dim3(grid), dim3(NTHR), LDS_BYTES, stream, a);
            if (ph2 >= 2 && ph2 - 1 < PH_FINAL && (ph2 - 2) % 10 == K_MIX && MIXFLAGS != 3) {
                const int l = (ph2 - 2) / 10; const bool last = (l == 1);
                if (!(MIXFLAGS & 1)) { nv_mout<<<dim3(NCHUNK, 32), 256, (128 * 129 + 1024) * 4, stream>>>(QP, KP, MVT, GATES, CST, NST, MST, HSUM, last ? 1 : 0);
                    nv_mnorm<<<MROWS, 256, 0, stream>>>(HSUM, PA, mnorm_w + l * 512, ACT, last ? 1 : 0); }
                if (!(MIXFLAGS & 2)) { nv_na<<<dim3(SEQ, 8, 8), 128, 0, stream>>>(PA, NVT, rpb + (size_t)l * 8 * 15 * 31, ACT, 0);
                    if (!last) nv_na<<<dim3(CTXL, 8, 8), 128, 0, stream>>>(PA, NVT, rpb + (size_t)l * 8 * 15 * 31, ACT, 1); }
            }
            ph = ph2; continue;
        }
        if (ph == PH_PRO) { nv_mod<<<dim3(24, 9, 2), 256, 0, stream>>>(c, c_ctx, ada_w, ada_b, MOD); ++ph; continue; }
        if (ph == PH_FINAL) {
            nv_combine<<<MROWS, 256, 0, stream>>>(out, CTXB, MOD + (size_t)9 * 6144, TOK_SLOT, TOK_W, Y, 1);
            nv_final<<<NB * SEQ, 256, 0, stream>>>(out, final_w); ++ph; continue; }
        const int l = (ph - 1) / 10, k = (ph - 1) % 10; const bool last = (l == 1); const int lo = 32 * l;
        const float* MODl = MOD + (size_t)l * 9 * 6144;
        const float* sl = l == 0 ? x : out; const float* scx = l == 0 ? ctx : CTXB;
        int* TILE_E = TILE_E0 + 512 * l;
        switch (k) {
        case K_NORM1:
            if (l == 1) nv_combine<<<MROWS, 256, 0, stream>>>(out, CTXB, MOD, TOK_SLOT, TOK_W, Y, 0);
            nv_norm<<<MROWS, 256, 0, stream>>>(sl, scx, norm1_w + l * 1024, MODl, 0, 1, ACT, 0, nullptr, nullptr, nullptr, nullptr, nullptr, 0); break;
        case K_GEMM_IN: { EpiIn ei{QKRAW, PA, MVT, NVT, GATES, gate_b + l * 16}; EpiOut eo{};
            nv_gemm<0><<<dim3((N_IN + 63) / 64, MROWS / 64), 256, 0, stream>>>(ACT, w_in + (size_t)l * 1024 * N_IN, N_IN, N_IN, 1024, ei, eo); } break;
        case K_PREP: nv_prep<<<MROWS * 1024 / 256, 256, 0, stream>>>(QKRAW, conv_w + l * 3072, conv_b + l * 1024, QP, KP, KPT); break;
        case K_SCAN: nv_scan<<<dim3(64, 64), 256, 0, stream>>>(KP, MVT, GATES, CST, NST, MST); break;
        case K_MIX:
            nv_mout<<<dim3(NCHUNK, 32), 256, (128 * 129 + 1024) * 4, stream>>>(QP, KP, MVT, GATES, CST, NST, MST, HSUM, last ? 1 : 0);
            nv_mnorm<<<MROWS, 256, 0, stream>>>(HSUM, PA, mnorm_w + l * 512, ACT, last ? 1 : 0);
            nv_na<<<dim3(SEQ, 8, 8), 128, 0, stream>>>(PA, NVT, rpb + (size_t)l * 8 * 15 * 31, ACT, 0);
            if (!last) nv_na<<<dim3(CTXL, 8, 8), 128, 0, stream>>>(PA, NVT, rpb + (size_t)l * 8 * 15 * 31, ACT, 1);
            break;
        case K_GEMM_OUT: { EpiOut eo2{sl, scx, out, CTXB, MODl, last ? 1 : 0, 0}; EpiIn ei2{};
            nv_gemm<1><<<dim3(16, MROWS / 64), 256, 0, stream>>>(ACT, w_out + (size_t)l * 1024 * 1024, 1024, 1024, 1024, ei2, eo2); } break;
        case K_NORM2: nv_norm<<<MROWS, 256, 0, stream>>>(out, CTXB, norm2_w + l * 1024, MODl, 3, 4, ACT, 1, router_w, router_b, TOK_E, TOK_W, CTL + CW_CNT + lo, last ? 1 : 0); break;
        case K_SLOTS:
            nv_slots_off<<<1, 256, 0, stream>>>(CTL, SLOT_TOK, SLOT_W, TILE_E, lo);
            nv_slots_assign<<<MROWS / 256, 256, 0, stream>>>(CTL, TOK_E, TOK_W, TOK_SLOT, SLOT_TOK, SLOT_W, last ? 1 : 0, lo); break;
        case K_MOE1: nv_moe1<<<MAXSLOTS, 256, 0, stream>>>(CTL, ACT, SLOT_TOK, SLOT_W, TILE_E, exp_w1 + (size_t)l * 16 * 1024 * 512, exp_w3 + (size_t)l * 16 * 1024 * 512, ACTM, lo); break;
        case K_MOE2: nv_moe2<<<MAXSLOTS, 256, 0, stream>>>(CTL, ACTM, SLOT_W, TILE_E, exp_w2 + (size_t)l * 16 * 512 * 1024, Y, lo); break;
        }
        ++ph;
    }
}
```
